# Optimizing an MI355X kernel written in HIP

```python
import math
import jax
import jax.numpy as jnp
from jax import lax
import numpy as np

D_MODEL = 2048
BATCH = 4
SEQ = 2048
DEPTH = 1
DEC_BATCH = 128
DEC_SEQ = 4
PAST_LEN = 16384
PAGE_SIZE = 128

HG_HEADS = 16
HG_DK = 128
HG_DV = 128
HG_CHUNK = 32
GDN_QK_HEADS = 16
GDN_V_HEADS = 32
GDN_DK = 128
GDN_DV = 128
GDN_CHUNK = 64
CONV_W = 4
D_FF = 4 * D_MODEL
NORM_EPS = 1e-6

HG_W = HG_HEADS * HG_DK
HG_VW = HG_HEADS * HG_DV
GDN_QK_W = GDN_QK_HEADS * GDN_DK
GDN_V_W = GDN_V_HEADS * GDN_DV
CONV_CH = 2 * GDN_QK_W + GDN_V_W
GDN_SCALE = GDN_DK ** -0.5
IN_SPLITS = (HG_W, HG_W, HG_VW, HG_VW, GDN_QK_W, GDN_QK_W, GDN_V_W, GDN_V_W, GDN_V_HEADS, GDN_V_HEADS, D_MODEL, D_MODEL)
N_IN = 4 * HG_W + 2 * GDN_QK_W + 2 * GDN_V_W + 2 * GDN_V_HEADS + 2 * D_MODEL

kernel_name = "hybrid_hgrn2_gdn_decoder_step"


def rmsnorm(x, g):
    x32 = x.astype(jnp.float32)
    return x32 * lax.rsqrt(jnp.mean(x32 * x32, axis=-1, keepdims=True) + NORM_EPS) * g.astype(jnp.float32)


def l2norm(x):
    return x * lax.rsqrt(jnp.sum(x * x, axis=-1, keepdims=True) + NORM_EPS)


def to_chunks(x, C, n):
    B, T = x.shape[0], x.shape[1]
    x = jnp.pad(x, [(0, 0), (0, n * C - T)] + [(0, 0)] * (x.ndim - 2))
    x = x.reshape((B, n, C) + x.shape[2:])
    return jnp.moveaxis(x, (1, 3), (0, 2))


def from_chunks(x, T):
    n, B, H, C, D = x.shape
    x = jnp.moveaxis(x, (0, 2), (1, 3)).reshape(B, n * C, H, D)
    return x[:, :T]


def hgrn2_scan(q, f, inp, S0):
    T = q.shape[1]
    C = min(HG_CHUNK, T)
    n = -(-T // C)
    log_f = jnp.log(f)
    k = 1.0 - f
    qc, gc, kc, ic = [to_chunks(a, C, n) for a in (q, log_f, k, inp)]
    causal = jnp.tril(jnp.ones((C, C), dtype=bool))
    ref = C // 2

    def step(S, xs):
        q_, g_, k_, i_ = xs
        G = jnp.cumsum(g_, axis=2)
        G_ref = G[:, :, ref:ref + 1]
        G_last = G[:, :, C - 1:C]
        A = jnp.einsum('bhtd,bhsd->bhts', q_ * jnp.exp(G - G_ref), k_ * jnp.exp(G_ref - G))
        A = jnp.where(causal, A, 0.0)
        o = (jnp.einsum('bhts,bhsv->bhtv', A, i_)
             + jnp.einsum('bhtd,bhdv->bhtv', q_ * jnp.exp(G), S))
        S = (jnp.exp(G_last[:, :, 0])[..., None] * S
             + jnp.einsum('bhsd,bhsv->bhdv', k_ * jnp.exp(G_last - G), i_))
        return S, o

    S, o = lax.scan(step, S0, (qc, gc, kc, ic))
    return from_chunks(o, T), S


def gdn_scan(q, k, v, log_a, beta, S0):
    T = q.shape[1]
    C = min(GDN_CHUNK, T)
    n = -(-T // C)
    qc, kc, vc, gc, bc = [to_chunks(a, C, n) for a in (q, k, v, log_a, beta)]
    incl = jnp.tril(jnp.ones((C, C), dtype=bool))
    strict = jnp.tril(jnp.ones((C, C), dtype=bool), -1)
    eye = jnp.eye(C, dtype=jnp.float32)

    def step(S, xs):
        q_, k_, v_, g_, b_ = xs
        gam = jnp.cumsum(g_, axis=-1)
        L = jnp.exp(jnp.where(incl, gam[..., :, None] - gam[..., None, :], -jnp.inf))
        kb = k_ * b_[..., None]
        A = jnp.where(strict, jnp.einsum('bhtd,bhsd->bhts', kb, k_) * L, 0.0)
        rhs = jnp.concatenate([v_ * b_[..., None], kb * jnp.exp(gam)[..., None]], axis=-1)
        X = lax.linalg.triangular_solve(A + eye, rhs, left_side=True, lower=True, unit_diagonal=True)
        u, w = X[..., :GDN_DV], X[..., GDN_DV:]
        v_new = u - jnp.einsum('bhtd,bhdv->bhtv', w, S)
        attn = jnp.einsum('bhtd,bhsd->bhts', q_, k_) * L
        o = (jnp.einsum('bhtd,bhdv->bhtv', q_ * jnp.exp(gam)[..., None], S)
             + jnp.einsum('bhts,bhsv->bhtv', attn, v_new))
        g_last = gam[..., C - 1:C]
        S = (jnp.exp(g_last)[..., None] * S
             + jnp.einsum('bhsd,bhsv->bhdv', k_ * jnp.exp(g_last - gam)[..., None], v_new))
        return S, o

    S, o = lax.scan(step, S0, (qc, kc, vc, gc, bc))
    return from_chunks(o, T), S


def token_mixer(a, conv_buf, s_hg, s_gdn, lb, w_in, conv_w, A_log, dt_bias,
                hg_norm_g, gdn_norm_g, w_out_hg, w_out_gdn, w_o):
    B, T, _ = a.shape
    f32 = jnp.float32
    proj = jnp.matmul(a, w_in).astype(f32)
    offsets = [int(o) for o in np.cumsum(IN_SPLITS)[:-1]]
    hq, hf, hi, hg, gq, gk, gv, gz, gb, ga, gate_a, gate_b = jnp.split(proj, offsets, axis=-1)

    q_h = jax.nn.silu(hq).reshape(B, T, HG_HEADS, HG_DK)
    f_h = (lb + (1.0 - lb) * jax.nn.sigmoid(hf)).reshape(B, T, HG_HEADS, HG_DK)
    i_h = hi.reshape(B, T, HG_HEADS, HG_DV)
    o_hg, s_hg_new = hgrn2_scan(q_h, f_h, i_h, s_hg.astype(f32))
    o_hg = (rmsnorm(o_hg, hg_norm_g) * jax.nn.silu(hg.reshape(B, T, HG_HEADS, HG_DV))).reshape(B, T, HG_VW)

    u = jnp.concatenate([gq, gk, gv], axis=-1)
    ucat = jnp.concatenate([conv_buf.astype(f32), u], axis=1)
    cw = conv_w.astype(f32)
    conv = cw[0] * ucat[:, 0:T]
    for j in range(1, CONV_W):
        conv = conv + cw[j] * ucat[:, j:j + T]
    conv_buf_new = ucat[:, T:]
    conv = jax.nn.silu(conv)
    cq, ck, cv = jnp.split(conv, [GDN_QK_W, 2 * GDN_QK_W], axis=-1)
    rep = GDN_V_HEADS // GDN_QK_HEADS
    q_g = jnp.repeat(l2norm(cq.reshape(B, T, GDN_QK_HEADS, GDN_DK)), rep, axis=2) * GDN_SCALE
    k_g = jnp.repeat(l2norm(ck.reshape(B, T, GDN_QK_HEADS, GDN_DK)), rep, axis=2)
    v_g = cv.reshape(B, T, GDN_V_HEADS, GDN_DV)
    beta = jax.nn.sigmoid(gb)
    log_a = -jnp.exp(A_log.astype(f32)) * jax.nn.softplus(ga + dt_bias.astype(f32))
    o_gdn, s_gdn_new = gdn_scan(q_g, k_g, v_g, log_a, beta, s_gdn.astype(f32))
    o_gdn = (rmsnorm(o_gdn, gdn_norm_g) * jax.nn.silu(gz.reshape(B, T, GDN_V_HEADS, GDN_DV))).reshape(B, T, GDN_V_W)

    merged = (jax.nn.sigmoid(gate_a) * jnp.matmul(o_hg, w_out_hg)
              + jax.nn.sigmoid(gate_b) * jnp.matmul(o_gdn, w_out_gdn))
    return jnp.matmul(merged, w_o), conv_buf_new, s_hg_new, s_gdn_new


def run_trunk(x, c, conv_buf, st_hg, st_gdn, lb_logits, w_ada, b_ada, norm_g, w_in, conv_w,
              A_log, dt_bias, hg_norm_g, gdn_norm_g, w_out_hg, w_out_gdn, w_o, w_up, w_down):
    f32 = jnp.float32
    lbs = jnp.cumsum(jax.nn.softmax(lb_logits.astype(f32), axis=0), axis=0)
    h = x.astype(f32)
    cs = jax.nn.silu(c.astype(f32))
    new_conv, new_hg, new_gdn = [], [], []
    for l in range(DEPTH):
        mod = jnp.matmul(cs, w_ada[l]) + b_ada[l]
        sh1, sc1, g1, sh2, sc2, g2 = [m[:, None, :] for m in jnp.split(mod, 6, axis=-1)]
        a = rmsnorm(h, norm_g[l, 0]) * (1.0 + sc1) + sh1
        mix, cb, shg, sgd = token_mixer(a, conv_buf[l], st_hg[l], st_gdn[l], lbs[l], w_in[l], conv_w[l],
                                        A_log[l], dt_bias[l], hg_norm_g[l], gdn_norm_g[l],
                                        w_out_hg[l], w_out_gdn[l], w_o[l])
        h = h + g1 * rmsnorm(mix, norm_g[l, 1])
        a = rmsnorm(h, norm_g[l, 2]) * (1.0 + sc2) + sh2
        ff = jnp.matmul(jnp.square(jax.nn.relu(jnp.matmul(a, w_up[l]))), w_down[l])
        h = h + g2 * rmsnorm(ff, norm_g[l, 3])
        new_conv.append(cb)
        new_hg.append(shg)
        new_gdn.append(sgd)
    return h.astype(x.dtype), jnp.stack(new_conv), jnp.stack(new_hg), jnp.stack(new_gdn)


def setup_inputs(seed: int = 0) -> dict:
    key = jax.random.key(seed)
    ks = jax.random.split(key, 24)
    f32 = jnp.float32

    def nrm(k, shape, scale):
        return jax.random.normal(k, shape, f32) * scale

    dt = jnp.exp(jax.random.uniform(ks[14], (DEPTH, GDN_V_HEADS), f32, math.log(1e-3), math.log(1e-1)))
    return {
        "x_prompt": nrm(ks[0], (BATCH, SEQ, D_MODEL), 1.0),
        "x_sample": nrm(ks[1], (DEC_BATCH, DEC_SEQ, D_MODEL), 1.0),
        "state_hgrn": nrm(ks[2], (DEPTH, DEC_BATCH, HG_HEADS, HG_DK, HG_DV), 0.5),
        "state_gdn": nrm(ks[3], (DEPTH, DEC_BATCH, GDN_V_HEADS, GDN_DK, GDN_DV), 0.1),
        "cache_conv": nrm(ks[4], (DEPTH, DEC_BATCH, CONV_W - 1, CONV_CH), 1.0),
        "c_prompt": nrm(ks[5], (BATCH, D_MODEL), 1.0),
        "c_sample": nrm(ks[6], (DEC_BATCH, D_MODEL), 1.0),
        "lb_logits": nrm(ks[7], (DEPTH + 1, HG_W), 0.1),
        "w_ada": nrm(ks[8], (DEPTH, D_MODEL, 6 * D_MODEL), 0.5 * D_MODEL ** -0.5),
        "b_ada": nrm(ks[9], (DEPTH, 6 * D_MODEL), 0.02),
        "norm_g": 1.0 + nrm(ks[10], (DEPTH, 4, D_MODEL), 0.02),
        "w_in": nrm(ks[11], (DEPTH, D_MODEL, N_IN), D_MODEL ** -0.5),
        "conv_w": nrm(ks[12], (DEPTH, CONV_W, CONV_CH), CONV_W ** -0.5),
        "A_log": jnp.log(jax.random.uniform(ks[13], (DEPTH, GDN_V_HEADS), f32, 1.0, 16.0)),
        "dt_bias": dt + jnp.log(-jnp.expm1(-dt)),
        "hg_norm_g": 1.0 + nrm(ks[15], (DEPTH, HG_DV), 0.02),
        "gdn_norm_g": 1.0 + nrm(ks[16], (DEPTH, GDN_DV), 0.02),
        "w_out_hg": nrm(ks[17], (DEPTH, HG_VW, D_MODEL), HG_VW ** -0.5),
        "w_out_gdn": nrm(ks[18], (DEPTH, GDN_V_W, D_MODEL), GDN_V_W ** -0.5),
        "w_o": nrm(ks[19], (DEPTH, D_MODEL, D_MODEL), D_MODEL ** -0.5),
        "w_up": nrm(ks[20], (DEPTH, D_MODEL, D_FF), D_MODEL ** -0.5),
        "w_down": nrm(ks[21], (DEPTH, D_FF, D_MODEL), D_FF ** -0.5),
    }


def reference(x_prompt, x_sample, state_hgrn, state_gdn, cache_conv, c_prompt, c_sample,
              lb_logits, w_ada, b_ada, norm_g, w_in, conv_w, A_log, dt_bias, hg_norm_g, gdn_norm_g,
              w_out_hg, w_out_gdn, w_o, w_up, w_down):
    sdt = state_hgrn.dtype
    zero_conv = jnp.zeros((DEPTH, BATCH, CONV_W - 1, CONV_CH), cache_conv.dtype)
    zero_hg = jnp.zeros((DEPTH, BATCH, HG_HEADS, HG_DK, HG_DV), sdt)
    zero_gdn = jnp.zeros((DEPTH, BATCH, GDN_V_HEADS, GDN_DK, GDN_DV), state_gdn.dtype)
    y_prompt, conv_p, hg_p, gdn_p = run_trunk(
        x_prompt, c_prompt, zero_conv, zero_hg, zero_gdn, lb_logits, w_ada, b_ada, norm_g, w_in, conv_w,
        A_log, dt_bias, hg_norm_g, gdn_norm_g, w_out_hg, w_out_gdn, w_o, w_up, w_down)
    y_sample, conv_s, hg_s, gdn_s = run_trunk(
        x_sample, c_sample, cache_conv, state_hgrn, state_gdn, lb_logits, w_ada, b_ada, norm_g, w_in, conv_w,
        A_log, dt_bias, hg_norm_g, gdn_norm_g, w_out_hg, w_out_gdn, w_o, w_up, w_down)
    return (y_prompt, y_sample,
            hg_p.astype(sdt), gdn_p.astype(state_gdn.dtype), conv_p.astype(cache_conv.dtype),
            hg_s.astype(sdt), gdn_s.astype(state_gdn.dtype), conv_s.astype(cache_conv.dtype))
```

```cpp
#include <hip/hip_runtime.h>
#include <hip/hip_cooperative_groups.h>
#include <cstdio>
#include <cstdint>
namespace cg = cooperative_groups;
__device__ __forceinline__ int lane_id_() { int l; asm volatile("v_mbcnt_lo_u32_b32 %0, -1, 0\n\tv_mbcnt_hi_u32_b32 %0, -1, %0" : "=v"(l)); return l; }
namespace pg8 {
#define PG8_LAS __attribute__((address_space(3)))
typedef unsigned short bf16_t;
typedef short bf16x8 __attribute__((ext_vector_type(8)));
typedef float f32x4 __attribute__((ext_vector_type(4)));
typedef unsigned u32x4 __attribute__((ext_vector_type(4)));
constexpr int BM = 256, BK = 64, HALF = 128, HTB = HALF * BK * 2  , STAGE_BYTES = 8 * HTB, NXCD = 8, WGM = 8;

__host__ __device__ __forceinline__ int lds_byte(int r, int c) { const int st = (r >> 4) * 2 + (c >> 5), rr = r & 15, cc = c & 31, ob = rr * 64 + cc * 2; return st * 1024 + (ob ^ (((ob >> 9) & 1) << 5)); }
__host__ __device__ __forceinline__ void stage_rc(int b, int& R, int& C) { const int st = b / 1024, sb = b % 1024, swz = sb ^ (((sb >> 9) & 1) << 5); R = (st >> 1) * 16 + swz / 64; C = (st & 1) * 32 + (swz % 64) / 2; }
__host__ __device__ __forceinline__ int perm32(int rho) { const int n = rho >> 4, i = rho & 15; return 8 * (i >> 2) + 4 * n + (i & 3); }

struct Unit { int pm, pn; };
struct Gemm { const bf16_t* A; const bf16_t* Bt; int lda, ldb, K; };

struct StaticOrder {
    int nM, nN, nwg, G, c;
    __host__ __device__ void init(int M, int N, int G_, int c_) { nM = M / BM; nN = N / BM; nwg = nM * nN; G = G_; c = c_; }
    __host__ __device__ bool next(int i, Unit& u) const {
        const long L = (long)i * G + c; if (L >= nwg) return false;
        int wgid = (int)L; { const int q = nwg / NXCD, r = nwg % NXCD, xcd = wgid % NXCD, off = wgid / NXCD; wgid = (xcd < r ? xcd * (q + 1) : r * (q + 1) + (xcd - r) * q) + off; }
        const int nig = WGM * nN, gid = wgid / nig, fm = gid * WGM, gsz = (nM - fm) < WGM ? (nM - fm) : WGM;
        u.pm = fm + ((wgid % nig) % gsz); u.pn = (wgid % nig) / gsz; return true;
    }
    __device__ __forceinline__ void a_ready(const Unit&) const {}
    __device__ __forceinline__ void done(const Unit&) const {}
};

__device__ __forceinline__ unsigned cvt_pk_bf16(float lo, float hi) { unsigned r; asm volatile("v_cvt_pk_bf16_f32 %0, %1, %2" : "=v"(r) : "v"(lo), "v"(hi)); return r; }

template <class Epi, class Sched, bool ALIGN_EPI = false, bool SP2 = false>
__device__ __forceinline__ void gemm_phase(PG8_LAS unsigned char* lds, const Gemm g, const Sched& S, const Epi& E, int wid_in) {
    const int wid = wid_in, lane = lane_id_(), tid = wid * 64 + lane, wr = wid >> 2, wc = wid & 3, fr = lane & 15, fq = lane >> 4;
    const int K = g.K, nt = K / BK;
    unsigned voffA[2], voffB[2];
#pragma unroll
    for (int i = 0; i < 2; ++i) { int R, C; stage_rc(tid * 16 + i * 8192, R, C); const int Rb = Epi::PERM ? ((R & ~31) + perm32(R & 31)) : R;
        voffA[i] = (unsigned)(R * g.lda + C) * 2u; voffB[i] = (unsigned)(Rb * g.ldb + C) * 2u; }
    const size_t kstep = (size_t)(BK * 2);
    const size_t hstepA = (size_t)HALF * g.lda * 2, hstepB = (size_t)HALF * g.ldb * 2;
    const size_t tstepA = 2 * hstepA, tstepB = 2 * hstepB;
    const unsigned ldsw = (unsigned)wid * 1024u;
    const int aoff = lds_byte(wr * 64 + fr, fq * 8), boff = lds_byte(wc * 32 + fr, fq * 8);
#define PG8_SA(b, h) (((b) * 2 + (h)) * HTB)
#define PG8_SB(b, h) ((4 + (b) * 2 + (h)) * HTB)
#define PG8_STAGE(bufoff, gbase, voff) do { _Pragma("unroll") for (int _i = 0; _i < 2; ++_i) \
        __builtin_amdgcn_global_load_lds((const unsigned*)((const char*)(gbase) + (voff)[_i]), (PG8_LAS unsigned*)(lds + (bufoff) + ldsw + _i * 8192), 16, 0, 0); } while (0)
#define PG8_LDA(dst, b, h) do { _Pragma("unroll") for (int m = 0; m < 4; ++m) _Pragma("unroll") for (int k = 0; k < 2; ++k) dst[m][k] = *(const PG8_LAS bf16x8*)(lds + PG8_SA(b, h) + aoff + m * 2048 + k * 1024); } while (0)
#define PG8_LDB(dst, b, h) do { _Pragma("unroll") for (int n = 0; n < 2; ++n) _Pragma("unroll") for (int k = 0; k < 2; ++k) dst[n][k] = *(const PG8_LAS bf16x8*)(lds + PG8_SB(b, h) + boff + n * 2048 + k * 1024); } while (0)
#define PG8_MMA(ai, bj, At, Bt) do { __builtin_amdgcn_s_setprio(1); _Pragma("unroll") for (int m = 0; m < 4; ++m) _Pragma("unroll") for (int n = 0; n < 2; ++n) _Pragma("unroll") for (int k = 0; k < 2; ++k) \
        acc[ai][bj][m][n] = __builtin_amdgcn_mfma_f32_16x16x32_bf16(Bt[n][k], At[m][k], acc[ai][bj][m][n], 0, 0, 0); __builtin_amdgcn_s_setprio(0); } while (0)
#define PG8_WAIT_V(n) asm volatile("s_waitcnt vmcnt(" #n ")" ::: "memory")
#define PG8_WAIT_L(n) asm volatile("s_waitcnt lgkmcnt(" #n ")" ::: "memory")
#define PG8_BAR __builtin_amdgcn_s_barrier()
#define PG8_SCHED __builtin_amdgcn_sched_barrier(0)
    Unit cur, nxt; int ui = 0;
    if (!S.next(0, cur)) return;
    f32x4 acc[2][2][4][2];
#pragma unroll
    for (int a = 0; a < 2; ++a)
#pragma unroll
        for (int b = 0; b < 2; ++b)
#pragma unroll
            for (int m = 0; m < 4; ++m)
#pragma unroll
                for (int n = 0; n < 2; ++n) acc[a][b][m][n] = (f32x4){0.f, 0.f, 0.f, 0.f};
    bf16x8 At[4][2], B0[2][2], B1[2][2];
    const char* cA = (const char*)g.A + (size_t)cur.pm * tstepA; const char* cB = (const char*)g.Bt + (size_t)cur.pn * tstepB;
    S.a_ready(cur);
    if constexpr (SP2) {
        PG8_STAGE(PG8_SB(0, 0), cB, voffB); PG8_STAGE(PG8_SB(0, 1), cB + hstepB, voffB); PG8_STAGE(PG8_SA(0, 0), cA, voffA); PG8_STAGE(PG8_SA(0, 1), cA + hstepA, voffA);
        if (wr == 1) PG8_BAR;
        PG8_WAIT_V(2); PG8_BAR;
        PG8_STAGE(PG8_SB(1, 0), cB + kstep, voffB); PG8_STAGE(PG8_SA(1, 0), cA + kstep, voffA); PG8_STAGE(PG8_SB(1, 1), cB + hstepB + kstep, voffB);
        PG8_WAIT_V(6); PG8_BAR;
    } else {
        PG8_STAGE(PG8_SB(0, 0), cB, voffB); PG8_STAGE(PG8_SA(0, 0), cA, voffA); PG8_STAGE(PG8_SB(0, 1), cB + hstepB, voffB); PG8_STAGE(PG8_SA(0, 1), cA + hstepA, voffA);
        if (wr == 1) PG8_BAR;
        PG8_WAIT_V(4); PG8_BAR;
        PG8_STAGE(PG8_SB(1, 0), cB + kstep, voffB); PG8_STAGE(PG8_SA(1, 0), cA + kstep, voffA); PG8_STAGE(PG8_SB(1, 1), cB + hstepB + kstep, voffB);
        PG8_WAIT_V(6); PG8_BAR;
    }
    for (;;) {
        const bool has_next = S.next(ui + 1, nxt);
        const char* nA = has_next ? (const char*)g.A + (size_t)nxt.pm * tstepA : cA; const char* nB = has_next ? (const char*)g.Bt + (size_t)nxt.pn * tstepB : cB;
        for (int t = 0; t < nt; t += 2) {
            const bool last = (t == nt - 2);
            const char* a1 = cA + (size_t)(t + 1) * kstep;
            const char* a2 = last ? nA : cA + (size_t)(t + 2) * kstep; const char* b2 = last ? nB : cB + (size_t)(t + 2) * kstep;
            const char* a3 = a2 + kstep; const char* b3 = b2 + kstep;
            if (last && has_next) S.a_ready(nxt);
            if constexpr (SP2) {
            PG8_LDB(B0, 0, 0); PG8_LDB(B1, 0, 1); PG8_SCHED; PG8_LDA(At, 0, 0); PG8_STAGE(PG8_SA(1, 1), a1 + hstepA, voffA);
            PG8_WAIT_V(8); PG8_WAIT_L(0); PG8_BAR; PG8_MMA(0, 0, At, B0); PG8_MMA(0, 1, At, B1); PG8_BAR; PG8_SCHED;
            PG8_LDA(At, 0, 1); PG8_STAGE(PG8_SB(0, 0), b2, voffB); PG8_STAGE(PG8_SB(0, 1), b2 + hstepB, voffB); PG8_STAGE(PG8_SA(0, 0), a2, voffA);
            PG8_WAIT_V(8); PG8_WAIT_L(0); PG8_BAR; PG8_MMA(1, 0, At, B0); PG8_MMA(1, 1, At, B1); PG8_BAR; PG8_SCHED;
            PG8_LDB(B0, 1, 0); PG8_LDB(B1, 1, 1); PG8_SCHED; PG8_LDA(At, 1, 0); PG8_STAGE(PG8_SA(0, 1), a2 + hstepA, voffA);
            PG8_WAIT_V(8); PG8_WAIT_L(0); PG8_BAR; PG8_MMA(0, 0, At, B0); PG8_MMA(0, 1, At, B1); PG8_BAR; PG8_SCHED;
            PG8_LDA(At, 1, 1); PG8_STAGE(PG8_SB(1, 0), b3, voffB); PG8_STAGE(PG8_SB(1, 1), b3 + hstepB, voffB); PG8_STAGE(PG8_SA(1, 0), a3, voffA);
            PG8_WAIT_V(8); PG8_WAIT_L(0); PG8_BAR; PG8_MMA(1, 0, At, B0); PG8_MMA(1, 1, At, B1); PG8_BAR; PG8_SCHED;
            } else {
            PG8_LDB(B0, 0, 0); PG8_SCHED; PG8_LDA(At, 0, 0); PG8_STAGE(PG8_SA(1, 1), a1 + hstepA, voffA);
            PG8_WAIT_L(8); PG8_BAR; PG8_WAIT_L(0); PG8_MMA(0, 0, At, B0); PG8_BAR; PG8_SCHED;
            PG8_LDB(B1, 0, 1); PG8_STAGE(PG8_SB(0, 0), b2, voffB);
            PG8_BAR; PG8_WAIT_L(0); PG8_MMA(0, 1, At, B1); PG8_BAR;
            PG8_LDA(At, 0, 1); PG8_STAGE(PG8_SA(0, 0), a2, voffA);
            PG8_BAR; PG8_WAIT_L(0); PG8_MMA(1, 0, At, B0); PG8_BAR; PG8_SCHED;
            PG8_STAGE(PG8_SB(0, 1), b2 + hstepB, voffB);
            PG8_WAIT_V(6); PG8_BAR; PG8_MMA(1, 1, At, B1); PG8_BAR;
            PG8_LDB(B0, 1, 0); PG8_SCHED; PG8_LDA(At, 1, 0); PG8_STAGE(PG8_SA(0, 1), a2 + hstepA, voffA);
            PG8_WAIT_L(8); PG8_BAR; PG8_WAIT_L(0); PG8_MMA(0, 0, At, B0); PG8_BAR; PG8_SCHED;
            PG8_LDB(B1, 1, 1); PG8_STAGE(PG8_SB(1, 0), b3, voffB);
            PG8_BAR; PG8_WAIT_L(0); PG8_MMA(0, 1, At, B1); PG8_BAR;
            PG8_LDA(At, 1, 1); PG8_STAGE(PG8_SA(1, 0), a3, voffA);
            PG8_BAR; PG8_WAIT_L(0); PG8_MMA(1, 0, At, B0); PG8_BAR; PG8_SCHED;
            PG8_STAGE(PG8_SB(1, 1), b3 + hstepB, voffB);
            PG8_WAIT_V(6); PG8_BAR; PG8_MMA(1, 1, At, B1); PG8_BAR;
            }
        }
        if constexpr (ALIGN_EPI) { if (wr == 0) PG8_BAR; }
        if constexpr (!Epi::AFTER_DRAIN) { E(acc, cur, wr, wc, fr, fq); S.done(cur); }
        if (!has_next) break;
#pragma unroll
        for (int a = 0; a < 2; ++a)
#pragma unroll
            for (int b = 0; b < 2; ++b)
#pragma unroll
                for (int m = 0; m < 4; ++m)
#pragma unroll
                    for (int n = 0; n < 2; ++n) acc[a][b][m][n] = (f32x4){0.f, 0.f, 0.f, 0.f};
        cur = nxt; cA = nA; cB = nB; ++ui;
        if constexpr (ALIGN_EPI) { if (wr == 1) PG8_BAR; }
    }
    PG8_WAIT_V(0);
    if constexpr (!ALIGN_EPI) { if (wr == 0) PG8_BAR; }
    PG8_BAR;
    if constexpr (Epi::AFTER_DRAIN) { E.fused(acc, cur, wr, wc, fr, fq, lds, wid, lane); S.done(cur); }
#undef PG8_SA
#undef PG8_SB
#undef PG8_STAGE
#undef PG8_LDA
#undef PG8_LDB
#undef PG8_MMA
#undef PG8_WAIT_V
#undef PG8_WAIT_L
#undef PG8_BAR
#undef PG8_SCHED
}
}


#define LAS __attribute__((address_space(3)))
typedef unsigned short bf16;
typedef float f32x4 __attribute__((ext_vector_type(4)));
typedef float f32x2 __attribute__((ext_vector_type(2)));
typedef short bf16x8 __attribute__((ext_vector_type(8)));
typedef unsigned u32x4 __attribute__((ext_vector_type(4)));
typedef unsigned u32x2 __attribute__((ext_vector_type(2)));

constexpr int NWAVES = 8, NTHREADS = 512;
constexpr int DM = 2048, MROWS = 8704, NPROMPT = 8192, NSEQ = 132, SEQ = 2048, DSEQ = 4;
constexpr int N_IN = 24640, N_INP = 24832, CONVCH = 8192, DFF = 8192, NADA = 12288;
constexpr float EPS = 1e-6f;
constexpr int LDS_BYTES = 147456;

enum { I_XP = 0, I_XS, I_SHG, I_SGD, I_CC, I_CP, I_CS, I_LB, I_WADA, I_BADA, I_NG, I_WIN, I_CW, I_ALOG, I_DTB, I_HGN, I_GDN, I_WOHG, I_WOGD, I_WO, I_WUP, I_WDN };
constexpr size_t O_Y = 0, O_HGP = 17825792, O_GDP = 18874368, O_CCP = 20971520, O_HGS = 21069824, O_GDS = 54624256, O_CCS = 121733120, O_END = 124878848;
constexpr size_t MiB = 1u << 20;
constexpr size_t WS_MOD = 1 * MiB, WS_BTIN = 8 * MiB, WS_BTOUT = 105 * MiB, WS_BTO = 129 * MiB, WS_BTUP = 137 * MiB, WS_BTDN = 169 * MiB, WS_A1 = 201 * MiB;
constexpr size_t WS_QH = 235 * MiB, WS_F = 269 * MiB, WS_I = 337 * MiB, WS_GH = 371 * MiB, WS_U = 405 * MiB, WS_GZ = 541 * MiB, WS_SA = 609 * MiB, WS_SB = 643 * MiB, WS_BL = 677 * MiB;
constexpr size_t WS_UC = 680 * MiB, WS_O32 = 816 * MiB, WS_OA = 235 * MiB, WS_T1 = 337 * MiB, WS_MG = 405 * MiB, WS_MIX = 439 * MiB, WS_H = 507 * MiB, WS_U2 = 680 * MiB, WS_FF = 439 * MiB;
constexpr size_t WS_END = 1020 * MiB;

__device__ __forceinline__ unsigned f2bf(float f) { unsigned u = __float_as_uint(f); return (u + 0x7fffu + ((u >> 16) & 1u)) >> 16; }
__device__ __forceinline__ unsigned pk2(float lo, float hi) { return f2bf(lo) | (f2bf(hi) << 16); }
__device__ __forceinline__ float bf2f(unsigned h) { return __uint_as_float(h << 16); }
__device__ __forceinline__ float bflo(unsigned w) { return __uint_as_float(w << 16); }
__device__ __forceinline__ float bfhi(unsigned w) { return __uint_as_float(w & 0xffff0000u); }
__device__ __forceinline__ float sigmoidf_(float x) { return __builtin_amdgcn_rcpf(1.0f + __expf(-x)); }
__device__ __forceinline__ float siluf_(float x) { return x * sigmoidf_(x); }
__device__ __forceinline__ float wave_sum(float v) {
#pragma unroll
    for (int o = 1; o < 64; o <<= 1) v += __shfl_xor(v, o);
    return v;
}
#define LDS_WAIT() asm volatile("s_waitcnt lgkmcnt(0)" ::: "memory")

struct Args { const float* in[22]; float* out; unsigned char* ws; int ph_lo, ph_hi; };
typedef __attribute__((address_space(4))) const unsigned char* kargp_t;
struct PA {
    kargp_t kp;
    static __device__ __forceinline__ PA get() { PA p; p.kp = (kargp_t)__builtin_amdgcn_kernarg_segment_ptr(); asm volatile("" : "+s"(p.kp)); return p; }
    __device__ __forceinline__ const float* in(int i) const { typedef const float* cfp; return ((__attribute__((address_space(4))) const cfp*)kp)[i]; }
    __device__ __forceinline__ float* out() const { typedef float* fp; return *((__attribute__((address_space(4))) const fp*)(kp + 176)); }
    __device__ __forceinline__ unsigned char* ws() const { typedef unsigned char* up; return *((__attribute__((address_space(4))) const up*)(kp + 184)); }
    __device__ __forceinline__ int ph_lo() const { return *((__attribute__((address_space(4))) const int*)(kp + 192)); }
    __device__ __forceinline__ int ph_hi() const { return *((__attribute__((address_space(4))) const int*)(kp + 196)); }
};
static_assert(sizeof(Args) == 200, "Args layout");
__device__ __forceinline__ bool ph_in(int k) { const PA p = PA::get(); return p.ph_lo() <= k && k < p.ph_hi(); }

template <int MODE> __device__ __forceinline__ float actf(float v) {
    if (MODE == 1) return siluf_(v);
    if (MODE == 2) return sigmoidf_(v);
    if (MODE == 3) { const float r = fmaxf(v, 0.f); return r * r; }
    return v;
}
template <int MODE> __device__ __forceinline__ void tile_store_bf16(const f32x4 (&acc)[2][2][4][2], bf16* base, int ld, int row0, int col0) {
#pragma unroll
    for (int ai = 0; ai < 2; ++ai)
#pragma unroll
        for (int m = 0; m < 4; ++m) {
            bf16* rowp = base + (size_t)(row0 + ai * 128 + m * 16) * ld + col0;
#pragma unroll
            for (int bj = 0; bj < 2; ++bj) {
                const f32x4 v0 = acc[ai][bj][m][0], v1 = acc[ai][bj][m][1];
                u32x4 w;
                w.x = pk2(actf<MODE>(v0[0]), actf<MODE>(v0[1])); w.y = pk2(actf<MODE>(v0[2]), actf<MODE>(v0[3]));
                w.z = pk2(actf<MODE>(v1[0]), actf<MODE>(v1[1])); w.w = pk2(actf<MODE>(v1[2]), actf<MODE>(v1[3]));
                *(u32x4*)(rowp + bj * 128) = w;
            }
        }
}
__device__ __forceinline__ void tile_store_f32(const f32x4 (&acc)[2][2][4][2], float* base, int ld, int row0, int col0) {
#pragma unroll
    for (int ai = 0; ai < 2; ++ai)
#pragma unroll
        for (int m = 0; m < 4; ++m) {
            float* rowp = base + (size_t)(row0 + ai * 128 + m * 16) * ld + col0;
#pragma unroll
            for (int bj = 0; bj < 2; ++bj) { *(f32x4*)(rowp + bj * 128) = acc[ai][bj][m][0]; *(f32x4*)(rowp + bj * 128 + 4) = acc[ai][bj][m][1]; }
        }
}

struct EpiIn {
    static constexpr bool PERM = true, AFTER_DRAIN = false;
    unsigned char* ws; const float *lbl, *alog, *dtb;
    __device__ __forceinline__ void operator()(const f32x4 (&acc)[2][2][4][2], const pg8::Unit& u, int wr, int wc, int fr, int fq) const {
        const int pn = u.pn, row0 = u.pm * 256 + wr * 64 + fr, cl = wc * 32 + 8 * fq;
        if (pn >= 8 && pn < 16) {
            const int c0 = (pn - 8) * 256 + cl;
            float lb[2][8];
#pragma unroll
            for (int bj = 0; bj < 2; ++bj)
#pragma unroll
                for (int j = 0; j < 8; ++j) { const int c = c0 + bj * 128 + j; lb[bj][j] = sigmoidf_(lbl[c] - lbl[2048 + c]); }
#pragma unroll
            for (int ai = 0; ai < 2; ++ai)
#pragma unroll
                for (int m = 0; m < 4; ++m) {
                    float* rowp = (float*)(ws + WS_F) + (size_t)(row0 + ai * 128 + m * 16) * 2048 + c0;
#pragma unroll
                    for (int bj = 0; bj < 2; ++bj) {
                        const f32x4 v0 = acc[ai][bj][m][0], v1 = acc[ai][bj][m][1]; f32x4 o0, o1;
#pragma unroll
                        for (int j = 0; j < 4; ++j) { o0[j] = lb[bj][j] + (1.f - lb[bj][j]) * sigmoidf_(v0[j]); o1[j] = lb[bj][4 + j] + (1.f - lb[bj][4 + j]) * sigmoidf_(v1[j]); }
                        *(f32x4*)(rowp + bj * 128) = o0; *(f32x4*)(rowp + bj * 128 + 4) = o1;
                    }
                }
            return;
        }
        if (pn == 96) {
            if (wc < 2) {
#pragma unroll
                for (int ai = 0; ai < 2; ++ai)
#pragma unroll
                    for (int m = 0; m < 4; ++m) {
                        float* rowp = (float*)(ws + WS_BL) + (size_t)(row0 + ai * 128 + m * 16) * 64 + cl;
                        const f32x4 v0 = acc[ai][0][m][0], v1 = acc[ai][0][m][1]; f32x4 o0, o1;
#pragma unroll
                        for (int j = 0; j < 4; ++j) {
                            if (wc == 0) { o0[j] = sigmoidf_(v0[j]); o1[j] = sigmoidf_(v1[j]); }
                            else { const int h0 = 8 * fq + j, h1 = 8 * fq + 4 + j; const float x0 = v0[j] + dtb[h0], x1 = v1[j] + dtb[h1];
                                   o0[j] = -expf(alog[h0]) * (fmaxf(x0, 0.f) + log1pf(expf(-fabsf(x0)))); o1[j] = -expf(alog[h1]) * (fmaxf(x1, 0.f) + log1pf(expf(-fabsf(x1)))); }
                        }
                        *(f32x4*)(rowp) = o0; *(f32x4*)(rowp + 4) = o1;
                    }
            }
            return;
        }
        size_t boff; int ld, c0, mode;
        if (pn < 8)       { boff = WS_QH; ld = 2048; c0 = pn * 256; mode = 1; }
        else if (pn < 24) { boff = WS_I;  ld = 2048; c0 = (pn - 16) * 256; mode = 0; }
        else if (pn < 32) { boff = WS_GH; ld = 2048; c0 = (pn - 24) * 256; mode = 1; }
        else if (pn < 64) { boff = WS_U;  ld = 8192; c0 = (pn - 32) * 256; mode = 0; }
        else if (pn < 80) { boff = WS_GZ; ld = 4096; c0 = (pn - 64) * 256; mode = 1; }
        else if (pn < 88) { boff = WS_SA; ld = 2048; c0 = (pn - 80) * 256; mode = 2; }
        else              { boff = WS_SB; ld = 2048; c0 = (pn - 88) * 256; mode = 2; }
        bf16* base = (bf16*)(ws + boff);
        if (mode == 0) tile_store_bf16<0>(acc, base, ld, row0, c0 + cl);
        else if (mode == 1) tile_store_bf16<1>(acc, base, ld, row0, c0 + cl);
        else tile_store_bf16<2>(acc, base, ld, row0, c0 + cl);
    }
};
struct EpiOut1 {
    static constexpr bool PERM = true, AFTER_DRAIN = false;
    float* T1; const bf16* SA;
    __device__ __forceinline__ void operator()(const f32x4 (&acc)[2][2][4][2], const pg8::Unit& u, int wr, int wc, int fr, int fq) const {
        const int row0 = u.pm * 256 + wr * 64 + fr, c0 = u.pn * 256 + wc * 32 + 8 * fq;
#pragma unroll
        for (int ai = 0; ai < 2; ++ai)
#pragma unroll
            for (int m = 0; m < 4; ++m) {
                const size_t ro = (size_t)(row0 + ai * 128 + m * 16) * 2048 + c0;
#pragma unroll
                for (int bj = 0; bj < 2; ++bj) {
                    const u32x4 s = *(const u32x4*)(SA + ro + bj * 128);
                    const f32x4 v0 = acc[ai][bj][m][0], v1 = acc[ai][bj][m][1];
                    f32x4 o0 = {v0[0] * bflo(s.x), v0[1] * bfhi(s.x), v0[2] * bflo(s.y), v0[3] * bfhi(s.y)};
                    f32x4 o1 = {v1[0] * bflo(s.z), v1[1] * bfhi(s.z), v1[2] * bflo(s.w), v1[3] * bfhi(s.w)};
                    *(f32x4*)(T1 + ro + bj * 128) = o0; *(f32x4*)(T1 + ro + bj * 128 + 4) = o1;
                }
            }
    }
};
struct EpiOut2 {
    static constexpr bool PERM = true, AFTER_DRAIN = false;
    const float* T1; const bf16* SB; bf16* MG;
    __device__ __forceinline__ void operator()(const f32x4 (&acc)[2][2][4][2], const pg8::Unit& u, int wr, int wc, int fr, int fq) const {
        const int row0 = u.pm * 256 + wr * 64 + fr, c0 = u.pn * 256 + wc * 32 + 8 * fq;
#pragma unroll
        for (int ai = 0; ai < 2; ++ai)
#pragma unroll
            for (int m = 0; m < 4; ++m) {
                const size_t ro = (size_t)(row0 + ai * 128 + m * 16) * 2048 + c0;
#pragma unroll
                for (int bj = 0; bj < 2; ++bj) {
                    const u32x4 s = *(const u32x4*)(SB + ro + bj * 128);
                    const f32x4 t0 = *(const f32x4*)(T1 + ro + bj * 128), t1 = *(const f32x4*)(T1 + ro + bj * 128 + 4);
                    const f32x4 v0 = acc[ai][bj][m][0], v1 = acc[ai][bj][m][1];
                    u32x4 w;
                    w.x = pk2(t0[0] + v0[0] * bflo(s.x), t0[1] + v0[1] * bfhi(s.x)); w.y = pk2(t0[2] + v0[2] * bflo(s.y), t0[3] + v0[3] * bfhi(s.y));
                    w.z = pk2(t1[0] + v1[0] * bflo(s.z), t1[1] + v1[1] * bfhi(s.z)); w.w = pk2(t1[2] + v1[2] * bflo(s.w), t1[3] + v1[3] * bfhi(s.w));
                    *(u32x4*)(MG + ro + bj * 128) = w;
                }
            }
    }
};
struct EpiF32 {
    static constexpr bool PERM = true, AFTER_DRAIN = false;
    float* O; int ld;
    __device__ __forceinline__ void operator()(const f32x4 (&acc)[2][2][4][2], const pg8::Unit& u, int wr, int wc, int fr, int fq) const {
        tile_store_f32(acc, O, ld, u.pm * 256 + wr * 64 + fr, u.pn * 256 + wc * 32 + 8 * fq);
    }
};
struct EpiRelu2 {
    static constexpr bool PERM = true, AFTER_DRAIN = false;
    bf16* O; int ld;
    __device__ __forceinline__ void operator()(const f32x4 (&acc)[2][2][4][2], const pg8::Unit& u, int wr, int wc, int fr, int fq) const {
        tile_store_bf16<3>(acc, O, ld, u.pm * 256 + wr * 64 + fr, u.pn * 256 + wc * 32 + 8 * fq);
    }
};

__device__ __forceinline__ void transpose_item(const float* W, int N, bf16* WT, int ldk, int k0, int n0, int nrow0, LAS float* scr, int lane) {
#pragma unroll 8
    for (int i = 0; i < 32; ++i) { const int kk = 2 * i + (lane >> 5); scr[kk * 33 + (lane & 31)] = W[(size_t)(k0 + kk) * N + n0 + (lane & 31)]; }
    LDS_WAIT(); asm volatile("" ::: "memory");
    const int c = lane & 7;
#pragma unroll
    for (int j = 0; j < 4; ++j) { const int n = (lane >> 3) + 8 * j; const LAS float* s = scr + (8 * c) * 33 + n;
        u32x4 o; o.x = pk2(s[0 * 33], s[1 * 33]); o.y = pk2(s[2 * 33], s[3 * 33]); o.z = pk2(s[4 * 33], s[5 * 33]); o.w = pk2(s[6 * 33], s[7 * 33]);
        *(u32x4*)(WT + (size_t)(nrow0 + n) * ldk + k0 + 8 * c) = o; }
    LDS_WAIT(); asm volatile("" ::: "memory");
}
__device__ __forceinline__ void mod_item(const PA& a, LAS unsigned char* lds, int cb, int tid, int wid, int lane) {
    constexpr int AST = 264;
    LAS bf16* As = (LAS bf16*)lds;
    const float* cp = a.in(I_CP); const float* cs = a.in(I_CS); const float* W = a.in(I_WADA); const float* bada = a.in(I_BADA);
    float* mod = (float*)(a.ws() + WS_MOD);
    const int nt = wid & 3, mh = wid >> 2, fr = lane & 15, fq = lane >> 4, n = cb * 64 + nt * 16 + fr;
    f32x4 acc[5];
#pragma unroll
    for (int i = 0; i < 5; ++i) acc[i] = (f32x4){0.f, 0.f, 0.f, 0.f};
    for (int kc = 0; kc < 8; ++kc) {
        __syncthreads();
        for (int e = tid; e < 144 * 64; e += NTHREADS) {
            const int s = e >> 6, q = e & 63; u32x2 w = {0u, 0u};
            if (s < NSEQ) { const float* src = (s < 4 ? cp + (size_t)s * 2048 : cs + (size_t)(s - 4) * 2048) + kc * 256 + q * 4; const f32x4 x = *(const f32x4*)src;
                w.x = pk2(siluf_(x[0]), siluf_(x[1])); w.y = pk2(siluf_(x[2]), siluf_(x[3])); }
            *(LAS u32x2*)(As + s * AST + q * 4) = w;
        }
        __syncthreads();
#pragma unroll 2
        for (int ks = 0; ks < 8; ++ks) {
            const int k0 = kc * 256 + ks * 32 + 8 * fq;
            bf16x8 b;
#pragma unroll
            for (int j = 0; j < 8; ++j) b[j] = (short)f2bf(W[(size_t)(k0 + j) * NADA + n]);
#pragma unroll
            for (int i = 0; i < 5; ++i) {
                const int mt = mh * 5 + i;
                if (mt < 9) { const bf16x8 av = *(const LAS bf16x8*)(As + (mt * 16 + fr) * AST + ks * 32 + 8 * fq);
                    acc[i] = __builtin_amdgcn_mfma_f32_16x16x32_bf16(av, b, acc[i], 0, 0, 0); }
            }
        }
    }
    const float bb = bada[n];
#pragma unroll
    for (int i = 0; i < 5; ++i)
#pragma unroll
        for (int r = 0; r < 4; ++r) { const int s = (mh * 5 + i) * 16 + 4 * fq + r; if (s < NSEQ) mod[(size_t)s * NADA + n] = acc[i][r] + bb; }
}

__device__ __forceinline__ const float* xrow_ptr(const PA& a, int row) { return row < NPROMPT ? a.in(I_XP) + (size_t)row * DM : a.in(I_XS) + (size_t)(row - NPROMPT) * DM; }
__device__ __forceinline__ int seq_of_row(int row) { return row < NPROMPT ? (row >> 11) : 4 + ((row - NPROMPT) >> 2); }

__device__ __forceinline__ void hgrn_item(const PA& a, LAS float* wl, int grp, int b, int h, int half, int lane) {
    const bf16* Qh = (const bf16*)(a.ws() + WS_QH); const float* F = (const float*)(a.ws() + WS_F); const bf16* Ih = (const bf16*)(a.ws() + WS_I);
    float* O32 = (float*)(a.ws() + WS_O32);
    const int T = grp ? DSEQ : SEQ, row0 = grp ? NPROMPT + b * DSEQ : b * SEQ, dv = half * 64 + lane;
    unsigned sidx = (unsigned)((b * 16 + h) * 128) * 128u + dv;
    float S[128];
    if (grp) { const float* s0 = a.in(I_SHG); unsigned so_ = sidx; asm volatile("" : "+v"(so_));
#pragma unroll
        for (int d8 = 0; d8 < 16; ++d8) {
#pragma unroll
            for (int j = 0; j < 8; ++j) S[d8 * 8 + j] = s0[so_ + j * 128];
            so_ += 1024; asm volatile("" : "+v"(so_)); } }
    else {
#pragma unroll
        for (int d = 0; d < 128; ++d) S[d] = 0.f; }
    LAS float* qs = wl; LAS float* fs = wl + 128;
    unsigned ro = (unsigned)row0 * 2048u + h * 128 + lane;
    unsigned oo = (unsigned)row0 * 6144u + h * 128 + dv;
    float nq0 = bf2f(Qh[ro]), nq1 = bf2f(Qh[ro + 64]), nf0 = F[ro], nf1 = F[ro + 64], niv = bf2f(Ih[ro + half * 64]);
#pragma unroll 1
    for (int t = 0; t < T; ++t) {
        const float q0 = nq0, q1 = nq1, f0 = nf0, f1 = nf1, iv = niv;
        if (t + 1 < T) { const unsigned rn = ro + 2048; nq0 = bf2f(Qh[rn]); nq1 = bf2f(Qh[rn + 64]); nf0 = F[rn]; nf1 = F[rn + 64]; niv = bf2f(Ih[rn + half * 64]); }
        qs[lane] = q0; qs[64 + lane] = q1; fs[lane] = f0; fs[64 + lane] = f1;
        float o0 = 0.f, o1 = 0.f, o2 = 0.f, o3 = 0.f;
#pragma unroll
        for (int d4 = 0; d4 < 32; ++d4) {
            const f32x4 q4 = *(const LAS f32x4*)(qs + 4 * d4), f4 = *(const LAS f32x4*)(fs + 4 * d4);
            S[4 * d4 + 0] = fmaf(f4[0], S[4 * d4 + 0] - iv, iv); o0 = fmaf(q4[0], S[4 * d4 + 0], o0);
            S[4 * d4 + 1] = fmaf(f4[1], S[4 * d4 + 1] - iv, iv); o1 = fmaf(q4[1], S[4 * d4 + 1], o1);
            S[4 * d4 + 2] = fmaf(f4[2], S[4 * d4 + 2] - iv, iv); o2 = fmaf(q4[2], S[4 * d4 + 2], o2);
            S[4 * d4 + 3] = fmaf(f4[3], S[4 * d4 + 3] - iv, iv); o3 = fmaf(q4[3], S[4 * d4 + 3], o3);
            if ((d4 & 1) == 1) asm volatile("" ::: "memory");
        }
        O32[oo] = (o0 + o1) + (o2 + o3);
        ro += 2048; oo += 6144;
    }
    float* so = a.out() + (grp ? O_HGS : O_HGP); asm volatile("" : "+v"(sidx));
#pragma unroll
    for (int d8 = 0; d8 < 16; ++d8) {
#pragma unroll
        for (int j = 0; j < 8; ++j) so[sidx + j * 128] = S[d8 * 8 + j];
        sidx += 1024; asm volatile("" : "+v"(sidx)); }
}
__device__ __forceinline__ void gdn_item(const PA& a, LAS float* wl, int grp, int b, int vh, int half, int lane) {
    const bf16* UC = (const bf16*)(a.ws() + WS_UC); const float* BL = (const float*)(a.ws() + WS_BL);
    float* O32 = (float*)(a.ws() + WS_O32);
    const int T = grp ? DSEQ : SEQ, row0 = grp ? NPROMPT + b * DSEQ : b * SEQ, dv = half * 64 + lane, qh = vh >> 1;
    unsigned sidx = (unsigned)((b * 32 + vh) * 128) * 128u + dv;
    float S[128];
    if (grp) { const float* s0 = a.in(I_SGD); unsigned so_ = sidx; asm volatile("" : "+v"(so_));
#pragma unroll
        for (int d8 = 0; d8 < 16; ++d8) {
#pragma unroll
            for (int j = 0; j < 8; ++j) S[d8 * 8 + j] = s0[so_ + j * 128];
            so_ += 1024; asm volatile("" : "+v"(so_)); } }
    else {
#pragma unroll
        for (int d = 0; d < 128; ++d) S[d] = 0.f; }
    LAS float* qs = wl; LAS float* ks = wl + 128;
    unsigned ro = (unsigned)row0 * 8192u + qh * 128 + lane, rv = (unsigned)row0 * 8192u + 4096 + vh * 128 + dv, rb = (unsigned)row0 * 64u + vh;
    unsigned oo = (unsigned)row0 * 6144u + 2048 + vh * 128 + dv;
    float nq0 = bf2f(UC[ro]), nq1 = bf2f(UC[ro + 64]), nk0 = bf2f(UC[ro + 2048]), nk1 = bf2f(UC[ro + 2048 + 64]);
    float nv = bf2f(UC[rv]), nbeta = BL[rb], nla = BL[rb + 32];
#pragma unroll 1
    for (int t = 0; t < T; ++t) {
        const float q0 = nq0, q1 = nq1, k0 = nk0, k1 = nk1, vv = nv, beta = nbeta, al = __expf(nla);
        if (t + 1 < T) { const unsigned rn = ro + 8192, rvn = rv + 8192, rbn = rb + 64;
            nq0 = bf2f(UC[rn]); nq1 = bf2f(UC[rn + 64]); nk0 = bf2f(UC[rn + 2048]); nk1 = bf2f(UC[rn + 2048 + 64]);
            nv = bf2f(UC[rvn]); nbeta = BL[rbn]; nla = BL[rbn + 32]; }
        qs[lane] = q0; qs[64 + lane] = q1; ks[lane] = k0; ks[64 + lane] = k1;
        const float qk = wave_sum(q0 * k0 + q1 * k1);
        float c0 = 0.f, c1 = 0.f, c2 = 0.f, c3 = 0.f, o0 = 0.f, o1 = 0.f, o2 = 0.f, o3 = 0.f;
#pragma unroll
        for (int d4 = 0; d4 < 32; ++d4) {
            const f32x4 k4 = *(const LAS f32x4*)(ks + 4 * d4), q4 = *(const LAS f32x4*)(qs + 4 * d4);
            c0 = fmaf(k4[0], S[4 * d4 + 0], c0); c1 = fmaf(k4[1], S[4 * d4 + 1], c1); c2 = fmaf(k4[2], S[4 * d4 + 2], c2); c3 = fmaf(k4[3], S[4 * d4 + 3], c3);
            o0 = fmaf(q4[0], S[4 * d4 + 0], o0); o1 = fmaf(q4[1], S[4 * d4 + 1], o1); o2 = fmaf(q4[2], S[4 * d4 + 2], o2); o3 = fmaf(q4[3], S[4 * d4 + 3], o3);
            if ((d4 & 1) == 1) asm volatile("" ::: "memory");
        }
        const float kS = (c0 + c1) + (c2 + c3), qS = (o0 + o1) + (o2 + o3);
        const float dlt = beta * (vv - al * kS);
#pragma unroll
        for (int d4 = 0; d4 < 32; ++d4) {
            const f32x4 k4 = *(const LAS f32x4*)(ks + 4 * d4);
            S[4 * d4 + 0] = fmaf(k4[0], dlt, al * S[4 * d4 + 0]); S[4 * d4 + 1] = fmaf(k4[1], dlt, al * S[4 * d4 + 1]);
            S[4 * d4 + 2] = fmaf(k4[2], dlt, al * S[4 * d4 + 2]); S[4 * d4 + 3] = fmaf(k4[3], dlt, al * S[4 * d4 + 3]);
            if ((d4 & 1) == 1) asm volatile("" ::: "memory");
        }
        O32[oo] = fmaf(al, qS, qk * dlt);
        ro += 8192; rv += 8192; rb += 64; oo += 6144;
    }
    float* so = a.out() + (grp ? O_GDS : O_GDP); asm volatile("" : "+v"(sidx));
#pragma unroll
    for (int d8 = 0; d8 < 16; ++d8) {
#pragma unroll
        for (int j = 0; j < 8; ++j) so[sidx + j * 128] = S[d8 * 8 + j];
        sidx += 1024; asm volatile("" : "+v"(sidx)); }
}

#define XB_TMO      128
#define XB_XCNT(j)  (256  + 64 * (j))
#define XB_XSUB(j)  (1280 + 64 * (j))
#define XB_XGEN(j)  (2304 + 64 * (j))
#define XB_TOP      3328
#define XB_TOPGEN   3392
#define XCD_BAR_WORDS 3456
#define XB_SPIN_CAP (1u << 18)
__device__ __forceinline__ unsigned xb_ld(unsigned* p)              { return __hip_atomic_load(p, __ATOMIC_RELAXED, __HIP_MEMORY_SCOPE_AGENT); }
__device__ __forceinline__ unsigned xb_add(unsigned* p, unsigned v) { return __hip_atomic_fetch_add(p, v, __ATOMIC_RELAXED, __HIP_MEMORY_SCOPE_AGENT); }
__device__ __forceinline__ unsigned xb_xcc_id() { return (unsigned)__builtin_amdgcn_s_getreg((3 << 11) | 20) & 0xFu; }
#define XB_SPIN(cond, bar) do { unsigned _sp = 0; while (cond) { __builtin_amdgcn_s_sleep(1); \
    if ((++_sp & 255u) == 0u) { if (xb_ld(&(bar)[XB_TMO])) break; if (_sp > XB_SPIN_CAP) { atomicAdd(&(bar)[XB_TMO], 1u); break; } } } } while (0)
__device__ __forceinline__ void xcd_barrier_complete(unsigned* bar, unsigned x, unsigned G, unsigned& nloc, unsigned& nx) {
    unsigned sum, cnt, mine, sp = 0u;
    for (;;) {
        sum = 0u; cnt = 0u; mine = 0u;
#pragma unroll
        for (unsigned j = 0; j < 16; ++j) { const unsigned c = xb_ld(&bar[XB_XCNT(j)]); sum += c; cnt += (c > 0u) ? 1u : 0u; mine = (j == x) ? c : mine; }
        if (sum == G) break;
        __builtin_amdgcn_s_sleep(1);
        if ((++sp & 255u) == 0u) { if (xb_ld(&bar[XB_TMO])) break; if (sp > XB_SPIN_CAP) { atomicAdd(&bar[XB_TMO], 1u); break; } }
    }
    nloc = mine > 0u ? mine : 1u; nx = cnt > 0u ? cnt : 1u;
}
__device__ __forceinline__ void xcd_barrier(unsigned* bar, unsigned x, volatile LAS unsigned* st, int tid, unsigned G) {
    asm volatile("s_waitcnt vmcnt(0)" ::: "memory");
    __syncthreads();
    if (tid == 0) {
        __builtin_amdgcn_s_waitcnt(0);
        unsigned nloc = st[0], nx = st[1];
        if (nloc == 0u) { xcd_barrier_complete(bar, x, G, nloc, nx); st[0] = nloc; st[1] = nx; }
        const unsigned old = xb_add(&bar[XB_XSUB(x)], 1u);
        const unsigned gen = old / nloc;
        if (old + 1u == (gen + 1u) * nloc) {
            __builtin_amdgcn_fence(__ATOMIC_RELEASE, "agent");
            asm volatile("s_waitcnt vmcnt(0)" ::: "memory");
            const unsigned og = xb_add(&bar[XB_TOP], 1u);
            const unsigned tg = og / nx;
            if (og + 1u == (tg + 1u) * nx) xb_add(&bar[XB_TOPGEN], 1u);
            else XB_SPIN(xb_ld(&bar[XB_TOPGEN]) == tg, bar);
            __builtin_amdgcn_fence(__ATOMIC_ACQUIRE, "agent");
            xb_add(&bar[XB_XGEN(x)], 1u);
            asm volatile("s_waitcnt vmcnt(0)" ::: "memory");
        } else {
            XB_SPIN(xb_ld(&bar[XB_XGEN(x)]) == gen, bar);
            __builtin_amdgcn_fence(__ATOMIC_ACQUIRE, "agent");
            asm volatile("s_waitcnt vmcnt(0)" ::: "memory");
        }
    }
    __syncthreads();
}
constexpr int CW_BAR = 4096;
constexpr size_t CTL_ZERO_BYTES = 65536;
constexpr int LDS_ST_OFF = 131072 + 512;

__global__ void __launch_bounds__(NTHREADS, 2) fwd(Args args_unused) {
    extern __shared__ __attribute__((aligned(16))) unsigned char lds_raw[];
    LAS unsigned char* lds = (LAS unsigned char*)lds_raw;
    const int wid = __builtin_amdgcn_readfirstlane(threadIdx.x >> 6);
    const int G = gridDim.x, bx = blockIdx.x;
    const int vcu = (G % 8 == 0) ? (bx % 8) * (G / 8) + bx / 8 : bx;
    const int gw = vcu * NWAVES + wid, NGW = G * NWAVES;
    volatile LAS unsigned* bst = (volatile LAS unsigned*)(lds + LDS_ST_OFF);
    const unsigned xcc = xb_xcc_id();
    { const PA a0 = PA::get(); const int l0 = lane_id_(); if (wid == 0 && l0 < 2) bst[l0] = 0u;
      if (a0.ph_hi() - a0.ph_lo() > 1 && wid == 0 && l0 == 0) (void)xb_add((unsigned*)a0.ws() + CW_BAR + XB_XCNT(xcc), 1u); }
    __syncthreads();
#ifndef PH_MASK
#define PH_MASK 0xffff
#endif
#define IN(k) (((PH_MASK >> (k)) & 1) && ph_in(k))
#define SEAM(k) do { if (IN(k) && IN((k) + 1)) { if ((k) == 0) cg::this_grid().sync(); \
    else { const PA ab = PA::get(); xcd_barrier((unsigned*)ab.ws() + CW_BAR, xcc, bst, wid * 64 + lane_id_(), (unsigned)G); } } } while (0)

    if (IN(0)) { const PA a = PA::get(); unsigned char* ws = a.ws(); const int lane = lane_id_(), tid = wid * 64 + lane; (void)tid;
        for (int cb = vcu; cb < NADA / 64; cb += G) mod_item(a, lds, cb, tid, wid, lane);
        __syncthreads();
        LAS float* scr = (LAS float*)(lds + wid * 16384);
        constexpr int I0 = 32 * 770, I1 = 32 * 64, I2 = 64 * 64, I3 = 32 * 64, I4 = 32 * 256, I5 = 128 * 64, NIT = I0 + I1 + I2 + I3 + I4 + I5;
        bf16* BtIn = (bf16*)(ws + WS_BTIN); bf16* BtOut = (bf16*)(ws + WS_BTOUT); bf16* BtO = (bf16*)(ws + WS_BTO); bf16* BtUp = (bf16*)(ws + WS_BTUP); bf16* BtDn = (bf16*)(ws + WS_BTDN);
        for (int it = gw; it < NIT; it += NGW) {
            int r = it;
            if (r < I0) { const int kb = r / 770, nb = r % 770, n0 = nb * 32; const int nd = n0 < 20480 ? n0 : (n0 < 20544 ? n0 - 20480 + 24576 : n0 - 64);
                transpose_item(a.in(I_WIN), N_IN, BtIn, 2048, kb * 64, n0, nd, scr, lane); continue; } r -= I0;
            if (r < I1) { transpose_item(a.in(I_WOHG), 2048, BtOut, 6144, (r / 64) * 64, (r % 64) * 32, (r % 64) * 32, scr, lane); continue; } r -= I1;
            if (r < I2) { transpose_item(a.in(I_WOGD), 2048, BtOut + 2048, 6144, (r / 64) * 64, (r % 64) * 32, (r % 64) * 32, scr, lane); continue; } r -= I2;
            if (r < I3) { transpose_item(a.in(I_WO), 2048, BtO, 2048, (r / 64) * 64, (r % 64) * 32, (r % 64) * 32, scr, lane); continue; } r -= I3;
            if (r < I4) { transpose_item(a.in(I_WUP), 8192, BtUp, 2048, (r / 256) * 64, (r % 256) * 32, (r % 256) * 32, scr, lane); continue; } r -= I4;
            transpose_item(a.in(I_WDN), 2048, BtDn, 8192, (r / 64) * 64, (r % 64) * 32, (r % 64) * 32, scr, lane);
        }
        { u32x4* z = (u32x4*)(BtIn + (size_t)N_IN * 2048); const int nz = (N_INP - N_IN) * 2048 * 2 / 16;
          for (int i = vcu * NTHREADS + tid; i < nz; i += G * NTHREADS) z[i] = (u32x4){0u, 0u, 0u, 0u}; }
    }
    SEAM(0);
    if (IN(1)) { const PA a = PA::get(); unsigned char* ws = a.ws(); const int lane = lane_id_(), tid = wid * 64 + lane; (void)tid;
        const float* mod = (const float*)(ws + WS_MOD); const float* ng = a.in(I_NG); bf16* A1 = (bf16*)(ws + WS_A1);
        for (int row = gw; row < MROWS; row += NGW) {
            const f32x4* xr = (const f32x4*)xrow_ptr(a, row) + lane; const float* md = mod + (size_t)seq_of_row(row) * NADA;
            f32x4 v[8]; float ss = 0.f;
#pragma unroll
            for (int j = 0; j < 8; ++j) { v[j] = xr[64 * j]; ss += (v[j][0] * v[j][0] + v[j][1] * v[j][1]) + (v[j][2] * v[j][2] + v[j][3] * v[j][3]); }
            const float r = rsqrtf(wave_sum(ss) * (1.f / DM) + EPS);
            u32x2* o = (u32x2*)(A1 + (size_t)row * DM) + lane;
#pragma unroll
            for (int j = 0; j < 8; ++j) { const int c = 4 * lane + 256 * j; const f32x4 g = *(const f32x4*)(ng + c), sh = *(const f32x4*)(md + c), sc = *(const f32x4*)(md + 2048 + c);
                f32x4 y; _Pragma("unroll") for (int e = 0; e < 4; ++e) y[e] = v[j][e] * r * g[e] * (1.f + sc[e]) + sh[e];
                o[64 * j] = (u32x2){pk2(y[0], y[1]), pk2(y[2], y[3])}; }
        }
    }
    SEAM(1);
    if (IN(2)) { const PA a = PA::get(); unsigned char* ws = a.ws(); const int lane = lane_id_(), tid = wid * 64 + lane; (void)tid;
        pg8::Gemm g{(const bf16*)(ws + WS_A1), (const bf16*)(ws + WS_BTIN), 2048, 2048, 2048}; pg8::StaticOrder S; S.init(MROWS, N_INP, G, bx);
        EpiIn E{ws, a.in(I_LB), a.in(I_ALOG), a.in(I_DTB)};
        pg8::gemm_phase<EpiIn, pg8::StaticOrder, true, true>(lds, g, S, E, wid);
    }
    SEAM(2);
    if (IN(3)) { const PA a = PA::get(); unsigned char* ws = a.ws(); const int lane = lane_id_(), tid = wid * 64 + lane; (void)tid;
        const bf16* U = (const bf16*)(ws + WS_U); bf16* UC = (bf16*)(ws + WS_UC); const float* cw = a.in(I_CW); const float* cc = a.in(I_CC);
        for (int it = gw; it < MROWS * 64; it += NGW) {
            const int row = it >> 6, g = it & 63, c = g * 128 + 2 * lane;
            const bool samp = row >= NPROMPT; const int t = samp ? (row - NPROMPT) & 3 : row & 2047;
            float x0 = 0.f, x1 = 0.f;
#pragma unroll
            for (int j = 0; j < 4; ++j) {
                const int tt = t - 3 + j; float u0 = 0.f, u1 = 0.f;
                if (tt >= 0) { const unsigned w = *(const unsigned*)(U + (size_t)(row - 3 + j) * CONVCH + c); u0 = bflo(w); u1 = bfhi(w); }
                else if (samp) { const int b = (row - NPROMPT) >> 2; const f32x2 w = *(const f32x2*)(cc + ((size_t)b * 3 + (3 + tt)) * CONVCH + c); u0 = w[0]; u1 = w[1]; }
                const f32x2 wj = *(const f32x2*)(cw + (size_t)j * CONVCH + c);
                x0 = fmaf(wj[0], u0, x0); x1 = fmaf(wj[1], u1, x1);
            }
            x0 = siluf_(x0); x1 = siluf_(x1);
            if (g < 32) { const float ss = wave_sum(x0 * x0 + x1 * x1); float r = rsqrtf(ss + EPS); if (g < 16) r *= 0.08838834764831845f; x0 *= r; x1 *= r; }
            *(unsigned*)(UC + (size_t)row * CONVCH + c) = pk2(x0, x1);
        }
        for (int i = vcu * NTHREADS + tid; i < (12 + 384) * (CONVCH / 2); i += G * NTHREADS) {
            const int rr = i / (CONVCH / 2), c = (i % (CONVCH / 2)) * 2; int srow; float* dst;
            if (rr < 12) { const int b = rr / 3, j = rr % 3; srow = b * SEQ + SEQ - 3 + j; dst = a.out() + O_CCP + (size_t)rr * CONVCH + c; }
            else { const int r2 = rr - 12, b = r2 / 3, j = r2 % 3; srow = NPROMPT + b * DSEQ + 1 + j; dst = a.out() + O_CCS + (size_t)r2 * CONVCH + c; }
            const unsigned w = *(const unsigned*)(U + (size_t)srow * CONVCH + c);
            *(f32x2*)dst = (f32x2){bflo(w), bfhi(w)};
        }
    }
    SEAM(3);
    if (IN(4)) { const PA a = PA::get(); unsigned char* ws = a.ws(); const int lane = lane_id_(), tid = wid * 64 + lane; (void)tid;
        LAS float* wl = (LAS float*)(lds + wid * 4096);
        constexpr int NI_HP = 128, NI_GP = 256, NI_HS = 4096, NI_GS = 8192, NI = NI_HP + NI_GP + NI_HS + NI_GS;
        for (int it = wid * G + bx; it < NI; it += NGW) {
            int r = it, kind, grp;
            if (r < NI_HP) { kind = 0; grp = 0; } else if ((r -= NI_HP) < NI_GP) { kind = 1; grp = 0; } else if ((r -= NI_GP) < NI_HS) { kind = 0; grp = 1; } else { r -= NI_HS; kind = 1; grp = 1; }
            if (kind == 0) hgrn_item(a, wl, grp, r >> 5, (r >> 1) & 15, r & 1, lane);
            else gdn_item(a, wl, grp, r >> 6, (r >> 1) & 31, r & 1, lane);
        }
    }
    SEAM(4);
    if (IN(5)) { const PA a = PA::get(); unsigned char* ws = a.ws(); const int lane = lane_id_(), tid = wid * 64 + lane; (void)tid;
        const float* O32 = (const float*)(ws + WS_O32); bf16* OA = (bf16*)(ws + WS_OA); const bf16* Gh = (const bf16*)(ws + WS_GH); const bf16* Gz = (const bf16*)(ws + WS_GZ);
        for (int it = gw; it < MROWS * 48; it += NGW) {
            const int row = it / 48, hd = it % 48; const size_t co = (size_t)row * 6144 + hd * 128 + 2 * lane;
            const f32x2 o = *(const f32x2*)(O32 + co);
            const float r = rsqrtf(wave_sum(o[0] * o[0] + o[1] * o[1]) * (1.f / 128.f) + EPS);
            const f32x2 g = *(const f32x2*)((hd < 16 ? a.in(I_HGN) : a.in(I_GDN)) + 2 * lane);
            const unsigned gt = hd < 16 ? *(const unsigned*)(Gh + (size_t)row * 2048 + hd * 128 + 2 * lane) : *(const unsigned*)(Gz + (size_t)row * 4096 + (hd - 16) * 128 + 2 * lane);
            *(unsigned*)(OA + co) = pk2(o[0] * r * g[0] * bflo(gt), o[1] * r * g[1] * bfhi(gt));
        }
    }
    SEAM(5);
    if (IN(6)) { const PA a = PA::get(); unsigned char* ws = a.ws(); const int lane = lane_id_(), tid = wid * 64 + lane; (void)tid;
        pg8::Gemm g{(const bf16*)(ws + WS_OA), (const bf16*)(ws + WS_BTOUT), 6144, 6144, 2048}; pg8::StaticOrder S; S.init(MROWS, 2048, G, bx);
        EpiOut1 E{(float*)(ws + WS_T1), (const bf16*)(ws + WS_SA)};
        pg8::gemm_phase<EpiOut1, pg8::StaticOrder, true, true>(lds, g, S, E, wid);
    }
    SEAM(6);
    if (IN(7)) { const PA a = PA::get(); unsigned char* ws = a.ws(); const int lane = lane_id_(), tid = wid * 64 + lane; (void)tid;
        pg8::Gemm g{(const bf16*)(ws + WS_OA) + 2048, (const bf16*)(ws + WS_BTOUT) + 2048, 6144, 6144, 4096}; pg8::StaticOrder S; S.init(MROWS, 2048, G, bx);
        EpiOut2 E{(const float*)(ws + WS_T1), (const bf16*)(ws + WS_SB), (bf16*)(ws + WS_MG)};
        pg8::gemm_phase<EpiOut2, pg8::StaticOrder, true, true>(lds, g, S, E, wid);
    }
    SEAM(7);
    if (IN(8)) { const PA a = PA::get(); unsigned char* ws = a.ws(); const int lane = lane_id_(), tid = wid * 64 + lane; (void)tid;
        pg8::Gemm g{(const bf16*)(ws + WS_MG), (const bf16*)(ws + WS_BTO), 2048, 2048, 2048}; pg8::StaticOrder S; S.init(MROWS, 2048, G, bx);
        EpiF32 E{(float*)(ws + WS_MIX), 2048};
        pg8::gemm_phase<EpiF32, pg8::StaticOrder, true, true>(lds, g, S, E, wid);
    }
    SEAM(8);
    if (IN(9)) { const PA a = PA::get(); unsigned char* ws = a.ws(); const int lane = lane_id_(), tid = wid * 64 + lane; (void)tid;
        const float* mod = (const float*)(ws + WS_MOD); const float* ng = a.in(I_NG); bf16* A1 = (bf16*)(ws + WS_A1); const float* MIX = (const float*)(ws + WS_MIX); float* H = (float*)(ws + WS_H);
        for (int row = gw; row < MROWS; row += NGW) {
            const f32x4* xr = (const f32x4*)xrow_ptr(a, row) + lane; const f32x4* mr = (const f32x4*)(MIX + (size_t)row * DM) + lane; const float* md = mod + (size_t)seq_of_row(row) * NADA;
            f32x4 v[8]; float ss = 0.f;
#pragma unroll
            for (int j = 0; j < 8; ++j) { v[j] = mr[64 * j]; ss += (v[j][0] * v[j][0] + v[j][1] * v[j][1]) + (v[j][2] * v[j][2] + v[j][3] * v[j][3]); }
            const float r1 = rsqrtf(wave_sum(ss) * (1.f / DM) + EPS);
            f32x4* ho = (f32x4*)(H + (size_t)row * DM) + lane; float s2 = 0.f;
#pragma unroll
            for (int j = 0; j < 8; ++j) { const int c = 4 * lane + 256 * j; const f32x4 g = *(const f32x4*)(ng + 2048 + c), g1 = *(const f32x4*)(md + 4096 + c), x = xr[64 * j];
                _Pragma("unroll") for (int e = 0; e < 4; ++e) { v[j][e] = x[e] + g1[e] * (v[j][e] * r1 * g[e]); s2 += v[j][e] * v[j][e]; }
                ho[64 * j] = v[j]; }
            const float r2 = rsqrtf(wave_sum(s2) * (1.f / DM) + EPS);
            u32x2* o = (u32x2*)(A1 + (size_t)row * DM) + lane;
#pragma unroll
            for (int j = 0; j < 8; ++j) { const int c = 4 * lane + 256 * j; const f32x4 g = *(const f32x4*)(ng + 4096 + c), sh = *(const f32x4*)(md + 6144 + c), sc = *(const f32x4*)(md + 8192 + c);
                f32x4 y; _Pragma("unroll") for (int e = 0; e < 4; ++e) y[e] = v[j][e] * r2 * g[e] * (1.f + sc[e]) + sh[e];
                o[64 * j] = (u32x2){pk2(y[0], y[1]), pk2(y[2], y[3])}; }
        }
    }
    SEAM(9);
    if (IN(10)) { const PA a = PA::get(); unsigned char* ws = a.ws(); const int lane = lane_id_(), tid = wid * 64 + lane; (void)tid;
        pg8::Gemm g{(const bf16*)(ws + WS_A1), (const bf16*)(ws + WS_BTUP), 2048, 2048, 2048}; pg8::StaticOrder S; S.init(MROWS, DFF, G, bx);
        EpiRelu2 E{(bf16*)(ws + WS_U2), DFF};
        pg8::gemm_phase<EpiRelu2, pg8::StaticOrder, true, true>(lds, g, S, E, wid);
    }
    SEAM(10);
    if (IN(11)) { const PA a = PA::get(); unsigned char* ws = a.ws(); const int lane = lane_id_(), tid = wid * 64 + lane; (void)tid;
        pg8::Gemm g{(const bf16*)(ws + WS_U2), (const bf16*)(ws + WS_BTDN), DFF, DFF, DFF}; pg8::StaticOrder S; S.init(MROWS, 2048, G, bx);
        EpiF32 E{(float*)(ws + WS_FF), 2048};
        pg8::gemm_phase<EpiF32, pg8::StaticOrder, true, true>(lds, g, S, E, wid);
    }
    SEAM(11);
    if (IN(12)) { const PA a = PA::get(); unsigned char* ws = a.ws(); const int lane = lane_id_(), tid = wid * 64 + lane; (void)tid;
        const float* mod = (const float*)(ws + WS_MOD); const float* ng = a.in(I_NG); const float* FF = (const float*)(ws + WS_FF); const float* H = (const float*)(ws + WS_H);
        for (int row = gw; row < MROWS; row += NGW) {
            const f32x4* fr_ = (const f32x4*)(FF + (size_t)row * DM) + lane; const f32x4* hr = (const f32x4*)(H + (size_t)row * DM) + lane; const float* md = mod + (size_t)seq_of_row(row) * NADA;
            f32x4 v[8]; float ss = 0.f;
#pragma unroll
            for (int j = 0; j < 8; ++j) { v[j] = fr_[64 * j]; ss += (v[j][0] * v[j][0] + v[j][1] * v[j][1]) + (v[j][2] * v[j][2] + v[j][3] * v[j][3]); }
            const float r = rsqrtf(wave_sum(ss) * (1.f / DM) + EPS);
            f32x4* yo = (f32x4*)(a.out() + O_Y + (size_t)row * DM) + lane;
#pragma unroll
            for (int j = 0; j < 8; ++j) { const int c = 4 * lane + 256 * j; const f32x4 g = *(const f32x4*)(ng + 6144 + c), g2 = *(const f32x4*)(md + 10240 + c), h = hr[64 * j];
                f32x4 y; _Pragma("unroll") for (int e = 0; e < 4; ++e) y[e] = h[e] + g2[e] * (v[j][e] * r * g[e]);
                yo[64 * j] = y; }
        }
    }
#undef IN
#undef SEAM
}

constexpr int N_PHASES = 13;
extern "C" void kernel_launch(void* const* d_in, const int* in_sizes, int n_in, void* d_out, int out_size, void* d_ws, size_t ws_size, hipStream_t stream) {
    static int grid = 0;
    if (grid == 0) {
        if (n_in != 22 || (size_t)out_size != O_END || ws_size < WS_END) { fprintf(stderr, "kernel_launch: unexpected shapes: n_in %d out %d ws %zu\n", n_in, out_size, ws_size); grid = -1; return; }
        int dev = 0, cus = 0, per_cu = 0;
        if (hipGetDevice(&dev) != hipSuccess || hipDeviceGetAttribute(&cus, hipDeviceAttributeMultiprocessorCount, dev) != hipSuccess) { grid = -1; return; }
        if (hipFuncSetAttribute((const void*)fwd, hipFuncAttributeMaxDynamicSharedMemorySize, LDS_BYTES) != hipSuccess) { fprintf(stderr, "kernel_launch: hipFuncSetAttribute failed\n"); grid = -1; return; }
        if (hipOccupancyMaxActiveBlocksPerMultiprocessor(&per_cu, (const void*)fwd, NTHREADS, LDS_BYTES) != hipSuccess || per_cu < 1) { fprintf(stderr, "kernel_launch: occupancy query says %d\n", per_cu); (void)hipGetLastError(); per_cu = 1; }
        grid = cus;
    }
    if (grid < 0) return;
    if (hipMemsetAsync(d_ws, 0, CTL_ZERO_BYTES, stream) != hipSuccess) { fprintf(stderr, "kernel_launch: memset failed\n"); return; }
    Args a{};
    for (int i = 0; i < 22; ++i) a.in[i] = (const float*)d_in[i];
    a.out = (float*)d_out; a.ws = (unsigned char*)d_ws;
#ifndef ONE_LAUNCH
    for (int p = 0; p < N_PHASES; ++p) { a.ph_lo = p; a.ph_hi = p + 1; hipLaunchKernelGGL(fwd, dim3(grid), dim3(NTHREADS), LDS_BYTES, stream, a); }
#else
    a.ph_lo = 0; a.ph_hi = N_PHASES;
    void* args[] = {&a};
    hipError_t e = hipLaunchCooperativeKernel((const void*)fwd, dim3(grid), dim3(NTHREADS), args, LDS_BYTES, stream);
    if (e != hipSuccess) fprintf(stderr, "cooperative launch failed: %s (grid %d)\n", hipGetErrorString(e), grid);
#endif
}
```

```cpp
#include <hip/hip_runtime.h>
#include <hip/hip_cooperative_groups.h>
#include <cstdio>
#include <cstdint>
namespace cg = cooperative_groups;
__device__ __forceinline__ int lane_id_() { int l; asm volatile("v_mbcnt_lo_u32_b32 %0, -1, 0\n\tv_mbcnt_hi_u32_b32 %0, -1, %0" : "=v"(l)); return l; }
namespace pg8 {
#define PG8_LAS __attribute__((address_space(3)))
typedef unsigned short bf16_t;
typedef short bf16x8 __attribute__((ext_vector_type(8)));
typedef float f32x4 __attribute__((ext_vector_type(4)));
typedef unsigned u32x4 __attribute__((ext_vector_type(4)));
constexpr int BM = 256, BK = 64, HALF = 128, HTB = HALF * BK * 2  , STAGE_BYTES = 8 * HTB, NXCD = 8, WGM = 8;

__host__ __device__ __forceinline__ int lds_byte(int r, int c) { const int st = (r >> 4) * 2 + (c >> 5), rr = r & 15, cc = c & 31, ob = rr * 64 + cc * 2; return st * 1024 + (ob ^ (((ob >> 9) & 1) << 5)); }
__host__ __device__ __forceinline__ void stage_rc(int b, int& R, int& C) { const int st = b / 1024, sb = b % 1024, swz = sb ^ (((sb >> 9) & 1) << 5); R = (st >> 1) * 16 + swz / 64; C = (st & 1) * 32 + (swz % 64) / 2; }
__host__ __device__ __forceinline__ int perm32(int rho) { const int n = rho >> 4, i = rho & 15; return 8 * (i >> 2) + 4 * n + (i & 3); }

struct Unit { int pm, pn; };
struct Gemm { const bf16_t* A; const bf16_t* Bt; int lda, ldb, K; };

struct StaticOrder {
    int nM, nN, nwg, G, c;
    __host__ __device__ void init(int M, int N, int G_, int c_) { nM = M / BM; nN = N / BM; nwg = nM * nN; G = G_; c = c_; }
    __host__ __device__ bool next(int i, Unit& u) const {
        const long L = (long)i * G + c; if (L >= nwg) return false;
        int wgid = (int)L; { const int q = nwg / NXCD, r = nwg % NXCD, xcd = wgid % NXCD, off = wgid / NXCD; wgid = (xcd < r ? xcd * (q + 1) : r * (q + 1) + (xcd - r) * q) + off; }
        const int nig = WGM * nN, gid = wgid / nig, fm = gid * WGM, gsz = (nM - fm) < WGM ? (nM - fm) : WGM;
        u.pm = fm + ((wgid % nig) % gsz); u.pn = (wgid % nig) / gsz; return true;
    }
    __device__ __forceinline__ void a_ready(const Unit&) const {}
    __device__ __forceinline__ void done(const Unit&) const {}
};

__device__ __forceinline__ unsigned cvt_pk_bf16(float lo, float hi) { unsigned r; asm volatile("v_cvt_pk_bf16_f32 %0, %1, %2" : "=v"(r) : "v"(lo), "v"(hi)); return r; }

template <class Epi, class Sched, bool ALIGN_EPI = false, bool SP2 = false>
__device__ __forceinline__ void gemm_phase(PG8_LAS unsigned char* lds, const Gemm g, const Sched& S, const Epi& E, int wid_in) {
    const int wid = wid_in, lane = lane_id_(), tid = wid * 64 + lane, wr = wid >> 2, wc = wid & 3, fr = lane & 15, fq = lane >> 4;
    const int K = g.K, nt = K / BK;
    unsigned voffA[2], voffB[2];
#pragma unroll
    for (int i = 0; i < 2; ++i) { int R, C; stage_rc(tid * 16 + i * 8192, R, C); const int Rb = Epi::PERM ? ((R & ~31) + perm32(R & 31)) : R;
        voffA[i] = (unsigned)(R * g.lda + C) * 2u; voffB[i] = (unsigned)(Rb * g.ldb + C) * 2u; }
    const size_t kstep = (size_t)(BK * 2);
    const size_t hstepA = (size_t)HALF * g.lda * 2, hstepB = (size_t)HALF * g.ldb * 2;
    const size_t tstepA = 2 * hstepA, tstepB = 2 * hstepB;
    const unsigned ldsw = (unsigned)wid * 1024u;
    const int aoff = lds_byte(wr * 64 + fr, fq * 8), boff = lds_byte(wc * 32 + fr, fq * 8);
#define PG8_SA(b, h) (((b) * 2 + (h)) * HTB)
#define PG8_SB(b, h) ((4 + (b) * 2 + (h)) * HTB)
#define PG8_STAGE(bufoff, gbase, voff) do { _Pragma("unroll") for (int _i = 0; _i < 2; ++_i) \
        __builtin_amdgcn_global_load_lds((const unsigned*)((const char*)(gbase) + (voff)[_i]), (PG8_LAS unsigned*)(lds + (bufoff) + ldsw + _i * 8192), 16, 0, 0); } while (0)
#define PG8_LDA(dst, b, h) do { _Pragma("unroll") for (int m = 0; m < 4; ++m) _Pragma("unroll") for (int k = 0; k < 2; ++k) dst[m][k] = *(const PG8_LAS bf16x8*)(lds + PG8_SA(b, h) + aoff + m * 2048 + k * 1024); } while (0)
#define PG8_LDB(dst, b, h) do { _Pragma("unroll") for (int n = 0; n < 2; ++n) _Pragma("unroll") for (int k = 0; k < 2; ++k) dst[n][k] = *(const PG8_LAS bf16x8*)(lds + PG8_SB(b, h) + boff + n * 2048 + k * 1024); } while (0)
#define PG8_MMA(ai, bj, At, Bt) do { __builtin_amdgcn_s_setprio(1); _Pragma("unroll") for (int m = 0; m < 4; ++m) _Pragma("unroll") for (int n = 0; n < 2; ++n) _Pragma("unroll") for (int k = 0; k < 2; ++k) \
        acc[ai][bj][m][n] = __builtin_amdgcn_mfma_f32_16x16x32_bf16(Bt[n][k], At[m][k], acc[ai][bj][m][n], 0, 0, 0); __builtin_amdgcn_s_setprio(0); } while (0)
#define PG8_WAIT_V(n) asm volatile("s_waitcnt vmcnt(" #n ")" ::: "memory")
#define PG8_WAIT_L(n) asm volatile("s_waitcnt lgkmcnt(" #n ")" ::: "memory")
#define PG8_BAR __builtin_amdgcn_s_barrier()
#define PG8_SCHED __builtin_amdgcn_sched_barrier(0)
    Unit cur, nxt; int ui = 0;
    if (!S.next(0, cur)) return;
    f32x4 acc[2][2][4][2];
#pragma unroll
    for (int a = 0; a < 2; ++a)
#pragma unroll
        for (int b = 0; b < 2; ++b)
#pragma unroll
            for (int m = 0; m < 4; ++m)
#pragma unroll
                for (int n = 0; n < 2; ++n) acc[a][b][m][n] = (f32x4){0.f, 0.f, 0.f, 0.f};
    bf16x8 At[4][2], B0[2][2], B1[2][2];
    const char* cA = (const char*)g.A + (size_t)cur.pm * tstepA; const char* cB = (const char*)g.Bt + (size_t)cur.pn * tstepB;
    S.a_ready(cur);
    if constexpr (SP2) {
        PG8_STAGE(PG8_SB(0, 0), cB, voffB); PG8_STAGE(PG8_SB(0, 1), cB + hstepB, voffB); PG8_STAGE(PG8_SA(0, 0), cA, voffA); PG8_STAGE(PG8_SA(0, 1), cA + hstepA, voffA);
        if (wr == 1) PG8_BAR;
        PG8_WAIT_V(2); PG8_BAR;
        PG8_STAGE(PG8_SB(1, 0), cB + kstep, voffB); PG8_STAGE(PG8_SA(1, 0), cA + kstep, voffA); PG8_STAGE(PG8_SB(1, 1), cB + hstepB + kstep, voffB);
        PG8_WAIT_V(6); PG8_BAR;
    } else {
        PG8_STAGE(PG8_SB(0, 0), cB, voffB); PG8_STAGE(PG8_SA(0, 0), cA, voffA); PG8_STAGE(PG8_SB(0, 1), cB + hstepB, voffB); PG8_STAGE(PG8_SA(0, 1), cA + hstepA, voffA);
        if (wr == 1) PG8_BAR;
        PG8_WAIT_V(4); PG8_BAR;
        PG8_STAGE(PG8_SB(1, 0), cB + kstep, voffB); PG8_STAGE(PG8_SA(1, 0), cA + kstep, voffA); PG8_STAGE(PG8_SB(1, 1), cB + hstepB + kstep, voffB);
        PG8_WAIT_V(6); PG8_BAR;
    }
    for (;;) {
        const bool has_next = S.next(ui + 1, nxt);
        const char* nA = has_next ? (const char*)g.A + (size_t)nxt.pm * tstepA : cA; const char* nB = has_next ? (const char*)g.Bt + (size_t)nxt.pn * tstepB : cB;
        for (int t = 0; t < nt; t += 2) {
            const bool last = (t == nt - 2);
            const char* a1 = cA + (size_t)(t + 1) * kstep;
            const char* a2 = last ? nA : cA + (size_t)(t + 2) * kstep; const char* b2 = last ? nB : cB + (size_t)(t + 2) * kstep;
            const char* a3 = a2 + kstep; const char* b3 = b2 + kstep;
            if (last && has_next) S.a_ready(nxt);
            if constexpr (SP2) {
            PG8_LDB(B0, 0, 0); PG8_LDB(B1, 0, 1); PG8_SCHED; PG8_LDA(At, 0, 0); PG8_STAGE(PG8_SA(1, 1), a1 + hstepA, voffA);
            PG8_WAIT_V(8); PG8_WAIT_L(0); PG8_BAR; PG8_MMA(0, 0, At, B0); PG8_MMA(0, 1, At, B1); PG8_BAR; PG8_SCHED;
            PG8_LDA(At, 0, 1); PG8_STAGE(PG8_SB(0, 0), b2, voffB); PG8_STAGE(PG8_SB(0, 1), b2 + hstepB, voffB); PG8_STAGE(PG8_SA(0, 0), a2, voffA);
            PG8_WAIT_V(8); PG8_WAIT_L(0); PG8_BAR; PG8_MMA(1, 0, At, B0); PG8_MMA(1, 1, At, B1); PG8_BAR; PG8_SCHED;
            PG8_LDB(B0, 1, 0); PG8_LDB(B1, 1, 1); PG8_SCHED; PG8_LDA(At, 1, 0); PG8_STAGE(PG8_SA(0, 1), a2 + hstepA, voffA);
            PG8_WAIT_V(8); PG8_WAIT_L(0); PG8_BAR; PG8_MMA(0, 0, At, B0); PG8_MMA(0, 1, At, B1); PG8_BAR; PG8_SCHED;
            PG8_LDA(At, 1, 1); PG8_STAGE(PG8_SB(1, 0), b3, voffB); PG8_STAGE(PG8_SB(1, 1), b3 + hstepB, voffB); PG8_STAGE(PG8_SA(1, 0), a3, voffA);
            PG8_WAIT_V(8); PG8_WAIT_L(0); PG8_BAR; PG8_MMA(1, 0, At, B0); PG8_MMA(1, 1, At, B1); PG8_BAR; PG8_SCHED;
            } else {
            PG8_LDB(B0, 0, 0); PG8_SCHED; PG8_LDA(At, 0, 0); PG8_STAGE(PG8_SA(1, 1), a1 + hstepA, voffA);
            PG8_WAIT_L(8); PG8_BAR; PG8_WAIT_L(0); PG8_MMA(0, 0, At, B0); PG8_BAR; PG8_SCHED;
            PG8_LDB(B1, 0, 1); PG8_STAGE(PG8_SB(0, 0), b2, voffB);
            PG8_BAR; PG8_WAIT_L(0); PG8_MMA(0, 1, At, B1); PG8_BAR;
            PG8_LDA(At, 0, 1); PG8_STAGE(PG8_SA(0, 0), a2, voffA);
            PG8_BAR; PG8_WAIT_L(0); PG8_MMA(1, 0, At, B0); PG8_BAR; PG8_SCHED;
            PG8_STAGE(PG8_SB(0, 1), b2 + hstepB, voffB);
            PG8_WAIT_V(6); PG8_BAR; PG8_MMA(1, 1, At, B1); PG8_BAR;
            PG8_LDB(B0, 1, 0); PG8_SCHED; PG8_LDA(At, 1, 0); PG8_STAGE(PG8_SA(0, 1), a2 + hstepA, voffA);
            PG8_WAIT_L(8); PG8_BAR; PG8_WAIT_L(0); PG8_MMA(0, 0, At, B0); PG8_BAR; PG8_SCHED;
            PG8_LDB(B1, 1, 1); PG8_STAGE(PG8_SB(1, 0), b3, voffB);
            PG8_BAR; PG8_WAIT_L(0); PG8_MMA(0, 1, At, B1); PG8_BAR;
            PG8_LDA(At, 1, 1); PG8_STAGE(PG8_SA(1, 0), a3, voffA);
            PG8_BAR; PG8_WAIT_L(0); PG8_MMA(1, 0, At, B0); PG8_BAR; PG8_SCHED;
            PG8_STAGE(PG8_SB(1, 1), b3 + hstepB, voffB);
            PG8_WAIT_V(6); PG8_BAR; PG8_MMA(1, 1, At, B1); PG8_BAR;
            }
        }
        if constexpr (ALIGN_EPI) { if (wr == 0) PG8_BAR; }
        if constexpr (!Epi::AFTER_DRAIN) { E(acc, cur, wr, wc, fr, fq); S.done(cur); }
        if (!has_next) break;
#pragma unroll
        for (int a = 0; a < 2; ++a)
#pragma unroll
            for (int b = 0; b < 2; ++b)
#pragma unroll
                for (int m = 0; m < 4; ++m)
#pragma unroll
                    for (int n = 0; n < 2; ++n) acc[a][b][m][n] = (f32x4){0.f, 0.f, 0.f, 0.f};
        cur = nxt; cA = nA; cB = nB; ++ui;
        if constexpr (ALIGN_EPI) { if (wr == 1) PG8_BAR; }
    }
    PG8_WAIT_V(0);
    if constexpr (!ALIGN_EPI) { if (wr == 0) PG8_BAR; }
    PG8_BAR;
    if constexpr (Epi::AFTER_DRAIN) { E.fused(acc, cur, wr, wc, fr, fq, lds, wid, lane); S.done(cur); }
#undef PG8_SA
#undef PG8_SB
#undef PG8_STAGE
#undef PG8_LDA
#undef PG8_LDB
#undef PG8_MMA
#undef PG8_WAIT_V
#undef PG8_WAIT_L
#undef PG8_BAR
#undef PG8_SCHED
}
}


#define LAS __attribute__((address_space(3)))
typedef unsigned short bf16;
typedef float f32x4 __attribute__((ext_vector_type(4)));
typedef float f32x2 __attribute__((ext_vector_type(2)));
typedef short bf16x8 __attribute__((ext_vector_type(8)));
typedef unsigned u32x4 __attribute__((ext_vector_type(4)));
typedef unsigned u32x2 __attribute__((ext_vector_type(2)));

constexpr int NWAVES = 8, NTHREADS = 512;
constexpr int DM = 2048, MROWS = 8704, NPROMPT = 8192, NSEQ = 132, SEQ = 2048, DSEQ = 4;
constexpr int N_IN = 24640, N_INP = 24832, CONVCH = 8192, DFF = 8192, NADA = 12288;
constexpr float EPS = 1e-6f;
constexpr int LDS_BYTES = 147456;

enum { I_XP = 0, I_XS, I_SHG, I_SGD, I_CC, I_CP, I_CS, I_LB, I_WADA, I_BADA, I_NG, I_WIN, I_CW, I_ALOG, I_DTB, I_HGN, I_GDN, I_WOHG, I_WOGD, I_WO, I_WUP, I_WDN };
constexpr size_t O_Y = 0, O_HGP = 17825792, O_GDP = 18874368, O_CCP = 20971520, O_HGS = 21069824, O_GDS = 54624256, O_CCS = 121733120, O_END = 124878848;
constexpr size_t MiB = 1u << 20;
constexpr size_t WS_MOD = 1 * MiB, WS_BTIN = 8 * MiB, WS_BTOUT = 105 * MiB, WS_BTO = 129 * MiB, WS_BTUP = 137 * MiB, WS_BTDN = 169 * MiB, WS_A1 = 201 * MiB;
constexpr size_t WS_QH = 235 * MiB, WS_F = 269 * MiB, WS_I = 337 * MiB, WS_GH = 371 * MiB, WS_U = 405 * MiB, WS_GZ = 541 * MiB, WS_SA = 609 * MiB, WS_SB = 643 * MiB, WS_BL = 677 * MiB;
constexpr size_t WS_UC = 680 * MiB, WS_O32 = 816 * MiB, WS_OA = 235 * MiB, WS_T1 = 337 * MiB, WS_MG = 405 * MiB, WS_MIX = 439 * MiB, WS_H = 507 * MiB, WS_U2 = 680 * MiB, WS_FF = 439 * MiB;
constexpr size_t WS_END = 1020 * MiB;

__device__ __forceinline__ unsigned f2bf(float f) { unsigned u = __float_as_uint(f); return (u + 0x7fffu + ((u >> 16) & 1u)) >> 16; }
__device__ __forceinline__ unsigned pk2(float lo, float hi) { return f2bf(lo) | (f2bf(hi) << 16); }
__device__ __forceinline__ float bf2f(unsigned h) { return __uint_as_float(h << 16); }
__device__ __forceinline__ float bflo(unsigned w) { return __uint_as_float(w << 16); }
__device__ __forceinline__ float bfhi(unsigned w) { return __uint_as_float(w & 0xffff0000u); }
__device__ __forceinline__ float sigmoidf_(float x) { return __builtin_amdgcn_rcpf(1.0f + __expf(-x)); }
__device__ __forceinline__ float siluf_(float x) { return x * sigmoidf_(x); }
__device__ __forceinline__ float wave_sum(float v) {
#pragma unroll
    for (int o = 1; o < 64; o <<= 1) v += __shfl_xor(v, o);
    return v;
}
#define LDS_WAIT() asm volatile("s_waitcnt lgkmcnt(0)" ::: "memory")

struct Args { const float* in[22]; float* out; unsigned char* ws; int ph_lo, ph_hi; };
typedef __attribute__((address_space(4))) const unsigned char* kargp_t;
struct PA {
    kargp_t kp;
    static __device__ __forceinline__ PA get() { PA p; p.kp = (kargp_t)__builtin_amdgcn_kernarg_segment_ptr(); asm volatile("" : "+s"(p.kp)); return p; }
    __device__ __forceinline__ const float* in(int i) const { typedef const float* cfp; return ((__attribute__((address_space(4))) const cfp*)kp)[i]; }
    __device__ __forceinline__ float* out() const { typedef float* fp; return *((__attribute__((address_space(4))) const fp*)(kp + 176)); }
    __device__ __forceinline__ unsigned char* ws() const { typedef unsigned char* up; return *((__attribute__((address_space(4))) const up*)(kp + 184)); }
    __device__ __forceinline__ int ph_lo() const { return *((__attribute__((address_space(4))) const int*)(kp + 192)); }
    __device__ __forceinline__ int ph_hi() const { return *((__attribute__((address_space(4))) const int*)(kp + 196)); }
};
static_assert(sizeof(Args) == 200, "Args layout");
__device__ __forceinline__ bool ph_in(int k) { const PA p = PA::get(); return p.ph_lo() <= k && k < p.ph_hi(); }

template <int MODE> __device__ __forceinline__ float actf(float v) {
    if (MODE == 1) return siluf_(v);
    if (MODE == 2) return sigmoidf_(v);
    if (MODE == 3) { const float r = fmaxf(v, 0.f); return r * r; }
    return v;
}
template <int MODE> __device__ __forceinline__ void tile_store_bf16(const f32x4 (&acc)[2][2][4][2], bf16* base, int ld, int row0, int col0) {
#pragma unroll
    for (int ai = 0; ai < 2; ++ai)
#pragma unroll
        for (int m = 0; m < 4; ++m) {
            bf16* rowp = base + (size_t)(row0 + ai * 128 + m * 16) * ld + col0;
#pragma unroll
            for (int bj = 0; bj < 2; ++bj) {
                const f32x4 v0 = acc[ai][bj][m][0], v1 = acc[ai][bj][m][1];
                u32x4 w;
                w.x = pk2(actf<MODE>(v0[0]), actf<MODE>(v0[1])); w.y = pk2(actf<MODE>(v0[2]), actf<MODE>(v0[3]));
                w.z = pk2(actf<MODE>(v1[0]), actf<MODE>(v1[1])); w.w = pk2(actf<MODE>(v1[2]), actf<MODE>(v1[3]));
                *(u32x4*)(rowp + bj * 128) = w;
            }
        }
}
__device__ __forceinline__ void tile_store_f32(const f32x4 (&acc)[2][2][4][2], float* base, int ld, int row0, int col0) {
#pragma unroll
    for (int ai = 0; ai < 2; ++ai)
#pragma unroll
        for (int m = 0; m < 4; ++m) {
            float* rowp = base + (size_t)(row0 + ai * 128 + m * 16) * ld + col0;
#pragma unroll
            for (int bj = 0; bj < 2; ++bj) { *(f32x4*)(rowp + bj * 128) = acc[ai][bj][m][0]; *(f32x4*)(rowp + bj * 128 + 4) = acc[ai][bj][m][1]; }
        }
}

struct EpiIn {
    static constexpr bool PERM = true, AFTER_DRAIN = false;
    unsigned char* ws; const float *lbl, *alog, *dtb;
    __device__ __forceinline__ void operator()(const f32x4 (&acc)[2][2][4][2], const pg8::Unit& u, int wr, int wc, int fr, int fq) const {
        const int pn = u.pn, row0 = u.pm * 256 + wr * 64 + fr, cl = wc * 32 + 8 * fq;
        if (pn >= 8 && pn < 16) {
            const int c0 = (pn - 8) * 256 + cl;
            float lb[2][8];
#pragma unroll
            for (int bj = 0; bj < 2; ++bj)
#pragma unroll
                for (int j = 0; j < 8; ++j) { const int c = c0 + bj * 128 + j; lb[bj][j] = sigmoidf_(lbl[c] - lbl[2048 + c]); }
#pragma unroll
            for (int ai = 0; ai < 2; ++ai)
#pragma unroll
                for (int m = 0; m < 4; ++m) {
                    float* rowp = (float*)(ws + WS_F) + (size_t)(row0 + ai * 128 + m * 16) * 2048 + c0;
#pragma unroll
                    for (int bj = 0; bj < 2; ++bj) {
                        const f32x4 v0 = acc[ai][bj][m][0], v1 = acc[ai][bj][m][1]; f32x4 o0, o1;
#pragma unroll
                        for (int j = 0; j < 4; ++j) { o0[j] = lb[bj][j] + (1.f - lb[bj][j]) * sigmoidf_(v0[j]); o1[j] = lb[bj][4 + j] + (1.f - lb[bj][4 + j]) * sigmoidf_(v1[j]); }
                        *(f32x4*)(rowp + bj * 128) = o0; *(f32x4*)(rowp + bj * 128 + 4) = o1;
                    }
                }
            return;
        }
        if (pn == 96) {
            if (wc < 2) {
#pragma unroll
                for (int ai = 0; ai < 2; ++ai)
#pragma unroll
                    for (int m = 0; m < 4; ++m) {
                        float* rowp = (float*)(ws + WS_BL) + (size_t)(row0 + ai * 128 + m * 16) * 64 + cl;
                        const f32x4 v0 = acc[ai][0][m][0], v1 = acc[ai][0][m][1]; f32x4 o0, o1;
#pragma unroll
                        for (int j = 0; j < 4; ++j) {
                            if (wc == 0) { o0[j] = sigmoidf_(v0[j]); o1[j] = sigmoidf_(v1[j]); }
                            else { const int h0 = 8 * fq + j, h1 = 8 * fq + 4 + j; const float x0 = v0[j] + dtb[h0], x1 = v1[j] + dtb[h1];
                                   o0[j] = -expf(alog[h0]) * (fmaxf(x0, 0.f) + log1pf(expf(-fabsf(x0)))); o1[j] = -expf(alog[h1]) * (fmaxf(x1, 0.f) + log1pf(expf(-fabsf(x1)))); }
                        }
                        *(f32x4*)(rowp) = o0; *(f32x4*)(rowp + 4) = o1;
                    }
            }
            return;
        }
        size_t boff; int ld, c0, mode;
        if (pn < 8)       { boff = WS_QH; ld = 2048; c0 = pn * 256; mode = 1; }
        else if (pn < 24) { boff = WS_I;  ld = 2048; c0 = (pn - 16) * 256; mode = 0; }
        else if (pn < 32) { boff = WS_GH; ld = 2048; c0 = (pn - 24) * 256; mode = 1; }
        else if (pn < 64) { boff = WS_U;  ld = 8192; c0 = (pn - 32) * 256; mode = 0; }
        else if (pn < 80) { boff = WS_GZ; ld = 4096; c0 = (pn - 64) * 256; mode = 1; }
        else if (pn < 88) { boff = WS_SA; ld = 2048; c0 = (pn - 80) * 256; mode = 2; }
        else              { boff = WS_SB; ld = 2048; c0 = (pn - 88) * 256; mode = 2; }
        bf16* base = (bf16*)(ws + boff);
        if (mode == 0) tile_store_bf16<0>(acc, base, ld, row0, c0 + cl);
        else if (mode == 1) tile_store_bf16<1>(acc, base, ld, row0, c0 + cl);
        else tile_store_bf16<2>(acc, base, ld, row0, c0 + cl);
    }
};
struct EpiOut1 {
    static constexpr bool PERM = true, AFTER_DRAIN = false;
    float* T1; const bf16* SA;
    __device__ __forceinline__ void operator()(const f32x4 (&acc)[2][2][4][2], const pg8::Unit& u, int wr, int wc, int fr, int fq) const {
        const int row0 = u.pm * 256 + wr * 64 + fr, c0 = u.pn * 256 + wc * 32 + 8 * fq;
#pragma unroll
        for (int ai = 0; ai < 2; ++ai)
#pragma unroll
            for (int m = 0; m < 4; ++m) {
                const size_t ro = (size_t)(row0 + ai * 128 + m * 16) * 2048 + c0;
#pragma unroll
                for (int bj = 0; bj < 2; ++bj) {
                    const u32x4 s = *(const u32x4*)(SA + ro + bj * 128);
                    const f32x4 v0 = acc[ai][bj][m][0], v1 = acc[ai][bj][m][1];
                    f32x4 o0 = {v0[0] * bflo(s.x), v0[1] * bfhi(s.x), v0[2] * bflo(s.y), v0[3] * bfhi(s.y)};
                    f32x4 o1 = {v1[0] * bflo(s.z), v1[1] * bfhi(s.z), v1[2] * bflo(s.w), v1[3] * bfhi(s.w)};
                    *(f32x4*)(T1 + ro + bj * 128) = o0; *(f32x4*)(T1 + ro + bj * 128 + 4) = o1;
                }
            }
    }
};
struct EpiOut2 {
    static constexpr bool PERM = true, AFTER_DRAIN = false;
    const float* T1; const bf16* SB; bf16* MG;
    __device__ __forceinline__ void operator()(const f32x4 (&acc)[2][2][4][2], const pg8::Unit& u, int wr, int wc, int fr, int fq) const {
        const int row0 = u.pm * 256 + wr * 64 + fr, c0 = u.pn * 256 + wc * 32 + 8 * fq;
#pragma unroll
        for (int ai = 0; ai < 2; ++ai)
#pragma unroll
            for (int m = 0; m < 4; ++m) {
                const size_t ro = (size_t)(row0 + ai * 128 + m * 16) * 2048 + c0;
#pragma unroll
                for (int bj = 0; bj < 2; ++bj) {
                    const u32x4 s = *(const u32x4*)(SB + ro + bj * 128);
                    const f32x4 t0 = *(const f32x4*)(T1 + ro + bj * 128), t1 = *(const f32x4*)(T1 + ro + bj * 128 + 4);
                    const f32x4 v0 = acc[ai][bj][m][0], v1 = acc[ai][bj][m][1];
                    u32x4 w;
                    w.x = pk2(t0[0] + v0[0] * bflo(s.x), t0[1] + v0[1] * bfhi(s.x)); w.y = pk2(t0[2] + v0[2] * bflo(s.y), t0[3] + v0[3] * bfhi(s.y));
                    w.z = pk2(t1[0] + v1[0] * bflo(s.z), t1[1] + v1[1] * bfhi(s.z)); w.w = pk2(t1[2] + v1[2] * bflo(s.w), t1[3] + v1[3] * bfhi(s.w));
                    *(u32x4*)(MG + ro + bj * 128) = w;
                }
            }
    }
};
struct EpiF32 {
    static constexpr bool PERM = true, AFTER_DRAIN = false;
    float* O; int ld;
    __device__ __forceinline__ void operator()(const f32x4 (&acc)[2][2][4][2], const pg8::Unit& u, int wr, int wc, int fr, int fq) const {
        tile_store_f32(acc, O, ld, u.pm * 256 + wr * 64 + fr, u.pn * 256 + wc * 32 + 8 * fq);
    }
};
struct EpiRelu2 {
    static constexpr bool PERM = true, AFTER_DRAIN = false;
    bf16* O; int ld;
    __device__ __forceinline__ void operator()(const f32x4 (&acc)[2][2][4][2], const pg8::Unit& u, int wr, int wc, int fr, int fq) const {
        tile_store_bf16<3>(acc, O, ld, u.pm * 256 + wr * 64 + fr, u.pn * 256 + wc * 32 + 8 * fq);
    }
};

__device__ __forceinline__ void transpose_item(const float* W, int N, bf16* WT, int ldk, int k0, int n0, int nrow0, LAS float* scr, int lane) {
#pragma unroll 8
    for (int i = 0; i < 32; ++i) { const int kk = 2 * i + (lane >> 5); scr[kk * 33 + (lane & 31)] = W[(size_t)(k0 + kk) * N + n0 + (lane & 31)]; }
    LDS_WAIT(); asm volatile("" ::: "memory");
    const int c = lane & 7;
#pragma unroll
    for (int j = 0; j < 4; ++j) { const int n = (lane >> 3) + 8 * j; const LAS float* s = scr + (8 * c) * 33 + n;
        u32x4 o; o.x = pk2(s[0 * 33], s[1 * 33]); o.y = pk2(s[2 * 33], s[3 * 33]); o.z = pk2(s[4 * 33], s[5 * 33]); o.w = pk2(s[6 * 33], s[7 * 33]);
        *(u32x4*)(WT + (size_t)(nrow0 + n) * ldk + k0 + 8 * c) = o; }
    LDS_WAIT(); asm volatile("" ::: "memory");
}
__device__ __forceinline__ void mod_item(const PA& a, LAS unsigned char* lds, int cb, int tid, int wid, int lane) {
    constexpr int AST = 264;
    LAS bf16* As = (LAS bf16*)lds;
    const float* cp = a.in(I_CP); const float* cs = a.in(I_CS); const float* W = a.in(I_WADA); const float* bada = a.in(I_BADA);
    float* mod = (float*)(a.ws() + WS_MOD);
    const int nt = wid & 3, mh = wid >> 2, fr = lane & 15, fq = lane >> 4, n = cb * 64 + nt * 16 + fr;
    f32x4 acc[5];
#pragma unroll
    for (int i = 0; i < 5; ++i) acc[i] = (f32x4){0.f, 0.f, 0.f, 0.f};
    for (int kc = 0; kc < 8; ++kc) {
        __syncthreads();
        for (int e = tid; e < 144 * 64; e += NTHREADS) {
            const int s = e >> 6, q = e & 63; u32x2 w = {0u, 0u};
            if (s < NSEQ) { const float* src = (s < 4 ? cp + (size_t)s * 2048 : cs + (size_t)(s - 4) * 2048) + kc * 256 + q * 4; const f32x4 x = *(const f32x4*)src;
                w.x = pk2(siluf_(x[0]), siluf_(x[1])); w.y = pk2(siluf_(x[2]), siluf_(x[3])); }
            *(LAS u32x2*)(As + s * AST + q * 4) = w;
        }
        __syncthreads();
#pragma unroll 2
        for (int ks = 0; ks < 8; ++ks) {
            const int k0 = kc * 256 + ks * 32 + 8 * fq;
            bf16x8 b;
#pragma unroll
            for (int j = 0; j < 8; ++j) b[j] = (short)f2bf(W[(size_t)(k0 + j) * NADA + n]);
#pragma unroll
            for (int i = 0; i < 5; ++i) {
                const int mt = mh * 5 + i;
                if (mt < 9) { const bf16x8 av = *(const LAS bf16x8*)(As + (mt * 16 + fr) * AST + ks * 32 + 8 * fq);
                    acc[i] = __builtin_amdgcn_mfma_f32_16x16x32_bf16(av, b, acc[i], 0, 0, 0); }
            }
        }
    }
    const float bb = bada[n];
#pragma unroll
    for (int i = 0; i < 5; ++i)
#pragma unroll
        for (int r = 0; r < 4; ++r) { const int s = (mh * 5 + i) * 16 + 4 * fq + r; if (s < NSEQ) mod[(size_t)s * NADA + n] = acc[i][r] + bb; }
}

__device__ __forceinline__ const float* xrow_ptr(const PA& a, int row) { return row < NPROMPT ? a.in(I_XP) + (size_t)row * DM : a.in(I_XS) + (size_t)(row - NPROMPT) * DM; }
__device__ __forceinline__ int seq_of_row(int row) { return row < NPROMPT ? (row >> 11) : 4 + ((row - NPROMPT) >> 2); }

__device__ __forceinline__ void hgrn_item(const PA& a, LAS float* wl, int grp, int b, int h, int half, int lane) {
    const bf16* Qh = (const bf16*)(a.ws() + WS_QH); const float* F = (const float*)(a.ws() + WS_F); const bf16* Ih = (const bf16*)(a.ws() + WS_I);
    float* O32 = (float*)(a.ws() + WS_O32);
    const int T = grp ? DSEQ : SEQ, row0 = grp ? NPROMPT + b * DSEQ : b * SEQ, dv = half * 64 + lane;
    unsigned sidx = (unsigned)((b * 16 + h) * 128) * 128u + dv;
    float S[128];
    if (grp) { const float* s0 = a.in(I_SHG); unsigned so_ = sidx; asm volatile("" : "+v"(so_));
#pragma unroll
        for (int d8 = 0; d8 < 16; ++d8) {
#pragma unroll
            for (int j = 0; j < 8; ++j) S[d8 * 8 + j] = s0[so_ + j * 128];
            so_ += 1024; asm volatile("" : "+v"(so_)); } }
    else {
#pragma unroll
        for (int d = 0; d < 128; ++d) S[d] = 0.f; }
    LAS float* qs = wl; LAS float* fs = wl + 128;
    unsigned ro = (unsigned)row0 * 2048u + h * 128 + lane;
    unsigned oo = (unsigned)row0 * 6144u + h * 128 + dv;
    float nq0 = bf2f(Qh[ro]), nq1 = bf2f(Qh[ro + 64]), nf0 = F[ro], nf1 = F[ro + 64], niv = bf2f(Ih[ro + half * 64]);
#pragma unroll 1
    for (int t = 0; t < T; ++t) {
        const float q0 = nq0, q1 = nq1, f0 = nf0, f1 = nf1, iv = niv;
        if (t + 1 < T) { const unsigned rn = ro + 2048; nq0 = bf2f(Qh[rn]); nq1 = bf2f(Qh[rn + 64]); nf0 = F[rn]; nf1 = F[rn + 64]; niv = bf2f(Ih[rn + half * 64]); }
        qs[lane] = q0; qs[64 + lane] = q1; fs[lane] = f0; fs[64 + lane] = f1;
        float o0 = 0.f, o1 = 0.f, o2 = 0.f, o3 = 0.f;
#pragma unroll
        for (int d4 = 0; d4 < 32; ++d4) {
            const f32x4 q4 = *(const LAS f32x4*)(qs + 4 * d4), f4 = *(const LAS f32x4*)(fs + 4 * d4);
            S[4 * d4 + 0] = fmaf(f4[0], S[4 * d4 + 0] - iv, iv); o0 = fmaf(q4[0], S[4 * d4 + 0], o0);
            S[4 * d4 + 1] = fmaf(f4[1], S[4 * d4 + 1] - iv, iv); o1 = fmaf(q4[1], S[4 * d4 + 1], o1);
            S[4 * d4 + 2] = fmaf(f4[2], S[4 * d4 + 2] - iv, iv); o2 = fmaf(q4[2], S[4 * d4 + 2], o2);
            S[4 * d4 + 3] = fmaf(f4[3], S[4 * d4 + 3] - iv, iv); o3 = fmaf(q4[3], S[4 * d4 + 3], o3);
            if ((d4 & 1) == 1) asm volatile("" ::: "memory");
        }
        O32[oo] = (o0 + o1) + (o2 + o3);
        ro += 2048; oo += 6144;
    }
    float* so = a.out() + (grp ? O_HGS : O_HGP); asm volatile("" : "+v"(sidx));
#pragma unroll
    for (int d8 = 0; d8 < 16; ++d8) {
#pragma unroll
        for (int j = 0; j < 8; ++j) so[sidx + j * 128] = S[d8 * 8 + j];
        sidx += 1024; asm volatile("" : "+v"(sidx)); }
}
__device__ __forceinline__ void gdn_item(const PA& a, LAS float* wl, int grp, int b, int vh, int half, int lane) {
    const bf16* UC = (const bf16*)(a.ws() + WS_UC); const float* BL = (const float*)(a.ws() + WS_BL);
    float* O32 = (float*)(a.ws() + WS_O32);
    const int T = grp ? DSEQ : SEQ, row0 = grp ? NPROMPT + b * DSEQ : b * SEQ, dv = half * 64 + lane, qh = vh >> 1;
    unsigned sidx = (unsigned)((b * 32 + vh) * 128) * 128u + dv;
    float S[128];
    if (grp) { const float* s0 = a.in(I_SGD); unsigned so_ = sidx; asm volatile("" : "+v"(so_));
#pragma unroll
        for (int d8 = 0; d8 < 16; ++d8) {
#pragma unroll
            for (int j = 0; j < 8; ++j) S[d8 * 8 + j] = s0[so_ + j * 128];
            so_ += 1024; asm volatile("" : "+v"(so_)); } }
    else {
#pragma unroll
        for (int d = 0; d < 128; ++d) S[d] = 0.f; }
    LAS float* qs = wl; LAS float* ks = wl + 128;
    unsigned ro = (unsigned)row0 * 8192u + qh * 128 + lane, rv = (unsigned)row0 * 8192u + 4096 + vh * 128 + dv, rb = (unsigned)row0 * 64u + vh;
    unsigned oo = (unsigned)row0 * 6144u + 2048 + vh * 128 + dv;
    float nq0 = bf2f(UC[ro]), nq1 = bf2f(UC[ro + 64]), nk0 = bf2f(UC[ro + 2048]), nk1 = bf2f(UC[ro + 2048 + 64]);
    float nv = bf2f(UC[rv]), nbeta = BL[rb], nla = BL[rb + 32];
#pragma unroll 1
    for (int t = 0; t < T; ++t) {
        const float q0 = nq0, q1 = nq1, k0 = nk0, k1 = nk1, vv = nv, beta = nbeta, al = __expf(nla);
        if (t + 1 < T) { const unsigned rn = ro + 8192, rvn = rv + 8192, rbn = rb + 64;
            nq0 = bf2f(UC[rn]); nq1 = bf2f(UC[rn + 64]); nk0 = bf2f(UC[rn + 2048]); nk1 = bf2f(UC[rn + 2048 + 64]);
            nv = bf2f(UC[rvn]); nbeta = BL[rbn]; nla = BL[rbn + 32]; }
        qs[lane] = q0; qs[64 + lane] = q1; ks[lane] = k0; ks[64 + lane] = k1;
        const float qk = wave_sum(q0 * k0 + q1 * k1);
        float c0 = 0.f, c1 = 0.f, c2 = 0.f, c3 = 0.f, o0 = 0.f, o1 = 0.f, o2 = 0.f, o3 = 0.f;
#pragma unroll
        for (int d4 = 0; d4 < 32; ++d4) {
            const f32x4 k4 = *(const LAS f32x4*)(ks + 4 * d4), q4 = *(const LAS f32x4*)(qs + 4 * d4);
            c0 = fmaf(k4[0], S[4 * d4 + 0], c0); c1 = fmaf(k4[1], S[4 * d4 + 1], c1); c2 = fmaf(k4[2], S[4 * d4 + 2], c2); c3 = fmaf(k4[3], S[4 * d4 + 3], c3);
            o0 = fmaf(q4[0], S[4 * d4 + 0], o0); o1 = fmaf(q4[1], S[4 * d4 + 1], o1); o2 = fmaf(q4[2], S[4 * d4 + 2], o2); o3 = fmaf(q4[3], S[4 * d4 + 3], o3);
            if ((d4 & 1) == 1) asm volatile("" ::: "memory");
        }
        const float kS = (c0 + c1) + (c2 + c3), qS = (o0 + o1) + (o2 + o3);
        const float dlt = beta * (vv - al * kS);
#pragma unroll
        for (int d4 = 0; d4 < 32; ++d4) {
            const f32x4 k4 = *(const LAS f32x4*)(ks + 4 * d4);
            S[4 * d4 + 0] = fmaf(k4[0], dlt, al * S[4 * d4 + 0]); S[4 * d4 + 1] = fmaf(k4[1], dlt, al * S[4 * d4 + 1]);
            S[4 * d4 + 2] = fmaf(k4[2], dlt, al * S[4 * d4 + 2]); S[4 * d4 + 3] = fmaf(k4[3], dlt, al * S[4 * d4 + 3]);
            if ((d4 & 1) == 1) asm volatile("" ::: "memory");
        }
        O32[oo] = fmaf(al, qS, qk * dlt);
        ro += 8192; rv += 8192; rb += 64; oo += 6144;
    }
    float* so = a.out() + (grp ? O_GDS : O_GDP); asm volatile("" : "+v"(sidx));
#pragma unroll
    for (int d8 = 0; d8 < 16; ++d8) {
#pragma unroll
        for (int j = 0; j < 8; ++j) so[sidx + j * 128] = S[d8 * 8 + j];
        sidx += 1024; asm volatile("" : "+v"(sidx)); }
}

#define XB_TMO      128
#define XB_XCNT(j)  (256  + 64 * (j))
#define XB_XSUB(j)  (1280 + 64 * (j))
#define XB_XGEN(j)  (2304 + 64 * (j))
#define XB_TOP      3328
#define XB_TOPGEN   3392
#define XCD_BAR_WORDS 3456
#define XB_SPIN_CAP (1u << 18)
__device__ __forceinline__ unsigned xb_ld(unsigned* p)              { return __hip_atomic_load(p, __ATOMIC_RELAXED, __HIP_MEMORY_SCOPE_AGENT); }
__device__ __forceinline__ unsigned xb_add(unsigned* p, unsigned v) { return __hip_atomic_fetch_add(p, v, __ATOMIC_RELAXED, __HIP_MEMORY_SCOPE_AGENT); }
__device__ __forceinline__ unsigned xb_xcc_id() { return (unsigned)__builtin_amdgcn_s_getreg((3 << 11) | 20) & 0xFu; }
#define XB_SPIN(cond, bar) do { unsigned _sp = 0; while (cond) { __builtin_amdgcn_s_sleep(1); \
    if ((++_sp & 255u) == 0u) { if (xb_ld(&(bar)[XB_TMO])) break; if (_sp > XB_SPIN_CAP) { atomicAdd(&(bar)[XB_TMO], 1u); break; } } } } while (0)
__device__ __forceinline__ void xcd_barrier_complete(unsigned* bar, unsigned x, unsigned G, unsigned& nloc, unsigned& nx) {
    unsigned sum, cnt, mine, sp = 0u;
    for (;;) {
        sum = 0u; cnt = 0u; mine = 0u;
#pragma unroll
        for (unsigned j = 0; j < 16; ++j) { const unsigned c = xb_ld(&bar[XB_XCNT(j)]); sum += c; cnt += (c > 0u) ? 1u : 0u; mine = (j == x) ? c : mine; }
        if (sum == G) break;
        __builtin_amdgcn_s_sleep(1);
        if ((++sp & 255u) == 0u) { if (xb_ld(&bar[XB_TMO])) break; if (sp > XB_SPIN_CAP) { atomicAdd(&bar[XB_TMO], 1u); break; } }
    }
    nloc = mine > 0u ? mine : 1u; nx = cnt > 0u ? cnt : 1u;
}
__device__ __forceinline__ void xcd_barrier(unsigned* bar, unsigned x, volatile LAS unsigned* st, int tid, unsigned G) {
    asm volatile("s_waitcnt vmcnt(0)" ::: "memory");
    __syncthreads();
    if (tid == 0) {
        __builtin_amdgcn_s_waitcnt(0);
        unsigned nloc = st[0], nx = st[1];
        if (nloc == 0u) { xcd_barrier_complete(bar, x, G, nloc, nx); st[0] = nloc; st[1] = nx; }
        const unsigned old = xb_add(&bar[XB_XSUB(x)], 1u);
        const unsigned gen = old / nloc;
        if (old + 1u == (gen + 1u) * nloc) {
            __builtin_amdgcn_fence(__ATOMIC_RELEASE, "agent");
            asm volatile("s_waitcnt vmcnt(0)" ::: "memory");
            const unsigned og = xb_add(&bar[XB_TOP], 1u);
            const unsigned tg = og / nx;
            if (og + 1u == (tg + 1u) * nx) xb_add(&bar[XB_TOPGEN], 1u);
            else XB_SPIN(xb_ld(&bar[XB_TOPGEN]) == tg, bar);
            __builtin_amdgcn_fence(__ATOMIC_ACQUIRE, "agent");
            xb_add(&bar[XB_XGEN(x)], 1u);
            asm volatile("s_waitcnt vmcnt(0)" ::: "memory");
        } else {
            XB_SPIN(xb_ld(&bar[XB_XGEN(x)]) == gen, bar);
            __builtin_amdgcn_fence(__ATOMIC_ACQUIRE, "agent");
            asm volatile("s_waitcnt vmcnt(0)" ::: "memory");
        }
    }
    __syncthreads();
}
constexpr int CW_BAR = 4096;
constexpr size_t CTL_ZERO_BYTES = 65536;
constexpr int LDS_ST_OFF = 131072 + 512;

__global__ void __launch_bounds__(NTHREADS, 2) fwd(Args args_unused) {
    extern __shared__ __attribute__((aligned(16))) unsigned char lds_raw[];
    LAS unsigned char* lds = (LAS unsigned char*)lds_raw;
    const int wid = __builtin_amdgcn_readfirstlane(threadIdx.x >> 6);
    const int G = gridDim.x, bx = blockIdx.x;
    const int vcu = (G % 8 == 0) ? (bx % 8) * (G / 8) + bx / 8 : bx;
    const int gw = vcu * NWAVES + wid, NGW = G * NWAVES;
    volatile LAS unsigned* bst = (volatile LAS unsigned*)(lds + LDS_ST_OFF);
    const unsigned xcc = xb_xcc_id();
    { const PA a0 = PA::get(); const int l0 = lane_id_(); if (wid == 0 && l0 < 2) bst[l0] = 0u;
      if (a0.ph_hi() - a0.ph_lo() > 1 && wid == 0 && l0 == 0) (void)xb_add((unsigned*)a0.ws() + CW_BAR + XB_XCNT(xcc), 1u); }
    __syncthreads();
#ifndef PH_MASK
#define PH_MASK 0xffff
#endif
#define IN(k) (((PH_MASK >> (k)) & 1) && ph_in(k))
#define SEAM(k) do { if (IN(k) && IN((k) + 1)) { if ((k) == 0) cg::this_grid().sync(); \
    else { const PA ab = PA::get(); xcd_barrier((unsigned*)ab.ws() + CW_BAR, xcc, bst, wid * 64 + lane_id_(), (unsigned)G); } } } while (0)

    if (IN(0)) { const PA a = PA::get(); unsigned char* ws = a.ws(); const int lane = lane_id_(), tid = wid * 64 + lane; (void)tid;
        for (int cb = vcu; cb < NADA / 64; cb += G) mod_item(a, lds, cb, tid, wid, lane);
        __syncthreads();
        LAS float* scr = (LAS float*)(lds + wid * 16384);
        constexpr int I0 = 32 * 770, I1 = 32 * 64, I2 = 64 * 64, I3 = 32 * 64, I4 = 32 * 256, I5 = 128 * 64, NIT = I0 + I1 + I2 + I3 + I4 + I5;
        bf16* BtIn = (bf16*)(ws + WS_BTIN); bf16* BtOut = (bf16*)(ws + WS_BTOUT); bf16* BtO = (bf16*)(ws + WS_BTO); bf16* BtUp = (bf16*)(ws + WS_BTUP); bf16* BtDn = (bf16*)(ws + WS_BTDN);
        for (int it = gw; it < NIT; it += NGW) {
            int r = it;
            if (r < I0) { const int kb = r / 770, nb = r % 770, n0 = nb * 32; const int nd = n0 < 20480 ? n0 : (n0 < 20544 ? n0 - 20480 + 24576 : n0 - 64);
                transpose_item(a.in(I_WIN), N_IN, BtIn, 2048, kb * 64, n0, nd, scr, lane); continue; } r -= I0;
            if (r < I1) { transpose_item(a.in(I_WOHG), 2048, BtOut, 6144, (r / 64) * 64, (r % 64) * 32, (r % 64) * 32, scr, lane); continue; } r -= I1;
            if (r < I2) { transpose_item(a.in(I_WOGD), 2048, BtOut + 2048, 6144, (r / 64) * 64, (r % 64) * 32, (r % 64) * 32, scr, lane); continue; } r -= I2;
            if (r < I3) { transpose_item(a.in(I_WO), 2048, BtO, 2048, (r / 64) * 64, (r % 64) * 32, (r % 64) * 32, scr, lane); continue; } r -= I3;
            if (r < I4) { transpose_item(a.in(I_WUP), 8192, BtUp, 2048, (r / 256) * 64, (r % 256) * 32, (r % 256) * 32, scr, lane); continue; } r -= I4;
            transpose_item(a.in(I_WDN), 2048, BtDn, 8192, (r / 64) * 64, (r % 64) * 32, (r % 64) * 32, scr, lane);
        }
        { u32x4* z = (u32x4*)(BtIn + (size_t)N_IN * 2048); const int nz = (N_INP - N_IN) * 2048 * 2 / 16;
          for (int i = vcu * NTHREADS + tid; i < nz; i += G * NTHREADS) z[i] = (u32x4){0u, 0u, 0u, 0u}; }
    }
    SEAM(0);
    if (IN(1)) { const PA a = PA::get(); unsigned char* ws = a.ws(); const int lane = lane_id_(), tid = wid * 64 + lane; (void)tid;
        const float* mod = (const float*)(ws + WS_MOD); const float* ng = a.in(I_NG); bf16* A1 = (bf16*)(ws + WS_A1);
        for (int row = gw; row < MROWS; row += NGW) {
            const f32x4* xr = (const f32x4*)xrow_ptr(a, row) + lane; const float* md = mod + (size_t)seq_of_row(row) * NADA;
            f32x4 v[8]; float ss = 0.f;
#pragma unroll
            for (int j = 0; j < 8; ++j) { v[j] = xr[64 * j]; ss += (v[j][0] * v[j][0] + v[j][1] * v[j][1]) + (v[j][2] * v[j][2] + v[j][3] * v[j][3]); }
            const float r = rsqrtf(wave_sum(ss) * (1.f / DM) + EPS);
            u32x2* o = (u32x2*)(A1 + (size_t)row * DM) + lane;
#pragma unroll
            for (int j = 0; j < 8; ++j) { const int c = 4 * lane + 256 * j; const f32x4 g = *(const f32x4*)(ng + c), sh = *(const f32x4*)(md + c), sc = *(const f32x4*)(md + 2048 + c);
                f32x4 y; _Pragma("unroll") for (int e = 0; e < 4; ++e) y[e] = v[j][e] * r * g[e] * (1.f + sc[e]) + sh[e];
                o[64 * j] = (u32x2){pk2(y[0], y[1]), pk2(y[2], y[3])}; }
        }
    }
    SEAM(1);
    if (IN(2)) { const PA a = PA::get(); unsigned char* ws = a.ws(); const int lane = lane_id_(), tid = wid * 64 + lane; (void)tid;
        pg8::Gemm g{(const bf16*)(ws + WS_A1), (const bf16*)(ws + WS_BTIN), 2048, 2048, 2048}; pg8::StaticOrder S; S.init(MROWS, N_INP, G, bx);
        EpiIn E{ws, a.in(I_LB), a.in(I_ALOG), a.in(I_DTB)};
        pg8::gemm_phase<EpiIn, pg8::StaticOrder, true, true>(lds, g, S, E, wid);
    }
    SEAM(2);
    if (IN(3)) { const PA a = PA::get(); unsigned char* ws = a.ws(); const int lane = lane_id_(), tid = wid * 64 + lane; (void)tid;
        const bf16* U = (const bf16*)(ws + WS_U); bf16* UC = (bf16*)(ws + WS_UC); const float* cw = a.in(I_CW); const float* cc = a.in(I_CC);
        for (int it = gw; it < MROWS * 64; it += NGW) {
            const int row = it >> 6, g = it & 63, c = g * 128 + 2 * lane;
            const bool samp = row >= NPROMPT; const int t = samp ? (row - NPROMPT) & 3 : row & 2047;
            float x0 = 0.f, x1 = 0.f;
#pragma unroll
            for (int j = 0; j < 4; ++j) {
                const int tt = t - 3 + j; float u0 = 0.f, u1 = 0.f;
                if (tt >= 0) { const unsigned w = *(const unsigned*)(U + (size_t)(row - 3 + j) * CONVCH + c); u0 = bflo(w); u1 = bfhi(w); }
                else if (samp) { const int b = (row - NPROMPT) >> 2; const f32x2 w = *(const f32x2*)(cc + ((size_t)b * 3 + (3 + tt)) * CONVCH + c); u0 = w[0]; u1 = w[1]; }
                const f32x2 wj = *(const f32x2*)(cw + (size_t)j * CONVCH + c);
                x0 = fmaf(wj[0], u0, x0); x1 = fmaf(wj[1], u1, x1);
            }
            x0 = siluf_(x0); x1 = siluf_(x1);
            if (g < 32) { const float ss = wave_sum(x0 * x0 + x1 * x1); float r = rsqrtf(ss + EPS); if (g < 16) r *= 0.08838834764831845f; x0 *= r; x1 *= r; }
            *(unsigned*)(UC + (size_t)row * CONVCH + c) = pk2(x0, x1);
        }
        for (int i = vcu * NTHREADS + tid; i < (12 + 384) * (CONVCH / 2); i += G * NTHREADS) {
            const int rr = i / (CONVCH / 2), c = (i % (CONVCH / 2)) * 2; int srow; float* dst;
            if (rr < 12) { const int b = rr / 3, j = rr % 3; srow = b * SEQ + SEQ - 3 + j; dst = a.out() + O_CCP + (size_t)rr * CONVCH + c; }
            else { const int r2 = rr - 12, b = r2 / 3, j = r2 % 3; srow = NPROMPT + b * DSEQ + 1 + j; dst = a.out() + O_CCS + (size_t)r2 * CONVCH + c; }
            const unsigned w = *(const unsigned*)(U + (size_t)srow * CONVCH + c);
            *(f32x2*)dst = (f32x2){bflo(w), bfhi(w)};
        }
    }
    SEAM(3);
    if (IN(4)) { const PA a = PA::get(); unsigned char* ws = a.ws(); const int lane = lane_id_(), tid = wid * 64 + lane; (void)tid;
        LAS float* wl = (LAS float*)(lds + wid * 4096);
        constexpr int NI_HP = 128, NI_GP = 256, NI_HS = 4096, NI_GS = 8192, NI = NI_HP + NI_GP + NI_HS + NI_GS;
        for (int it = wid * G + bx; it < NI; it += NGW) {
            int r = it, kind, grp;
            if (r < NI_HP) { kind = 0; grp = 0; } else if ((r -= NI_HP) < NI_GP) { kind = 1; grp = 0; } else if ((r -= NI_GP) < NI_HS) { kind = 0; grp = 1; } else { r -= NI_HS; kind = 1; grp = 1; }
            if (kind == 0) hgrn_item(a, wl, grp, r >> 5, (r >> 1) & 15, r & 1, lane);
            else gdn_item(a, wl, grp, r >> 6, (r >> 1) & 31, r & 1, lane);
        }
    }
    SEAM(4);
    if (IN(5)) { const PA a = PA::get(); unsigned char* ws = a.ws(); const int lane = lane_id_(), tid = wid * 64 + lane; (void)tid;
        const float* O32 = (const float*)(ws + WS_O32); bf16* OA = (bf16*)(ws + WS_OA); const bf16* Gh = (const bf16*)(ws + WS_GH); const bf16* Gz = (const bf16*)(ws + WS_GZ);
        for (int it = gw; it < MROWS * 48; it += NGW) {
            const int row = it / 48, hd = it % 48; const size_t co = (size_t)row * 6144 + hd * 128 + 2 * lane;
            const f32x2 o = *(const f32x2*)(O32 + co);
            const float r = rsqrtf(wave_sum(o[0] * o[0] + o[1] * o[1]) * (1.f / 128.f) + EPS);
            const f32x2 g = *(const f32x2*)((hd < 16 ? a.in(I_HGN) : a.in(I_GDN)) + 2 * lane);
            const unsigned gt = hd < 16 ? *(const unsigned*)(Gh + (size_t)row * 2048 + hd * 128 + 2 * lane) : *(const unsigned*)(Gz + (size_t)row * 4096 + (hd - 16) * 128 + 2 * lane);
            *(unsigned*)(OA + co) = pk2(o[0] * r * g[0] * bflo(gt), o[1] * r * g[1] * bfhi(gt));
        }
    }
    SEAM(5);
    if (IN(6)) { const PA a = PA::get(); unsigned char* ws = a.ws(); const int lane = lane_id_(), tid = wid * 64 + lane; (void)tid;
        pg8::Gemm g{(const bf16*)(ws + WS_OA), (const bf16*)(ws + WS_BTOUT), 6144, 6144, 2048}; pg8::StaticOrder S; S.init(MROWS, 2048, G, bx);
        EpiOut1 E{(float*)(ws + WS_T1), (const bf16*)(ws + WS_SA)};
        pg8::gemm_phase<EpiOut1, pg8::StaticOrder, true, true>(lds, g, S, E, wid);
    }
    SEAM(6);
    if (IN(7)) { const PA a = PA::get(); unsigned char* ws = a.ws(); const int lane = lane_id_(), tid = wid * 64 + lane; (void)tid;
        pg8::Gemm g{(const bf16*)(ws + WS_OA) + 2048, (const bf16*)(ws + WS_BTOUT) + 2048, 6144, 6144, 4096}; pg8::StaticOrder S; S.init(MROWS, 2048, G, bx);
        EpiOut2 E{(const float*)(ws + WS_T1), (const bf16*)(ws + WS_SB), (bf16*)(ws + WS_MG)};
        pg8::gemm_phase<EpiOut2, pg8::StaticOrder, true, true>(lds, g, S, E, wid);
    }
    SEAM(7);
    if (IN(8)) { const PA a = PA::get(); unsigned char* ws = a.ws(); const int lane = lane_id_(), tid = wid * 64 + lane; (void)tid;
        pg8::Gemm g{(const bf16*)(ws + WS_MG), (const bf16*)(ws + WS_BTO), 2048, 2048, 2048}; pg8::StaticOrder S; S.init(MROWS, 2048, G, bx);
        EpiF32 E{(float*)(ws + WS_MIX), 2048};
        pg8::gemm_phase<EpiF32, pg8::StaticOrder, true, true>(lds, g, S, E, wid);
    }
    SEAM(8);
    if (IN(9)) { const PA a = PA::get(); unsigned char* ws = a.ws(); const int lane = lane_id_(), tid = wid * 64 + lane; (void)tid;
        const float* mod = (const float*)(ws + WS_MOD); const float* ng = a.in(I_NG); bf16* A1 = (bf16*)(ws + WS_A1); const float* MIX = (const float*)(ws + WS_MIX); float* H = (float*)(ws + WS_H);
        for (int row = gw; row < MROWS; row += NGW) {
            const f32x4* xr = (const f32x4*)xrow_ptr(a, row) + lane; const f32x4* mr = (const f32x4*)(MIX + (size_t)row * DM) + lane; const float* md = mod + (size_t)seq_of_row(row) * NADA;
            f32x4 v[8]; float ss = 0.f;
#pragma unroll
            for (int j = 0; j < 8; ++j) { v[j] = mr[64 * j]; ss += (v[j][0] * v[j][0] + v[j][1] * v[j][1]) + (v[j][2] * v[j][2] + v[j][3] * v[j][3]); }
            const float r1 = rsqrtf(wave_sum(ss) * (1.f / DM) + EPS);
            f32x4* ho = (f32x4*)(H + (size_t)row * DM) + lane; float s2 = 0.f;
#pragma unroll
            for (int j = 0; j < 8; ++j) { const int c = 4 * lane + 256 * j; const f32x4 g = *(const f32x4*)(ng + 2048 + c), g1 = *(const f32x4*)(md + 4096 + c), x = xr[64 * j];
                _Pragma("unroll") for (int e = 0; e < 4; ++e) { v[j][e] = x[e] + g1[e] * (v[j][e] * r1 * g[e]); s2 += v[j][e] * v[j][e]; }
                ho[64 * j] = v[j]; }
            const float r2 = rsqrtf(wave_sum(s2) * (1.f / DM) + EPS);
            u32x2* o = (u32x2*)(A1 + (size_t)row * DM) + lane;
#pragma unroll
            for (int j = 0; j < 8; ++j) { const int c = 4 * lane + 256 * j; const f32x4 g = *(const f32x4*)(ng + 4096 + c), sh = *(const f32x4*)(md + 6144 + c), sc = *(const f32x4*)(md + 8192 + c);
                f32x4 y; _Pragma("unroll") for (int e = 0; e < 4; ++e) y[e] = v[j][e] * r2 * g[e] * (1.f + sc[e]) + sh[e];
                o[64 * j] = (u32x2){pk2(y[0], y[1]), pk2(y[2], y[3])}; }
        }
    }
    SEAM(9);
    if (IN(10)) { const PA a = PA::get(); unsigned char* ws = a.ws(); const int lane = lane_id_(), tid = wid * 64 + lane; (void)tid;
        pg8::Gemm g{(const bf16*)(ws + WS_A1), (const bf16*)(ws + WS_BTUP), 2048, 2048, 2048}; pg8::StaticOrder S; S.init(MROWS, DFF, G, bx);
        EpiRelu2 E{(bf16*)(ws + WS_U2), DFF};
        pg8::gemm_phase<EpiRelu2, pg8::StaticOrder, true, true>(lds, g, S, E, wid);
    }
    SEAM(10);
    if (IN(11)) { const PA a = PA::get(); unsigned char* ws = a.ws(); const int lane = lane_id_(), tid = wid * 64 + lane; (void)tid;
        pg8::Gemm g{(const bf16*)(ws + WS_U2), (const bf16*)(ws + WS_BTDN), DFF, DFF, DFF}; pg8::StaticOrder S; S.init(MROWS, 2048, G, bx);
        EpiF32 E{(float*)(ws + WS_FF), 2048};
        pg8::gemm_phase<EpiF32, pg8::StaticOrder, true, true>(lds, g, S, E, wid);
    }
    SEAM(11);
    if (IN(12)) { const PA a = PA::get(); unsigned char* ws = a.ws(); const int lane = lane_id_(), tid = wid * 64 + lane; (void)tid;
        const float* mod = (const float*)(ws + WS_MOD); const float* ng = a.in(I_NG); const float* FF = (const float*)(ws + WS_FF); const float* H = (const float*)(ws + WS_H);
        for (int row = gw; row < MROWS; row += NGW) {
            const f32x4* fr_ = (const f32x4*)(FF + (size_t)row * DM) + lane; const f32x4* hr = (const f32x4*)(H + (size_t)row * DM) + lane; const float* md = mod + (size_t)seq_of_row(row) * NADA;
            f32x4 v[8]; float ss = 0.f;
#pragma unroll
            for (int j = 0; j < 8; ++j) { v[j] = fr_[64 * j]; ss += (v[j][0] * v[j][0] + v[j][1] * v[j][1]) + (v[j][2] * v[j][2] + v[j][3] * v[j][3]); }
            const float r = rsqrtf(wave_sum(ss) * (1.f / DM) + EPS);
            f32x4* yo = (f32x4*)(a.out() + O_Y + (size_t)row * DM) + lane;
#pragma unroll
            for (int j = 0; j < 8; ++j) { const int c = 4 * lane + 256 * j; const f32x4 g = *(const f32x4*)(ng + 6144 + c), g2 = *(const f32x4*)(md + 10240 + c), h = hr[64 * j];
                f32x4 y; _Pragma("unroll") for (int e = 0; e < 4; ++e) y[e] = h[e] + g2[e] * (v[j][e] * r * g[e]);
                yo[64 * j] = y; }
        }
    }
#undef IN
#undef SEAM
}

constexpr int N_PHASES = 13;
extern "C" void kernel_launch(void* const* d_in, const int* in_sizes, int n_in, void* d_out, int out_size, void* d_ws, size_t ws_size, hipStream_t stream) {
    static int grid = 0;
    if (grid == 0) {
        if (n_in != 22 || (size_t)out_size != O_END || ws_size < WS_END) { fprintf(stderr, "kernel_launch: unexpected shapes: n_in %d out %d ws %zu\n", n_in, out_size, ws_size); grid = -1; return; }
        int dev = 0, cus = 0, per_cu = 0;
        if (hipGetDevice(&dev) != hipSuccess || hipDeviceGetAttribute(&cus, hipDeviceAttributeMultiprocessorCount, dev) != hipSuccess) { grid = -1; return; }
        if (hipFuncSetAttribute((const void*)fwd, hipFuncAttributeMaxDynamicSharedMemorySize, LDS_BYTES) != hipSuccess) { fprintf(stderr, "kernel_launch: hipFuncSetAttribute failed\n"); grid = -1; return; }
        if (hipOccupancyMaxActiveBlocksPerMultiprocessor(&per_cu, (const void*)fwd, NTHREADS, LDS_BYTES) != hipSuccess || per_cu < 1) { fprintf(stderr, "kernel_launch: occupancy query says %d\n", per_cu); (void)hipGetLastError(); per_cu = 1; }
        grid = cus;
    }
    if (grid < 0) return;
    if (hipMemsetAsync(d_ws, 0, CTL_ZERO_BYTES, stream) != hipSuccess) { fprintf(stderr, "kernel_launch: memset failed\n"); return; }
    Args a{};
    for (int i = 0; i < 22; ++i) a.in[i] = (const float*)d_in[i];
    a.out = (float*)d_out; a.ws = (unsigned char*)d_ws;
#ifdef MULTI_LAUNCH
    for (int p = 0; p < N_PHASES; ++p) { a.ph_lo = p; a.ph_hi = p + 1; hipLaunchKernelGGL(fwd, dim3(grid), dim3(NTHREADS), LDS_BYTES, stream, a); }
#else
    a.ph_lo = 0; a.ph_hi = N_PHASES;
    void* args[] = {&a};
    hipError_t e = hipLaunchCooperativeKernel((const void*)fwd, dim3(grid), dim3(NTHREADS), args, LDS_BYTES, stream);
    if (e != hipSuccess) fprintf(stderr, "cooperative launch failed: %s (grid %d)\n", hipGetErrorString(e), grid);
#endif
}
```

```cpp
#include <hip/hip_runtime.h>
#include <hip/hip_cooperative_groups.h>
#include <cstdio>
#include <cstdint>
namespace cg = cooperative_groups;
__device__ __forceinline__ int lane_id_() { int l; asm volatile("v_mbcnt_lo_u32_b32 %0, -1, 0\n\tv_mbcnt_hi_u32_b32 %0, -1, %0" : "=v"(l)); return l; }
namespace pg8 {
#define PG8_LAS __attribute__((address_space(3)))
typedef unsigned short bf16_t;
typedef short bf16x8 __attribute__((ext_vector_type(8)));
typedef float f32x4 __attribute__((ext_vector_type(4)));
typedef unsigned u32x4 __attribute__((ext_vector_type(4)));
constexpr int BM = 256, BK = 64, HALF = 128, HTB = HALF * BK * 2  , STAGE_BYTES = 8 * HTB, NXCD = 8, WGM = 8;

__host__ __device__ __forceinline__ int lds_byte(int r, int c) { const int st = (r >> 4) * 2 + (c >> 5), rr = r & 15, cc = c & 31, ob = rr * 64 + cc * 2; return st * 1024 + (ob ^ (((ob >> 9) & 1) << 5)); }
__host__ __device__ __forceinline__ void stage_rc(int b, int& R, int& C) { const int st = b / 1024, sb = b % 1024, swz = sb ^ (((sb >> 9) & 1) << 5); R = (st >> 1) * 16 + swz / 64; C = (st & 1) * 32 + (swz % 64) / 2; }
__host__ __device__ __forceinline__ int perm32(int rho) { const int n = rho >> 4, i = rho & 15; return 8 * (i >> 2) + 4 * n + (i & 3); }

struct Unit { int pm, pn; };
struct Gemm { const bf16_t* A; const bf16_t* Bt; int lda, ldb, K; };

struct StaticOrder {
    int nM, nN, nwg, G, c;
    __host__ __device__ void init(int M, int N, int G_, int c_) { nM = M / BM; nN = N / BM; nwg = nM * nN; G = G_; c = c_; }
    __host__ __device__ bool next(int i, Unit& u) const {
        const long L = (long)i * G + c; if (L >= nwg) return false;
        int wgid = (int)L; { const int q = nwg / NXCD, r = nwg % NXCD, xcd = wgid % NXCD, off = wgid / NXCD; wgid = (xcd < r ? xcd * (q + 1) : r * (q + 1) + (xcd - r) * q) + off; }
        const int nig = WGM * nN, gid = wgid / nig, fm = gid * WGM, gsz = (nM - fm) < WGM ? (nM - fm) : WGM;
        u.pm = fm + ((wgid % nig) % gsz); u.pn = (wgid % nig) / gsz; return true;
    }
    __device__ __forceinline__ void a_ready(const Unit&) const {}
    __device__ __forceinline__ void done(const Unit&) const {}
};

__device__ __forceinline__ unsigned cvt_pk_bf16(float lo, float hi) { unsigned r; asm volatile("v_cvt_pk_bf16_f32 %0, %1, %2" : "=v"(r) : "v"(lo), "v"(hi)); return r; }

template <class Epi, class Sched, bool ALIGN_EPI = false, bool SP2 = false>
__device__ __forceinline__ void gemm_phase(PG8_LAS unsigned char* lds, const Gemm g, const Sched& S, const Epi& E, int wid_in) {
    const int wid = wid_in, lane = lane_id_(), tid = wid * 64 + lane, wr = wid >> 2, wc = wid & 3, fr = lane & 15, fq = lane >> 4;
    const int K = g.K, nt = K / BK;
    unsigned voffA[2], voffB[2];
#pragma unroll
    for (int i = 0; i < 2; ++i) { int R, C; stage_rc(tid * 16 + i * 8192, R, C); const int Rb = Epi::PERM ? ((R & ~31) + perm32(R & 31)) : R;
        voffA[i] = (unsigned)(R * g.lda + C) * 2u; voffB[i] = (unsigned)(Rb * g.ldb + C) * 2u; }
    const size_t kstep = (size_t)(BK * 2);
    const size_t hstepA = (size_t)HALF * g.lda * 2, hstepB = (size_t)HALF * g.ldb * 2;
    const size_t tstepA = 2 * hstepA, tstepB = 2 * hstepB;
    const unsigned ldsw = (unsigned)wid * 1024u;
    const int aoff = lds_byte(wr * 64 + fr, fq * 8), boff = lds_byte(wc * 32 + fr, fq * 8);
#define PG8_SA(b, h) (((b) * 2 + (h)) * HTB)
#define PG8_SB(b, h) ((4 + (b) * 2 + (h)) * HTB)
#define PG8_STAGE(bufoff, gbase, voff) do { _Pragma("unroll") for (int _i = 0; _i < 2; ++_i) \
        __builtin_amdgcn_global_load_lds((const unsigned*)((const char*)(gbase) + (voff)[_i]), (PG8_LAS unsigned*)(lds + (bufoff) + ldsw + _i * 8192), 16, 0, 0); } while (0)
#define PG8_LDA(dst, b, h) do { _Pragma("unroll") for (int m = 0; m < 4; ++m) _Pragma("unroll") for (int k = 0; k < 2; ++k) dst[m][k] = *(const PG8_LAS bf16x8*)(lds + PG8_SA(b, h) + aoff + m * 2048 + k * 1024); } while (0)
#define PG8_LDB(dst, b, h) do { _Pragma("unroll") for (int n = 0; n < 2; ++n) _Pragma("unroll") for (int k = 0; k < 2; ++k) dst[n][k] = *(const PG8_LAS bf16x8*)(lds + PG8_SB(b, h) + boff + n * 2048 + k * 1024); } while (0)
#define PG8_MMA(ai, bj, At, Bt) do { __builtin_amdgcn_s_setprio(1); _Pragma("unroll") for (int m = 0; m < 4; ++m) _Pragma("unroll") for (int n = 0; n < 2; ++n) _Pragma("unroll") for (int k = 0; k < 2; ++k) \
        acc[ai][bj][m][n] = __builtin_amdgcn_mfma_f32_16x16x32_bf16(Bt[n][k], At[m][k], acc[ai][bj][m][n], 0, 0, 0); __builtin_amdgcn_s_setprio(0); } while (0)
#define PG8_WAIT_V(n) asm volatile("s_waitcnt vmcnt(" #n ")" ::: "memory")
#define PG8_WAIT_L(n) asm volatile("s_waitcnt lgkmcnt(" #n ")" ::: "memory")
#define PG8_BAR __builtin_amdgcn_s_barrier()
#define PG8_SCHED __builtin_amdgcn_sched_barrier(0)
    Unit cur, nxt; int ui = 0;
    if (!S.next(0, cur)) return;
    f32x4 acc[2][2][4][2];
#pragma unroll
    for (int a = 0; a < 2; ++a)
#pragma unroll
        for (int b = 0; b < 2; ++b)
#pragma unroll
            for (int m = 0; m < 4; ++m)
#pragma unroll
                for (int n = 0; n < 2; ++n) acc[a][b][m][n] = (f32x4){0.f, 0.f, 0.f, 0.f};
    bf16x8 At[4][2], B0[2][2], B1[2][2];
    const char* cA = (const char*)g.A + (size_t)cur.pm * tstepA; const char* cB = (const char*)g.Bt + (size_t)cur.pn * tstepB;
    S.a_ready(cur);
    if constexpr (SP2) {
        PG8_STAGE(PG8_SB(0, 0), cB, voffB); PG8_STAGE(PG8_SB(0, 1), cB + hstepB, voffB); PG8_STAGE(PG8_SA(0, 0), cA, voffA); PG8_STAGE(PG8_SA(0, 1), cA + hstepA, voffA);
        if (wr == 1) PG8_BAR;
        PG8_WAIT_V(2); PG8_BAR;
        PG8_STAGE(PG8_SB(1, 0), cB + kstep, voffB); PG8_STAGE(PG8_SA(1, 0), cA + kstep, voffA); PG8_STAGE(PG8_SB(1, 1), cB + hstepB + kstep, voffB);
        PG8_WAIT_V(6); PG8_BAR;
    } else {
        PG8_STAGE(PG8_SB(0, 0), cB, voffB); PG8_STAGE(PG8_SA(0, 0), cA, voffA); PG8_STAGE(PG8_SB(0, 1), cB + hstepB, voffB); PG8_STAGE(PG8_SA(0, 1), cA + hstepA, voffA);
        if (wr == 1) PG8_BAR;
        PG8_WAIT_V(4); PG8_BAR;
        PG8_STAGE(PG8_SB(1, 0), cB + kstep, voffB); PG8_STAGE(PG8_SA(1, 0), cA + kstep, voffA); PG8_STAGE(PG8_SB(1, 1), cB + hstepB + kstep, voffB);
        PG8_WAIT_V(6); PG8_BAR;
    }
    for (;;) {
        const bool has_next = S.next(ui + 1, nxt);
        const char* nA = has_next ? (const char*)g.A + (size_t)nxt.pm * tstepA : cA; const char* nB = has_next ? (const char*)g.Bt + (size_t)nxt.pn * tstepB : cB;
        for (int t = 0; t < nt; t += 2) {
            const bool last = (t == nt - 2);
            const char* a1 = cA + (size_t)(t + 1) * kstep;
            const char* a2 = last ? nA : cA + (size_t)(t + 2) * kstep; const char* b2 = last ? nB : cB + (size_t)(t + 2) * kstep;
            const char* a3 = a2 + kstep; const char* b3 = b2 + kstep;
            if (last && has_next) S.a_ready(nxt);
            if constexpr (SP2) {
            PG8_LDB(B0, 0, 0); PG8_LDB(B1, 0, 1); PG8_SCHED; PG8_LDA(At, 0, 0); PG8_STAGE(PG8_SA(1, 1), a1 + hstepA, voffA);
            PG8_WAIT_V(8); PG8_WAIT_L(0); PG8_BAR; PG8_MMA(0, 0, At, B0); PG8_MMA(0, 1, At, B1); PG8_BAR; PG8_SCHED;
            PG8_LDA(At, 0, 1); PG8_STAGE(PG8_SB(0, 0), b2, voffB); PG8_STAGE(PG8_SB(0, 1), b2 + hstepB, voffB); PG8_STAGE(PG8_SA(0, 0), a2, voffA);
            PG8_WAIT_V(8); PG8_WAIT_L(0); PG8_BAR; PG8_MMA(1, 0, At, B0); PG8_MMA(1, 1, At, B1); PG8_BAR; PG8_SCHED;
            PG8_LDB(B0, 1, 0); PG8_LDB(B1, 1, 1); PG8_SCHED; PG8_LDA(At, 1, 0); PG8_STAGE(PG8_SA(0, 1), a2 + hstepA, voffA);
            PG8_WAIT_V(8); PG8_WAIT_L(0); PG8_BAR; PG8_MMA(0, 0, At, B0); PG8_MMA(0, 1, At, B1); PG8_BAR; PG8_SCHED;
            PG8_LDA(At, 1, 1); PG8_STAGE(PG8_SB(1, 0), b3, voffB); PG8_STAGE(PG8_SB(1, 1), b3 + hstepB, voffB); PG8_STAGE(PG8_SA(1, 0), a3, voffA);
            PG8_WAIT_V(8); PG8_WAIT_L(0); PG8_BAR; PG8_MMA(1, 0, At, B0); PG8_MMA(1, 1, At, B1); PG8_BAR; PG8_SCHED;
            } else {
            PG8_LDB(B0, 0, 0); PG8_SCHED; PG8_LDA(At, 0, 0); PG8_STAGE(PG8_SA(1, 1), a1 + hstepA, voffA);
            PG8_WAIT_L(8); PG8_BAR; PG8_WAIT_L(0); PG8_MMA(0, 0, At, B0); PG8_BAR; PG8_SCHED;
            PG8_LDB(B1, 0, 1); PG8_STAGE(PG8_SB(0, 0), b2, voffB);
            PG8_BAR; PG8_WAIT_L(0); PG8_MMA(0, 1, At, B1); PG8_BAR;
            PG8_LDA(At, 0, 1); PG8_STAGE(PG8_SA(0, 0), a2, voffA);
            PG8_BAR; PG8_WAIT_L(0); PG8_MMA(1, 0, At, B0); PG8_BAR; PG8_SCHED;
            PG8_STAGE(PG8_SB(0, 1), b2 + hstepB, voffB);
            PG8_WAIT_V(6); PG8_BAR; PG8_MMA(1, 1, At, B1); PG8_BAR;
            PG8_LDB(B0, 1, 0); PG8_SCHED; PG8_LDA(At, 1, 0); PG8_STAGE(PG8_SA(0, 1), a2 + hstepA, voffA);
            PG8_WAIT_L(8); PG8_BAR; PG8_WAIT_L(0); PG8_MMA(0, 0, At, B0); PG8_BAR; PG8_SCHED;
            PG8_LDB(B1, 1, 1); PG8_STAGE(PG8_SB(1, 0), b3, voffB);
            PG8_BAR; PG8_WAIT_L(0); PG8_MMA(0, 1, At, B1); PG8_BAR;
            PG8_LDA(At, 1, 1); PG8_STAGE(PG8_SA(1, 0), a3, voffA);
            PG8_BAR; PG8_WAIT_L(0); PG8_MMA(1, 0, At, B0); PG8_BAR; PG8_SCHED;
            PG8_STAGE(PG8_SB(1, 1), b3 + hstepB, voffB);
            PG8_WAIT_V(6); PG8_BAR; PG8_MMA(1, 1, At, B1); PG8_BAR;
            }
        }
        if constexpr (ALIGN_EPI) { if (wr == 0) PG8_BAR; }
        if constexpr (!Epi::AFTER_DRAIN) { E(acc, cur, wr, wc, fr, fq); S.done(cur); }
        if (!has_next) break;
#pragma unroll
        for (int a = 0; a < 2; ++a)
#pragma unroll
            for (int b = 0; b < 2; ++b)
#pragma unroll
                for (int m = 0; m < 4; ++m)
#pragma unroll
                    for (int n = 0; n < 2; ++n) acc[a][b][m][n] = (f32x4){0.f, 0.f, 0.f, 0.f};
        cur = nxt; cA = nA; cB = nB; ++ui;
        if constexpr (ALIGN_EPI) { if (wr == 1) PG8_BAR; }
    }
    PG8_WAIT_V(0);
    if constexpr (!ALIGN_EPI) { if (wr == 0) PG8_BAR; }
    PG8_BAR;
    if constexpr (Epi::AFTER_DRAIN) { E.fused(acc, cur, wr, wc, fr, fq, lds, wid, lane); S.done(cur); }
#undef PG8_SA
#undef PG8_SB
#undef PG8_STAGE
#undef PG8_LDA
#undef PG8_LDB
#undef PG8_MMA
#undef PG8_WAIT_V
#undef PG8_WAIT_L
#undef PG8_BAR
#undef PG8_SCHED
}
}


#define LAS __attribute__((address_space(3)))
typedef unsigned short bf16;
typedef float f32x4 __attribute__((ext_vector_type(4)));
typedef float f32x2 __attribute__((ext_vector_type(2)));
typedef short bf16x8 __attribute__((ext_vector_type(8)));
typedef unsigned u32x4 __attribute__((ext_vector_type(4)));
typedef unsigned u32x2 __attribute__((ext_vector_type(2)));

constexpr int NWAVES = 8, NTHREADS = 512;
constexpr int DM = 2048, MROWS = 8704, NPROMPT = 8192, NSEQ = 132, SEQ = 2048, DSEQ = 4;
constexpr int N_IN = 24640, N_INP = 24832, CONVCH = 8192, DFF = 8192, NADA = 12288;
constexpr float EPS = 1e-6f;
constexpr int LDS_BYTES = 147456;

enum { I_XP = 0, I_XS, I_SHG, I_SGD, I_CC, I_CP, I_CS, I_LB, I_WADA, I_BADA, I_NG, I_WIN, I_CW, I_ALOG, I_DTB, I_HGN, I_GDN, I_WOHG, I_WOGD, I_WO, I_WUP, I_WDN };
constexpr size_t O_Y = 0, O_HGP = 17825792, O_GDP = 18874368, O_CCP = 20971520, O_HGS = 21069824, O_GDS = 54624256, O_CCS = 121733120, O_END = 124878848;
constexpr size_t MiB = 1u << 20;
constexpr size_t WS_MOD = 1 * MiB, WS_BTOUT = 8 * MiB, WS_BTO = 32 * MiB, WS_BTUP = 40 * MiB, WS_BTDN = 72 * MiB, WS_BTIN = 104 * MiB, WS_A1 = 201 * MiB;
constexpr size_t WS_QHP = 235 * MiB, WS_FP = 267 * MiB, WS_IP = 331 * MiB, WS_UP = 363 * MiB, WS_GH = 491 * MiB, WS_GZ = 525 * MiB, WS_SA = 593 * MiB, WS_SB = 627 * MiB, WS_BL = 661 * MiB;
constexpr size_t WS_QHS = 664 * MiB, WS_FS = 666 * MiB, WS_IS = 670 * MiB, WS_US = 672 * MiB;
constexpr size_t WS_GREC = 680 * MiB, WS_HREC = 104 * MiB, WS_UCS = 218 * MiB, WS_O16 = 235 * MiB;
constexpr size_t WS_OA = 363 * MiB, WS_T1 = 680 * MiB, WS_MG = 748 * MiB, WS_MIX = 782 * MiB, WS_H = 850 * MiB, WS_U2 = 235 * MiB, WS_FF = 782 * MiB;
constexpr size_t WS_END = 970 * MiB;

__device__ __forceinline__ unsigned f2bf(float f) { unsigned u = __float_as_uint(f); return (u + 0x7fffu + ((u >> 16) & 1u)) >> 16; }
typedef float f32x2c_t __attribute__((ext_vector_type(2))); typedef __bf16 bf16x2c_t __attribute__((ext_vector_type(2)));
__device__ __forceinline__ unsigned pk2(float lo, float hi) { f32x2c_t v = {lo, hi}; bf16x2c_t b = __builtin_convertvector(v, bf16x2c_t); return __builtin_bit_cast(unsigned, b); }
__device__ __forceinline__ float bf2f(unsigned h) { return __uint_as_float(h << 16); }
__device__ __forceinline__ float bflo(unsigned w) { return __uint_as_float(w << 16); }
__device__ __forceinline__ float bfhi(unsigned w) { return __uint_as_float(w & 0xffff0000u); }
__device__ __forceinline__ float sigmoidf_(float x) { return __builtin_amdgcn_rcpf(1.0f + __expf(-x)); }
__device__ __forceinline__ float siluf_(float x) { return x * sigmoidf_(x); }
__device__ __forceinline__ float wave_sum(float v) {
#pragma unroll
    for (int o = 1; o < 64; o <<= 1) v += __shfl_xor(v, o);
    return v;
}
__device__ __forceinline__ float wave_sum_sw(float v) {
    v += __builtin_bit_cast(float, __builtin_amdgcn_ds_swizzle(__builtin_bit_cast(int, v), (1 << 10) | 0x1f));
    v += __builtin_bit_cast(float, __builtin_amdgcn_ds_swizzle(__builtin_bit_cast(int, v), (2 << 10) | 0x1f));
    v += __builtin_bit_cast(float, __builtin_amdgcn_ds_swizzle(__builtin_bit_cast(int, v), (4 << 10) | 0x1f));
    v += __builtin_bit_cast(float, __builtin_amdgcn_ds_swizzle(__builtin_bit_cast(int, v), (8 << 10) | 0x1f));
    v += __builtin_bit_cast(float, __builtin_amdgcn_ds_swizzle(__builtin_bit_cast(int, v), (16 << 10) | 0x1f));
    return __builtin_bit_cast(float, __builtin_amdgcn_readlane(__builtin_bit_cast(int, v), 0)) + __builtin_bit_cast(float, __builtin_amdgcn_readlane(__builtin_bit_cast(int, v), 32));
}
#define LDS_WAIT() asm volatile("s_waitcnt lgkmcnt(0)" ::: "memory")

struct Args { const float* in[22]; float* out; unsigned char* ws; int ph_lo, ph_hi; };
typedef __attribute__((address_space(4))) const unsigned char* kargp_t;
struct PA {
    kargp_t kp;
    static __device__ __forceinline__ PA get() { PA p; p.kp = (kargp_t)__builtin_amdgcn_kernarg_segment_ptr(); asm volatile("" : "+s"(p.kp)); return p; }
    __device__ __forceinline__ const float* in(int i) const { typedef const float* cfp; return ((__attribute__((address_space(4))) const cfp*)kp)[i]; }
    __device__ __forceinline__ float* out() const { typedef float* fp; return *((__attribute__((address_space(4))) const fp*)(kp + 176)); }
    __device__ __forceinline__ unsigned char* ws() const { typedef unsigned char* up; return *((__attribute__((address_space(4))) const up*)(kp + 184)); }
    __device__ __forceinline__ int ph_lo() const { return *((__attribute__((address_space(4))) const int*)(kp + 192)); }
    __device__ __forceinline__ int ph_hi() const { return *((__attribute__((address_space(4))) const int*)(kp + 196)); }
};
static_assert(sizeof(Args) == 200, "Args layout");
__device__ __forceinline__ bool ph_in(int k) { const PA p = PA::get(); return p.ph_lo() <= k && k < p.ph_hi(); }

template <int MODE> __device__ __forceinline__ float actf(float v) {
    if (MODE == 1) return siluf_(v);
    if (MODE == 2) return sigmoidf_(v);
    if (MODE == 3) { const float r = fmaxf(v, 0.f); return r * r; }
    return v;
}
template <int MODE> __device__ __forceinline__ void tile_store_bf16(const f32x4 (&acc)[2][2][4][2], bf16* base, int ld, int row0, int col0) {
#pragma unroll
    for (int ai = 0; ai < 2; ++ai)
#pragma unroll
        for (int m = 0; m < 4; ++m) {
            bf16* rowp = base + (size_t)(row0 + ai * 128 + m * 16) * ld + col0;
#pragma unroll
            for (int bj = 0; bj < 2; ++bj) {
                const f32x4 v0 = acc[ai][bj][m][0], v1 = acc[ai][bj][m][1];
                u32x4 w;
                w.x = pk2(actf<MODE>(v0[0]), actf<MODE>(v0[1])); w.y = pk2(actf<MODE>(v0[2]), actf<MODE>(v0[3]));
                w.z = pk2(actf<MODE>(v1[0]), actf<MODE>(v1[1])); w.w = pk2(actf<MODE>(v1[2]), actf<MODE>(v1[3]));
                *(u32x4*)(rowp + bj * 128) = w;
            }
        }
}
__device__ __forceinline__ void tile_store_f32(const f32x4 (&acc)[2][2][4][2], float* base, int ld, int row0, int col0) {
#pragma unroll
    for (int ai = 0; ai < 2; ++ai)
#pragma unroll
        for (int m = 0; m < 4; ++m) {
            float* rowp = base + (size_t)(row0 + ai * 128 + m * 16) * ld + col0;
#pragma unroll
            for (int bj = 0; bj < 2; ++bj) { *(f32x4*)(rowp + bj * 128) = acc[ai][bj][m][0]; *(f32x4*)(rowp + bj * 128 + 4) = acc[ai][bj][m][1]; }
        }
}

struct EpiIn {
    static constexpr bool PERM = true, AFTER_DRAIN = false;
    unsigned char* ws; const float *lbl, *alog, *dtb;
    __device__ __forceinline__ void operator()(const f32x4 (&acc)[2][2][4][2], const pg8::Unit& u, int wr, int wc, int fr, int fq) const {
        const int pn = u.pn, row0 = u.pm * 256 + wr * 64 + fr, cl = wc * 32 + 8 * fq;
        const bool smp = u.pm >= 32; const int rowq = smp ? row0 - NPROMPT : row0;
        if (pn >= 8 && pn < 16) {
            const int c0 = (pn - 8) * 256 + cl;
            float lb[2][8];
#pragma unroll
            for (int bj = 0; bj < 2; ++bj)
#pragma unroll
                for (int j = 0; j < 8; ++j) { const int c = c0 + bj * 128 + j; lb[bj][j] = sigmoidf_(lbl[c] - lbl[2048 + c]); }
#pragma unroll
            for (int ai = 0; ai < 2; ++ai)
#pragma unroll
                for (int m = 0; m < 4; ++m) {
                    float* rowp = (float*)(ws + (smp ? WS_FS : WS_FP)) + (size_t)(rowq + ai * 128 + m * 16) * 2048 + c0;
#pragma unroll
                    for (int bj = 0; bj < 2; ++bj) {
                        const f32x4 v0 = acc[ai][bj][m][0], v1 = acc[ai][bj][m][1]; f32x4 o0, o1;
#pragma unroll
                        for (int j = 0; j < 4; ++j) { o0[j] = lb[bj][j] + (1.f - lb[bj][j]) * sigmoidf_(v0[j]); o1[j] = lb[bj][4 + j] + (1.f - lb[bj][4 + j]) * sigmoidf_(v1[j]); }
                        *(f32x4*)(rowp + bj * 128) = o0; *(f32x4*)(rowp + bj * 128 + 4) = o1;
                    }
                }
            return;
        }
        if (pn == 96) {
            if (wc < 2) {
#pragma unroll
                for (int ai = 0; ai < 2; ++ai)
#pragma unroll
                    for (int m = 0; m < 4; ++m) {
                        float* rowp = (float*)(ws + WS_BL) + (size_t)(row0 + ai * 128 + m * 16) * 64 + cl;
                        const f32x4 v0 = acc[ai][0][m][0], v1 = acc[ai][0][m][1]; f32x4 o0, o1;
#pragma unroll
                        for (int j = 0; j < 4; ++j) {
                            if (wc == 0) { o0[j] = sigmoidf_(v0[j]); o1[j] = sigmoidf_(v1[j]); }
                            else { const int h0 = 8 * fq + j, h1 = 8 * fq + 4 + j; const float x0 = v0[j] + dtb[h0], x1 = v1[j] + dtb[h1];
                                   o0[j] = -expf(alog[h0]) * (fmaxf(x0, 0.f) + log1pf(expf(-fabsf(x0)))); o1[j] = -expf(alog[h1]) * (fmaxf(x1, 0.f) + log1pf(expf(-fabsf(x1)))); }
                        }
                        *(f32x4*)(rowp) = o0; *(f32x4*)(rowp + 4) = o1;
                    }
            }
            return;
        }
        size_t boff; int ld, c0, mode, rowb = row0;
        if (pn < 8)       { boff = smp ? WS_QHS : WS_QHP; ld = 2048; c0 = pn * 256; mode = 1; rowb = rowq; }
        else if (pn < 24) { boff = smp ? WS_IS : WS_IP;   ld = 2048; c0 = (pn - 16) * 256; mode = 0; rowb = rowq; }
        else if (pn < 32) { boff = WS_GH; ld = 2048; c0 = (pn - 24) * 256; mode = 1; }
        else if (pn < 64) { boff = smp ? WS_US : WS_UP;   ld = 8192; c0 = (pn - 32) * 256; mode = 0; rowb = rowq; }
        else if (pn < 80) { boff = WS_GZ; ld = 4096; c0 = (pn - 64) * 256; mode = 1; }
        else if (pn < 88) { boff = WS_SA; ld = 2048; c0 = (pn - 80) * 256; mode = 2; }
        else              { boff = WS_SB; ld = 2048; c0 = (pn - 88) * 256; mode = 2; }
        bf16* base = (bf16*)(ws + boff);
        if (mode == 0) tile_store_bf16<0>(acc, base, ld, rowb, c0 + cl);
        else if (mode == 1) tile_store_bf16<1>(acc, base, ld, rowb, c0 + cl);
        else tile_store_bf16<2>(acc, base, ld, rowb, c0 + cl);
    }
};
struct EpiOut1 {
    static constexpr bool PERM = true, AFTER_DRAIN = false;
    float* T1; const bf16* SA;
    __device__ __forceinline__ void operator()(const f32x4 (&acc)[2][2][4][2], const pg8::Unit& u, int wr, int wc, int fr, int fq) const {
        const int row0 = u.pm * 256 + wr * 64 + fr, c0 = u.pn * 256 + wc * 32 + 8 * fq;
#pragma unroll
        for (int ai = 0; ai < 2; ++ai)
#pragma unroll
            for (int m = 0; m < 4; ++m) {
                const size_t ro = (size_t)(row0 + ai * 128 + m * 16) * 2048 + c0;
#pragma unroll
                for (int bj = 0; bj < 2; ++bj) {
                    const u32x4 s = *(const u32x4*)(SA + ro + bj * 128);
                    const f32x4 v0 = acc[ai][bj][m][0], v1 = acc[ai][bj][m][1];
                    f32x4 o0 = {v0[0] * bflo(s.x), v0[1] * bfhi(s.x), v0[2] * bflo(s.y), v0[3] * bfhi(s.y)};
                    f32x4 o1 = {v1[0] * bflo(s.z), v1[1] * bfhi(s.z), v1[2] * bflo(s.w), v1[3] * bfhi(s.w)};
                    *(f32x4*)(T1 + ro + bj * 128) = o0; *(f32x4*)(T1 + ro + bj * 128 + 4) = o1;
                }
            }
    }
};
struct EpiOut2 {
    static constexpr bool PERM = true, AFTER_DRAIN = false;
    const float* T1; const bf16* SB; bf16* MG;
    __device__ __forceinline__ void operator()(const f32x4 (&acc)[2][2][4][2], const pg8::Unit& u, int wr, int wc, int fr, int fq) const {
        const int row0 = u.pm * 256 + wr * 64 + fr, c0 = u.pn * 256 + wc * 32 + 8 * fq;
#pragma unroll
        for (int ai = 0; ai < 2; ++ai)
#pragma unroll
            for (int m = 0; m < 4; ++m) {
                const size_t ro = (size_t)(row0 + ai * 128 + m * 16) * 2048 + c0;
#pragma unroll
                for (int bj = 0; bj < 2; ++bj) {
                    const u32x4 s = *(const u32x4*)(SB + ro + bj * 128);
                    const f32x4 t0 = *(const f32x4*)(T1 + ro + bj * 128), t1 = *(const f32x4*)(T1 + ro + bj * 128 + 4);
                    const f32x4 v0 = acc[ai][bj][m][0], v1 = acc[ai][bj][m][1];
                    u32x4 w;
                    w.x = pk2(t0[0] + v0[0] * bflo(s.x), t0[1] + v0[1] * bfhi(s.x)); w.y = pk2(t0[2] + v0[2] * bflo(s.y), t0[3] + v0[3] * bfhi(s.y));
                    w.z = pk2(t1[0] + v1[0] * bflo(s.z), t1[1] + v1[1] * bfhi(s.z)); w.w = pk2(t1[2] + v1[2] * bflo(s.w), t1[3] + v1[3] * bfhi(s.w));
                    *(u32x4*)(MG + ro + bj * 128) = w;
                }
            }
    }
};
struct EpiF32 {
    static constexpr bool PERM = true, AFTER_DRAIN = false;
    float* O; int ld;
    __device__ __forceinline__ void operator()(const f32x4 (&acc)[2][2][4][2], const pg8::Unit& u, int wr, int wc, int fr, int fq) const {
        tile_store_f32(acc, O, ld, u.pm * 256 + wr * 64 + fr, u.pn * 256 + wc * 32 + 8 * fq);
    }
};
struct EpiRelu2 {
    static constexpr bool PERM = true, AFTER_DRAIN = false;
    bf16* O; int ld;
    __device__ __forceinline__ void operator()(const f32x4 (&acc)[2][2][4][2], const pg8::Unit& u, int wr, int wc, int fr, int fq) const {
        tile_store_bf16<3>(acc, O, ld, u.pm * 256 + wr * 64 + fr, u.pn * 256 + wc * 32 + 8 * fq);
    }
};

__device__ __forceinline__ void transpose_item(const float* W, int N, bf16* WT, int ldk, int k0, int n0, int nrow0, LAS float* scr, int lane) {
#pragma unroll 8
    for (int i = 0; i < 32; ++i) { const int kk = 2 * i + (lane >> 5); scr[kk * 33 + (lane & 31)] = W[(size_t)(k0 + kk) * N + n0 + (lane & 31)]; }
    LDS_WAIT(); asm volatile("" ::: "memory");
    const int c = lane & 7;
#pragma unroll
    for (int j = 0; j < 4; ++j) { const int n = (lane >> 3) + 8 * j; const LAS float* s = scr + (8 * c) * 33 + n;
        u32x4 o; o.x = pk2(s[0 * 33], s[1 * 33]); o.y = pk2(s[2 * 33], s[3 * 33]); o.z = pk2(s[4 * 33], s[5 * 33]); o.w = pk2(s[6 * 33], s[7 * 33]);
        *(u32x4*)(WT + (size_t)(nrow0 + n) * ldk + k0 + 8 * c) = o; }
    LDS_WAIT(); asm volatile("" ::: "memory");
}
__device__ __forceinline__ void mod_item(const PA& a, LAS unsigned char* lds, int cb, int tid, int wid, int lane) {
    constexpr int AST = 264;
    LAS bf16* As = (LAS bf16*)lds;
    const float* cp = a.in(I_CP); const float* cs = a.in(I_CS); const float* W = a.in(I_WADA); const float* bada = a.in(I_BADA);
    float* mod = (float*)(a.ws() + WS_MOD);
    const int nt = wid & 3, mh = wid >> 2, fr = lane & 15, fq = lane >> 4, n = cb * 64 + nt * 16 + fr;
    f32x4 acc[5];
#pragma unroll
    for (int i = 0; i < 5; ++i) acc[i] = (f32x4){0.f, 0.f, 0.f, 0.f};
    for (int kc = 0; kc < 8; ++kc) {
        __syncthreads();
        for (int e = tid; e < 144 * 64; e += NTHREADS) {
            const int s = e >> 6, q = e & 63; u32x2 w = {0u, 0u};
            if (s < NSEQ) { const float* src = (s < 4 ? cp + (size_t)s * 2048 : cs + (size_t)(s - 4) * 2048) + kc * 256 + q * 4; const f32x4 x = *(const f32x4*)src;
                w.x = pk2(siluf_(x[0]), siluf_(x[1])); w.y = pk2(siluf_(x[2]), siluf_(x[3])); }
            *(LAS u32x2*)(As + s * AST + q * 4) = w;
        }
        __syncthreads();
#pragma unroll 2
        for (int ks = 0; ks < 8; ++ks) {
            const int k0 = kc * 256 + ks * 32 + 8 * fq;
            bf16x8 b;
#pragma unroll
            for (int j = 0; j < 8; ++j) b[j] = (short)f2bf(W[(size_t)(k0 + j) * NADA + n]);
#pragma unroll
            for (int i = 0; i < 5; ++i) {
                const int mt = mh * 5 + i;
                if (mt < 9) { const bf16x8 av = *(const LAS bf16x8*)(As + (mt * 16 + fr) * AST + ks * 32 + 8 * fq);
                    acc[i] = __builtin_amdgcn_mfma_f32_16x16x32_bf16(av, b, acc[i], 0, 0, 0); }
            }
        }
    }
    const float bb = bada[n];
#pragma unroll
    for (int i = 0; i < 5; ++i)
#pragma unroll
        for (int r = 0; r < 4; ++r) { const int s = (mh * 5 + i) * 16 + 4 * fq + r; if (s < NSEQ) mod[(size_t)s * NADA + n] = acc[i][r] + bb; }
}

__device__ __forceinline__ const float* xrow_ptr(const PA& a, int row) { return row < NPROMPT ? a.in(I_XP) + (size_t)row * DM : a.in(I_XS) + (size_t)(row - NPROMPT) * DM; }
__device__ __forceinline__ int seq_of_row(int row) { return row < NPROMPT ? (row >> 11) : 4 + ((row - NPROMPT) >> 2); }

__device__ __forceinline__ float ldg_agent(const float* p) { return __hip_atomic_load(p, __ATOMIC_RELAXED, __HIP_MEMORY_SCOPE_AGENT); }
__device__ __forceinline__ float xhalf_sum(float v) { return v + __shfl_xor(v, 32); }
__device__ __forceinline__ void hgrn_item(const PA& a, LAS float* wl, int b, int h, int quarter, int lane) {
    const bf16* Qh = (const bf16*)(a.ws() + WS_QHS); const float* F = (const float*)(a.ws() + WS_FS); const bf16* Ih = (const bf16*)(a.ws() + WS_IS);
    bf16* O16 = (bf16*)(a.ws() + WS_O16);
    const int c = lane & 31, hh = lane >> 5, dv = quarter * 32 + c;
    const unsigned sidx = (unsigned)((b * 16 + h) * 128 + 64 * hh) * 128u + dv;
    float S[64];
    { const float* s0 = a.in(I_SHG) + sidx;
#pragma unroll
        for (int j = 0; j < 64; ++j) S[j] = s0[j * 128]; }
    LAS float* qs = wl; LAS float* fs = wl + 128;
#pragma unroll 1
    for (int t = 0; t < DSEQ; ++t) {
        const unsigned ro = (unsigned)(b * DSEQ + t) * 2048u + h * 128;
        const float q0 = bf2f(Qh[ro + lane]), q1 = bf2f(Qh[ro + 64 + lane]), f0 = F[ro + lane], f1 = F[ro + 64 + lane], iv = bf2f(Ih[ro + dv]);
        qs[lane] = q0; qs[64 + lane] = q1; fs[lane] = f0; fs[64 + lane] = f1;
        float o0 = 0.f, o1 = 0.f, o2 = 0.f, o3 = 0.f;
#pragma unroll
        for (int j4 = 0; j4 < 16; ++j4) {
            const f32x4 q4 = *(const LAS f32x4*)(qs + 64 * hh + 4 * j4), f4 = *(const LAS f32x4*)(fs + 64 * hh + 4 * j4);
            S[4 * j4 + 0] = fmaf(f4[0], S[4 * j4 + 0] - iv, iv); o0 = fmaf(q4[0], S[4 * j4 + 0], o0);
            S[4 * j4 + 1] = fmaf(f4[1], S[4 * j4 + 1] - iv, iv); o1 = fmaf(q4[1], S[4 * j4 + 1], o1);
            S[4 * j4 + 2] = fmaf(f4[2], S[4 * j4 + 2] - iv, iv); o2 = fmaf(q4[2], S[4 * j4 + 2], o2);
            S[4 * j4 + 3] = fmaf(f4[3], S[4 * j4 + 3] - iv, iv); o3 = fmaf(q4[3], S[4 * j4 + 3], o3);
        }
        const float o = xhalf_sum((o0 + o1) + (o2 + o3));
        if (hh == 0) O16[(unsigned)(NPROMPT + b * DSEQ + t) * 6144u + h * 128 + dv] = (bf16)(pk2(o, 0.f) & 0xffffu);
    }
    float* so = a.out() + O_HGS + sidx;
#pragma unroll
    for (int j = 0; j < 64; ++j) so[j * 128] = S[j];
}
__device__ __forceinline__ void gdn_item(const PA& a, LAS float* wl, int b, int vh, int quarter, int lane) {
    const bf16* UC = (const bf16*)(a.ws() + WS_UCS); const float* BL = (const float*)(a.ws() + WS_BL);
    bf16* O16 = (bf16*)(a.ws() + WS_O16);
    const int c = lane & 31, hh = lane >> 5, dv = quarter * 32 + c, qh = vh >> 1;
    const unsigned sidx = (unsigned)((b * 32 + vh) * 128 + 64 * hh) * 128u + dv;
    float S[64];
    { const float* s0 = a.in(I_SGD) + sidx;
#pragma unroll
        for (int j = 0; j < 64; ++j) S[j] = s0[j * 128]; }
    LAS float* qs = wl; LAS float* ks = wl + 128;
#pragma unroll 1
    for (int t = 0; t < DSEQ; ++t) {
        const unsigned ro = (unsigned)(b * DSEQ + t) * 8192u + qh * 128, rv = (unsigned)(b * DSEQ + t) * 8192u + 4096 + vh * 128, rb = (unsigned)(NPROMPT + b * DSEQ + t) * 64u + vh;
        const float q0 = bf2f(UC[ro + lane]), q1 = bf2f(UC[ro + 64 + lane]), k0 = bf2f(UC[ro + 2048 + lane]), k1 = bf2f(UC[ro + 2048 + 64 + lane]), vv = bf2f(UC[rv + dv]);
        const float beta = ldg_agent(BL + rb), al = __expf(ldg_agent(BL + rb + 32));
        qs[lane] = q0; qs[64 + lane] = q1; ks[lane] = k0; ks[64 + lane] = k1;
        const float qk = wave_sum_sw(q0 * k0 + q1 * k1);
        float c0 = 0.f, c1 = 0.f, c2 = 0.f, c3 = 0.f, o0 = 0.f, o1 = 0.f, o2 = 0.f, o3 = 0.f;
#pragma unroll
        for (int j4 = 0; j4 < 16; ++j4) {
            const f32x4 k4 = *(const LAS f32x4*)(ks + 64 * hh + 4 * j4), q4 = *(const LAS f32x4*)(qs + 64 * hh + 4 * j4);
            c0 = fmaf(k4[0], S[4 * j4 + 0], c0); c1 = fmaf(k4[1], S[4 * j4 + 1], c1); c2 = fmaf(k4[2], S[4 * j4 + 2], c2); c3 = fmaf(k4[3], S[4 * j4 + 3], c3);
            o0 = fmaf(q4[0], S[4 * j4 + 0], o0); o1 = fmaf(q4[1], S[4 * j4 + 1], o1); o2 = fmaf(q4[2], S[4 * j4 + 2], o2); o3 = fmaf(q4[3], S[4 * j4 + 3], o3);
        }
        const float kS = xhalf_sum((c0 + c1) + (c2 + c3)), qS = xhalf_sum((o0 + o1) + (o2 + o3));
        const float dlt = beta * (vv - al * kS);
#pragma unroll
        for (int j4 = 0; j4 < 16; ++j4) {
            const f32x4 k4 = *(const LAS f32x4*)(ks + 64 * hh + 4 * j4);
            S[4 * j4 + 0] = fmaf(k4[0], dlt, al * S[4 * j4 + 0]); S[4 * j4 + 1] = fmaf(k4[1], dlt, al * S[4 * j4 + 1]);
            S[4 * j4 + 2] = fmaf(k4[2], dlt, al * S[4 * j4 + 2]); S[4 * j4 + 3] = fmaf(k4[3], dlt, al * S[4 * j4 + 3]);
        }
        if (hh == 0) O16[(unsigned)(NPROMPT + b * DSEQ + t) * 6144u + 2048 + vh * 128 + dv] = (bf16)(pk2(fmaf(al, qS, qk * dlt), 0.f) & 0xffffu);
    }
    float* so = a.out() + O_GDS + sidx;
#pragma unroll
    for (int j = 0; j < 64; ++j) so[j * 128] = S[j];
}

typedef float f32x16 __attribute__((ext_vector_type(16)));
typedef float f32x2_t __attribute__((ext_vector_type(2))); typedef __bf16 bf16x2_t __attribute__((ext_vector_type(2)));
#define MFMA32(a, b, c) __builtin_amdgcn_mfma_f32_32x32x16_bf16((a), (b), (c), 0, 0, 0)
__device__ __forceinline__ unsigned cvtpk(float lo, float hi) { f32x2_t v = {lo, hi}; bf16x2_t b = __builtin_convertvector(v, bf16x2_t); return __builtin_bit_cast(unsigned, b); }
__device__ __forceinline__ int crow_(int i, int h) { return (i & 3) + 8 * (i >> 2) + 4 * h; }
template <int S> __device__ __forceinline__ bf16x8 pack_acc(const f32x16& x) {
    u32x4 p; p.x = cvtpk(x[8 * S + 0], x[8 * S + 1]); p.y = cvtpk(x[8 * S + 2], x[8 * S + 3]); p.z = cvtpk(x[8 * S + 4], x[8 * S + 5]); p.w = cvtpk(x[8 * S + 6], x[8 * S + 7]);
    return __builtin_bit_cast(bf16x8, p);
}
__device__ __forceinline__ u32x4 afrag_rows(const LAS bf16* img, int stride, int row, int kt, int h) {
    const LAS u32x2* p = (const LAS u32x2*)(img + row * stride + 16 * kt + 4 * h);
    const u32x2 lo = p[0], hi = p[2];
    return (u32x4){lo.x, lo.y, hi.x, hi.y};
}
__device__ __forceinline__ u32x4 afrag_rows_scaled(const LAS bf16* img, int stride, int row, int kt, int h, float sc) {
    const u32x4 w = afrag_rows(img, stride, row, kt, h);
    return (u32x4){cvtpk(bflo(w.x) * sc, bfhi(w.x) * sc), cvtpk(bflo(w.y) * sc, bfhi(w.y) * sc), cvtpk(bflo(w.z) * sc, bfhi(w.z) * sc), cvtpk(bflo(w.w) * sc, bfhi(w.w) * sc)};
}
__device__ __forceinline__ int kidx_(int kt, int h, int j) { return 16 * kt + 8 * (j >> 2) + 4 * h + (j & 3); }

constexpr int GREC_BYTES = 73984;
constexpr int GR_W = 0, GR_Q = 16384, GR_K = 32768, GR_A = 49152, GR_U = 57344, GR_DEC = 73728, GR_IMG = 57344;
constexpr int HREC_BYTES = 57856;
constexpr int HR_Q = 0, HR_K = 16384, HR_A = 32768, HR_I = 40960, HR_DEC = 57344, HR_IMG = 57856;

constexpr int GP_QS = 0, GP_KS = 17408, GP_VS = 34816, GP_BG = 69632, GP_KK = 73728, GP_QK = 90368, GP_AS = 107008, GP_XL = 0, GP_ATT = 73728;
constexpr int GP_ST = 136, GP_XST = 264, GP_AST = 68, GP_KST = 65, GP_TST = 72;
__device__ __forceinline__ void gdn_prep_unit(const PA& a, LAS unsigned char* lds, int u, int tid, int wid, int lane) {
    asm volatile("" : "+v"(tid), "+v"(lane));
    unsigned char* ws = a.ws();
    const int b = u >> 9, qh = (u >> 5) & 15, c = u & 31;
    const bf16* UP = (const bf16*)(ws + WS_UP); const float* BL = (const float*)(ws + WS_BL); const float* cw = a.in(I_CW);
    LAS bf16* QS = (LAS bf16*)(lds + GP_QS); LAS bf16* KS = (LAS bf16*)(lds + GP_KS); LAS bf16* VS = (LAS bf16*)(lds + GP_VS);
    LAS float* BG = (LAS float*)(lds + GP_BG);
    LAS float* KKs = (LAS float*)(lds + GP_KK); LAS float* QKs = (LAS float*)(lds + GP_QK); LAS float* AS = (LAS float*)(lds + GP_AS);
    LAS bf16* XL = (LAS bf16*)(lds + GP_XL); LAS bf16* ATT = (LAS bf16*)(lds + GP_ATT);
    const int row0 = b * SEQ + c * 64;
    unsigned char* rec0 = ws + WS_GREC + (size_t)((b * 32 + 2 * qh) * 32 + c) * GREC_BYTES;
    {
        const int t = tid >> 3, cg = tid & 7;
#pragma unroll
        for (int m = 0; m < 2; ++m) {
            const int ch0 = m * 2048 + qh * 128 + cg * 16;
            float x[16];
#pragma unroll
            for (int e = 0; e < 16; ++e) x[e] = 0.f;
#pragma unroll
            for (int j = 0; j < 4; ++j) {
                const int tt = c * 64 + t - 3 + j;
                if (tt >= 0) {
                    const u32x4* src = (const u32x4*)(UP + (size_t)(row0 + t - 3 + j) * CONVCH + ch0);
                    const u32x4 w0 = src[0], w1 = src[1];
                    const f32x4* wp = (const f32x4*)(cw + (size_t)j * CONVCH + ch0);
                    const f32x4 c0 = wp[0], c1 = wp[1], c2 = wp[2], c3 = wp[3];
                    x[0] = fmaf(c0[0], bflo(w0.x), x[0]); x[1] = fmaf(c0[1], bfhi(w0.x), x[1]); x[2] = fmaf(c0[2], bflo(w0.y), x[2]); x[3] = fmaf(c0[3], bfhi(w0.y), x[3]);
                    x[4] = fmaf(c1[0], bflo(w0.z), x[4]); x[5] = fmaf(c1[1], bfhi(w0.z), x[5]); x[6] = fmaf(c1[2], bflo(w0.w), x[6]); x[7] = fmaf(c1[3], bfhi(w0.w), x[7]);
                    x[8] = fmaf(c2[0], bflo(w1.x), x[8]); x[9] = fmaf(c2[1], bfhi(w1.x), x[9]); x[10] = fmaf(c2[2], bflo(w1.y), x[10]); x[11] = fmaf(c2[3], bfhi(w1.y), x[11]);
                    x[12] = fmaf(c3[0], bflo(w1.z), x[12]); x[13] = fmaf(c3[1], bfhi(w1.z), x[13]); x[14] = fmaf(c3[2], bflo(w1.w), x[14]); x[15] = fmaf(c3[3], bfhi(w1.w), x[15]);
                }
            }
            float ss = 0.f;
#pragma unroll
            for (int e = 0; e < 16; ++e) { x[e] = siluf_(x[e]); ss = fmaf(x[e], x[e], ss); }
            ss += __shfl_xor(ss, 1); ss += __shfl_xor(ss, 2); ss += __shfl_xor(ss, 4);
            float r = rsqrtf(ss + EPS); if (m == 0) r *= 0.08838834764831845f;
            u32x4 o0, o1;
            o0.x = cvtpk(x[0] * r, x[1] * r); o0.y = cvtpk(x[2] * r, x[3] * r); o0.z = cvtpk(x[4] * r, x[5] * r); o0.w = cvtpk(x[6] * r, x[7] * r);
            o1.x = cvtpk(x[8] * r, x[9] * r); o1.y = cvtpk(x[10] * r, x[11] * r); o1.z = cvtpk(x[12] * r, x[13] * r); o1.w = cvtpk(x[14] * r, x[15] * r);
            LAS u32x4* dst = (LAS u32x4*)((m ? KS : QS) + t * GP_ST + cg * 16);
            dst[0] = o0; dst[1] = o1;
            asm volatile("" ::: "memory");
        }
#pragma unroll
        for (int m = 0; m < 2; ++m) {
            const int cl = cg * 32 + m * 16;
            const int ch0 = 4096 + (2 * qh) * 128 + cl;
            float x[16];
#pragma unroll
            for (int e = 0; e < 16; ++e) x[e] = 0.f;
#pragma unroll
            for (int j = 0; j < 4; ++j) {
                const int tt = c * 64 + t - 3 + j;
                if (tt >= 0) {
                    const u32x4* src = (const u32x4*)(UP + (size_t)(row0 + t - 3 + j) * CONVCH + ch0);
                    const u32x4 w0 = src[0], w1 = src[1];
                    const f32x4* wp = (const f32x4*)(cw + (size_t)j * CONVCH + ch0);
                    const f32x4 c0 = wp[0], c1 = wp[1], c2 = wp[2], c3 = wp[3];
                    x[0] = fmaf(c0[0], bflo(w0.x), x[0]); x[1] = fmaf(c0[1], bfhi(w0.x), x[1]); x[2] = fmaf(c0[2], bflo(w0.y), x[2]); x[3] = fmaf(c0[3], bfhi(w0.y), x[3]);
                    x[4] = fmaf(c1[0], bflo(w0.z), x[4]); x[5] = fmaf(c1[1], bfhi(w0.z), x[5]); x[6] = fmaf(c1[2], bflo(w0.w), x[6]); x[7] = fmaf(c1[3], bfhi(w0.w), x[7]);
                    x[8] = fmaf(c2[0], bflo(w1.x), x[8]); x[9] = fmaf(c2[1], bfhi(w1.x), x[9]); x[10] = fmaf(c2[2], bflo(w1.y), x[10]); x[11] = fmaf(c2[3], bfhi(w1.y), x[11]);
                    x[12] = fmaf(c3[0], bflo(w1.z), x[12]); x[13] = fmaf(c3[1], bfhi(w1.z), x[13]); x[14] = fmaf(c3[2], bflo(w1.w), x[14]); x[15] = fmaf(c3[3], bfhi(w1.w), x[15]);
                }
            }
#pragma unroll
            for (int e = 0; e < 16; ++e) x[e] = siluf_(x[e]);
            u32x4 o0, o1;
            o0.x = cvtpk(x[0], x[1]); o0.y = cvtpk(x[2], x[3]); o0.z = cvtpk(x[4], x[5]); o0.w = cvtpk(x[6], x[7]);
            o1.x = cvtpk(x[8], x[9]); o1.y = cvtpk(x[10], x[11]); o1.z = cvtpk(x[12], x[13]); o1.w = cvtpk(x[14], x[15]);
            LAS u32x4* dst = (LAS u32x4*)(VS + (cl >> 7) * (64 * GP_ST) + t * GP_ST + (cl & 127));
            dst[0] = o0; dst[1] = o1;
            asm volatile("" ::: "memory");
        }
        if (tid < 256) { const int vhh = tid >> 7, k = (tid >> 6) & 1, tt = tid & 63;
            BG[k * 128 + vhh * 64 + tt] = BL[(size_t)(row0 + tt) * 64 + k * 32 + 2 * qh + vhh]; }
    }
    __syncthreads(); asm volatile("" : "+v"(tid), "+v"(lane));
    if (wid < 2) {
        float g = BG[128 + wid * 64 + lane];
#pragma unroll
        for (int o = 1; o < 64; o <<= 1) { const float v = __shfl_up(g, o); if (lane >= o) g += v; }
        const float g63 = __shfl(g, 63);
        BG[256 + wid * 64 + lane] = g; BG[384 + wid * 64 + lane] = __expf(g); BG[512 + wid * 64 + lane] = __expf(g63 - g);
        if (lane == 63) *(float*)(rec0 + (size_t)wid * 32 * GREC_BYTES + GR_DEC) = __expf(g63);
    }
    {
        const int m = wid >> 2, rt = (wid >> 1) & 1, ct = wid & 1, r = lane & 31, h = lane >> 5;
        const LAS bf16* Am = (m ? QS : KS) + (32 * rt + r) * GP_ST + 8 * h; const LAS bf16* Bm = KS + (32 * ct + r) * GP_ST + 8 * h;
        f32x16 acc;
#pragma unroll
        for (int i = 0; i < 16; ++i) acc[i] = 0.f;
#pragma unroll
        for (int kt = 0; kt < 8; ++kt) acc = MFMA32(*(const LAS bf16x8*)(Am + 16 * kt), *(const LAS bf16x8*)(Bm + 16 * kt), acc);
        LAS float* dst = (m ? QKs : KKs) + 32 * ct + r;
#pragma unroll
        for (int i = 0; i < 16; ++i) dst[(32 * rt + crow_(i, h)) * GP_KST] = acc[i];
    }
    __syncthreads(); asm volatile("" : "+v"(tid), "+v"(lane));
    float att[16];
    {
        const int vhh = tid >> 8, e = tid & 255;
        const LAS float* bet = BG + vhh * 64; const LAS float* gam = BG + 256 + vhh * 64;
#pragma unroll
        for (int n = 0; n < 16; ++n) {
            const int idx = e + 256 * n, t = idx >> 6, s = idx & 63;
            const float L = (t >= s) ? __expf(gam[t] - gam[s]) : 0.f;
            AS[(vhh * 64 + t) * GP_AST + s] = (t > s) ? bet[t] * KKs[t * GP_KST + s] * L : 0.f;
            att[n] = -QKs[t * GP_KST + s] * L;
        }
#pragma unroll
        for (int n = 0; n < 4; ++n) {
            const int task = tid + 512 * n, vh2 = task >> 10, f = (task >> 6) & 15, l = task & 63, rt = f >> 3, kt = f & 7, r = l & 31, h = l >> 5;
            const u32x4 w = afrag_rows_scaled(QS, GP_ST, 32 * rt + r, kt, h, BG[384 + vh2 * 64 + 32 * rt + r]);
            *(u32x4*)(rec0 + (size_t)vh2 * 32 * GREC_BYTES + GR_Q + (f * 64 + l) * 16) = w;
        }
#pragma unroll
        for (int n = 0; n < 4; ++n) {
            const int task = tid + 512 * n, vh2 = task >> 10, f = (task >> 6) & 15, l = task & 63, dt = f >> 2, ts = f & 3, r = l & 31, h = l >> 5;
            float v[8];
#pragma unroll
            for (int j = 0; j < 8; ++j) { const int tok = kidx_(ts, h, j); v[j] = -bf2f(KS[tok * GP_ST + 32 * dt + r]) * BG[512 + vh2 * 64 + tok]; }
            *(u32x4*)(rec0 + (size_t)vh2 * 32 * GREC_BYTES + GR_K + (f * 64 + l) * 16) = (u32x4){cvtpk(v[0], v[1]), cvtpk(v[2], v[3]), cvtpk(v[4], v[5]), cvtpk(v[6], v[7])};
        }
    }
    __syncthreads(); asm volatile("" : "+v"(tid), "+v"(lane));
    {
        const int vhh = tid >> 8, e = tid & 255;
#pragma unroll
        for (int n = 0; n < 16; ++n) { const int idx = e + 256 * n, t = idx >> 6, s = idx & 63; ATT[(vhh * 64 + t) * GP_TST + s] = (bf16)(cvtpk(att[n], 0.f) & 0xffffu); }
    }
    float X[64];
#pragma unroll
    for (int i = 0; i < 64; ++i) X[i] = 0.f;
    {
        const int vhh = tid >> 8, cc = tid & 255;
        const LAS float* bet = BG + vhh * 64; const LAS float* eg = BG + 384 + vhh * 64;
        const LAS bf16* src = (cc < 128) ? (VS + vhh * (64 * GP_ST) + cc) : (KS + (cc - 128));
        const bool isw = cc >= 128;
#define GDN_SOLVE_QUARTER(QQ) \
        _Pragma("unroll 1") for (int tb = 4 * (QQ); tb < 4 * (QQ) + 4; ++tb) { \
            float rr[4]; \
            _Pragma("unroll") for (int i = 0; i < 4; ++i) { const int t = 4 * tb + i; const float bt = bet[t] * (isw ? eg[t] : 1.f); rr[i] = bf2f(src[t * GP_ST]) * bt; } \
            const LAS float* ar = AS + (vhh * 64 + 4 * tb) * GP_AST; \
            _Pragma("unroll") for (int s4 = 0; s4 < 4 * (QQ) + 4; ++s4) { \
                const f32x4 a0 = *(const LAS f32x4*)(ar + 4 * s4), a1 = *(const LAS f32x4*)(ar + GP_AST + 4 * s4), a2 = *(const LAS f32x4*)(ar + 2 * GP_AST + 4 * s4), a3 = *(const LAS f32x4*)(ar + 3 * GP_AST + 4 * s4); \
                _Pragma("unroll") for (int e = 0; e < 4; ++e) { const float x = X[4 * s4 + e]; rr[0] = fmaf(-a0[e], x, rr[0]); rr[1] = fmaf(-a1[e], x, rr[1]); rr[2] = fmaf(-a2[e], x, rr[2]); rr[3] = fmaf(-a3[e], x, rr[3]); } \
                if ((s4 & 1) == 1) asm volatile("" : "+v"(ar) : "v"(rr[0])); \
            } \
            const f32x4 d1 = *(const LAS f32x4*)(ar + GP_AST + 4 * tb), d2 = *(const LAS f32x4*)(ar + 2 * GP_AST + 4 * tb), d3 = *(const LAS f32x4*)(ar + 3 * GP_AST + 4 * tb); \
            rr[1] = fmaf(-d1[0], rr[0], rr[1]); \
            rr[2] = fmaf(-d2[0], rr[0], rr[2]); rr[2] = fmaf(-d2[1], rr[1], rr[2]); \
            rr[3] = fmaf(-d3[0], rr[0], rr[3]); rr[3] = fmaf(-d3[1], rr[1], rr[3]); rr[3] = fmaf(-d3[2], rr[2], rr[3]); \
            _Pragma("unroll") for (int j = 4 * (QQ); j < 4 * (QQ) + 4; ++j) if (j == tb) { X[4 * j] = rr[0]; X[4 * j + 1] = rr[1]; X[4 * j + 2] = rr[2]; X[4 * j + 3] = rr[3]; } \
        }
        GDN_SOLVE_QUARTER(0) GDN_SOLVE_QUARTER(1) GDN_SOLVE_QUARTER(2) GDN_SOLVE_QUARTER(3)
#undef GDN_SOLVE_QUARTER
    }
    __syncthreads(); asm volatile("" : "+v"(tid), "+v"(lane));
    {
        const int vhh = tid >> 8, cc = tid & 255; const float sg = (cc < 128) ? -1.f : 1.f;
#pragma unroll
        for (int t = 0; t < 64; ++t) XL[(vhh * 64 + t) * GP_XST + cc] = (bf16)(cvtpk(X[t] * sg, 0.f) & 0xffffu);
    }
    __syncthreads(); asm volatile("" : "+v"(tid), "+v"(lane));
    {
#pragma unroll
        for (int n = 0; n < 4; ++n) {
            const int task = tid + 512 * n, vh2 = task >> 10, f = (task >> 6) & 15, l = task & 63, rt = f >> 3, kt = f & 7, r = l & 31, h = l >> 5;
            const u32x4 w = afrag_rows(XL + vh2 * (64 * GP_XST) + 128, GP_XST, 32 * rt + r, kt, h);
            *(u32x4*)(rec0 + (size_t)vh2 * 32 * GREC_BYTES + GR_W + (f * 64 + l) * 16) = w;
        }
#pragma unroll
        for (int n = 0; n < 2; ++n) {
            const int task = tid + 512 * n, vh2 = task >> 9, f = (task >> 6) & 7, l = task & 63, slab = f >> 1, rt = f & 1, r = l & 31, h = l >> 5;
            const LAS bf16* src = XL + (vh2 * 64 + 32 * rt) * GP_XST + 32 * slab + r;
            unsigned w[8];
#pragma unroll
            for (int i2 = 0; i2 < 8; ++i2) w[i2] = (unsigned)src[crow_(2 * i2, h) * GP_XST] | ((unsigned)src[crow_(2 * i2 + 1, h) * GP_XST] << 16);
            u32x4* dst = (u32x4*)(rec0 + (size_t)vh2 * 32 * GREC_BYTES + GR_U + (f * 64 + l) * 32);
            dst[0] = (u32x4){w[0], w[1], w[2], w[3]}; dst[1] = (u32x4){w[4], w[5], w[6], w[7]};
        }
#pragma unroll
        for (int n = 0; n < 2; ++n) {
            const int task = tid + 512 * n, vh2 = task >> 9, f = (task >> 6) & 7, l = task & 63, rt = f >> 2, ts = f & 3, r = l & 31, h = l >> 5;
            const u32x4 w = afrag_rows(ATT + vh2 * (64 * GP_TST), GP_TST, 32 * rt + r, ts, h);
            *(u32x4*)(rec0 + (size_t)vh2 * 32 * GREC_BYTES + GR_A + (f * 64 + l) * 16) = w;
        }
    }
    __syncthreads(); asm volatile("" : "+v"(tid), "+v"(lane));
}

constexpr int HP_QT = 0, HP_KT = 17408, HP_QH = 34816, HP_KH = 52224, HP_IS = 69632, HP_GS = 87040, HP_AT = 90112;
__device__ __forceinline__ void hgrn_prep_unit(const PA& a, LAS unsigned char* lds, int u, int tid, int wid, int lane) {
    asm volatile("" : "+v"(tid), "+v"(lane));
    unsigned char* ws = a.ws();
    const int b = u >> 9, hd = (u >> 5) & 15, c = u & 31;
    const bf16* QhP = (const bf16*)(ws + WS_QHP); const float* FP = (const float*)(ws + WS_FP); const bf16* IP = (const bf16*)(ws + WS_IP);
    LAS bf16* QT = (LAS bf16*)(lds + HP_QT); LAS bf16* KT = (LAS bf16*)(lds + HP_KT); LAS bf16* QH = (LAS bf16*)(lds + HP_QH); LAS bf16* KH = (LAS bf16*)(lds + HP_KH);
    LAS bf16* IS = (LAS bf16*)(lds + HP_IS); LAS float* GS = (LAS float*)(lds + HP_GS); LAS bf16* AT = (LAS bf16*)(lds + HP_AT);
    const int row0 = b * SEQ + c * 64;
    unsigned char* rec = ws + WS_HREC + (size_t)((b * 16 + hd) * 32 + c) * HREC_BYTES;
    {
        const int d = tid & 127, tq = tid >> 7;
        float G[16], qv[16], kv[16];
        const size_t base = (size_t)(row0 + 16 * tq) * 2048 + hd * 128 + d;
        float run = 0.f;
#pragma unroll
        for (int j = 0; j < 16; ++j) { const float f = FP[base + (size_t)j * 2048]; run += __logf(f); G[j] = run; kv[j] = 1.f - f; qv[j] = bf2f(QhP[base + (size_t)j * 2048]);
            IS[(16 * tq + j) * GP_ST + d] = IP[base + (size_t)j * 2048]; }
        GS[256 + tq * 128 + d] = run;
        __syncthreads(); asm volatile("" : "+v"(tid), "+v"(lane));
        float off = 0.f;
#pragma unroll
        for (int q = 0; q < 3; ++q) if (q < tq) off += GS[256 + q * 128 + d];
        if (tq == 2) GS[128 + d] = off + G[0];
        if (tq == 3) { const float g63 = off + G[15]; GS[d] = g63; *(float*)(rec + HR_DEC + d * 4) = __expf(g63); }
        __syncthreads(); asm volatile("" : "+v"(tid), "+v"(lane));
        const float gref = GS[128 + d], g63 = GS[d];
#pragma unroll
        for (int j = 0; j < 16; ++j) {
            const float g = off + G[j]; const int t = 16 * tq + j;
            QT[t * GP_ST + d] = (bf16)(cvtpk(qv[j] * __expf(g - gref), 0.f) & 0xffffu);
            KT[t * GP_ST + d] = (bf16)(cvtpk(kv[j] * __expf(gref - g), 0.f) & 0xffffu);
            QH[t * GP_ST + d] = (bf16)(cvtpk(qv[j] * __expf(g), 0.f) & 0xffffu);
            KH[t * GP_ST + d] = (bf16)(cvtpk(kv[j] * __expf(g63 - g), 0.f) & 0xffffu);
        }
    }
    __syncthreads(); asm volatile("" : "+v"(tid), "+v"(lane));
    if (wid < 4) {
        const int rt = wid >> 1, ct = wid & 1, r = lane & 31, h = lane >> 5;
        const LAS bf16* Am = QT + (32 * rt + r) * GP_ST + 8 * h; const LAS bf16* Bm = KT + (32 * ct + r) * GP_ST + 8 * h;
        f32x16 acc;
#pragma unroll
        for (int i = 0; i < 16; ++i) acc[i] = 0.f;
#pragma unroll
        for (int kt = 0; kt < 8; ++kt) acc = MFMA32(*(const LAS bf16x8*)(Am + 16 * kt), *(const LAS bf16x8*)(Bm + 16 * kt), acc);
#pragma unroll
        for (int i = 0; i < 16; ++i) { const int t = 32 * rt + crow_(i, h), s = 32 * ct + r; AT[t * GP_TST + s] = (bf16)(cvtpk(t >= s ? acc[i] : 0.f, 0.f) & 0xffffu); }
    } else {
        const int t2 = tid - 256;
#pragma unroll
        for (int n = 0; n < 4; ++n) { const int task = t2 + 256 * n, f = task >> 6, l = task & 63, rt = f >> 3, kt = f & 7, r = l & 31, h = l >> 5;
            *(u32x4*)(rec + HR_Q + (f * 64 + l) * 16) = afrag_rows(QH, GP_ST, 32 * rt + r, kt, h); }
    }
    __syncthreads(); asm volatile("" : "+v"(tid), "+v"(lane));
    {
#pragma unroll
        for (int n = 0; n < 2; ++n) {
            const int task = tid + 512 * n, f = task >> 6, l = task & 63, dt = f >> 2, ts = f & 3, r = l & 31, h = l >> 5;
            unsigned short v[8];
#pragma unroll
            for (int j = 0; j < 8; ++j) v[j] = KH[kidx_(ts, h, j) * GP_ST + 32 * dt + r];
            *(u32x4*)(rec + HR_K + (f * 64 + l) * 16) = (u32x4){(unsigned)v[0] | ((unsigned)v[1] << 16), (unsigned)v[2] | ((unsigned)v[3] << 16), (unsigned)v[4] | ((unsigned)v[5] << 16), (unsigned)v[6] | ((unsigned)v[7] << 16)};
        }
#pragma unroll
        for (int n = 0; n < 2; ++n) {
            const int task = tid + 512 * n, f = task >> 6, l = task & 63, slab = f >> 2, ts = f & 3, r = l & 31, h = l >> 5;
            unsigned short v[8];
#pragma unroll
            for (int j = 0; j < 8; ++j) v[j] = IS[kidx_(ts, h, j) * GP_ST + 32 * slab + r];
            *(u32x4*)(rec + HR_I + (f * 64 + l) * 16) = (u32x4){(unsigned)v[0] | ((unsigned)v[1] << 16), (unsigned)v[2] | ((unsigned)v[3] << 16), (unsigned)v[4] | ((unsigned)v[5] << 16), (unsigned)v[6] | ((unsigned)v[7] << 16)};
        }
        {
            const int f = tid >> 6, l = tid & 63, rt = f >> 2, ts = f & 3, r = l & 31, h = l >> 5;
            *(u32x4*)(rec + HR_A + (f * 64 + l) * 16) = afrag_rows(AT, GP_TST, 32 * rt + r, ts, h);
        }
    }
    __syncthreads(); asm volatile("" : "+v"(tid), "+v"(lane));
}

template <int NP> __device__ __forceinline__ void stage_image(LAS unsigned char* lds, const unsigned char* rec, unsigned nbytes, int tid) {
    unsigned off0 = (unsigned)tid * 16u; asm volatile("" : "+v"(off0));
    u32x4 v[NP];
#pragma unroll
    for (int i = 0; i < NP; ++i) { if (i * (NTHREADS * 16) + (NTHREADS * 16) <= (int)nbytes || off0 + i * (NTHREADS * 16) < nbytes) v[i] = *(const u32x4*)(rec + i * (NTHREADS * 16) + off0); }
    __syncthreads();
#pragma unroll
    for (int i = 0; i < NP; ++i) { if (i * (NTHREADS * 16) + (NTHREADS * 16) <= (int)nbytes || off0 + i * (NTHREADS * 16) < nbytes) *(LAS u32x4*)(lds + i * (NTHREADS * 16) + off0) = v[i]; }
    __syncthreads();
}
#define LFRAG(off) (*(const LAS bf16x8*)(lds + (off)))
__device__ __forceinline__ void gdn_seq_block(const PA& a, LAS unsigned char* lds, int u, int tid, int wid, int lane) {
    unsigned char* ws = a.ws();
    const int b = u >> 5, vh = u & 31, slab = wid;
    bf16* O16 = (bf16*)(ws + WS_O16);
    f32x16 S[4];
#pragma unroll
    for (int d = 0; d < 4; ++d)
#pragma unroll
        for (int i = 0; i < 16; ++i) S[d][i] = 0.f;
    for (int c = 0; c < 32; ++c) {
        const unsigned char* rec = ws + WS_GREC + (size_t)((b * 32 + vh) * 32 + c) * GREC_BYTES;
        stage_image<7>(lds, rec, GR_IMG, tid);
        asm volatile("" : "+v"(lane));
        const int r = lane & 31, h = lane >> 5;
        if (wid < 4) {
            const float dec = ldg_agent((const float*)(rec + GR_DEC));
            f32x16 P1[2], P2[2];
#pragma unroll
            for (int rt = 0; rt < 2; ++rt) {
                const u32x4* up = (const u32x4*)(rec + GR_U + ((slab * 2 + rt) * 64 + lane) * 32);
                const u32x4 u0 = up[0], u1 = up[1];
                P1[rt][0] = bflo(u0.x); P1[rt][1] = bfhi(u0.x); P1[rt][2] = bflo(u0.y); P1[rt][3] = bfhi(u0.y); P1[rt][4] = bflo(u0.z); P1[rt][5] = bfhi(u0.z); P1[rt][6] = bflo(u0.w); P1[rt][7] = bfhi(u0.w);
                P1[rt][8] = bflo(u1.x); P1[rt][9] = bfhi(u1.x); P1[rt][10] = bflo(u1.y); P1[rt][11] = bfhi(u1.y); P1[rt][12] = bflo(u1.z); P1[rt][13] = bfhi(u1.z); P1[rt][14] = bflo(u1.w); P1[rt][15] = bfhi(u1.w);
#pragma unroll
                for (int i = 0; i < 16; ++i) P2[rt][i] = 0.f;
            }
#pragma unroll
            for (int d = 0; d < 4; ++d) {
                const bf16x8 b0 = pack_acc<0>(S[d]), b1 = pack_acc<1>(S[d]);
#pragma unroll
                for (int rt = 0; rt < 2; ++rt) {
                    P1[rt] = MFMA32(LFRAG(GR_W + ((rt * 8 + 2 * d) * 64 + lane) * 16), b0, P1[rt]);     P2[rt] = MFMA32(LFRAG(GR_Q + ((rt * 8 + 2 * d) * 64 + lane) * 16), b0, P2[rt]);
                    P1[rt] = MFMA32(LFRAG(GR_W + ((rt * 8 + 2 * d + 1) * 64 + lane) * 16), b1, P1[rt]); P2[rt] = MFMA32(LFRAG(GR_Q + ((rt * 8 + 2 * d + 1) * 64 + lane) * 16), b1, P2[rt]);
                }
                __builtin_amdgcn_sched_barrier(0);
            }
            const bf16x8 bv0 = pack_acc<0>(P1[0]), bv1 = pack_acc<1>(P1[0]), bv2 = pack_acc<0>(P1[1]), bv3 = pack_acc<1>(P1[1]);
#pragma unroll
            for (int rt = 0; rt < 2; ++rt) {
                P2[rt] = MFMA32(LFRAG(GR_A + ((rt * 4 + 0) * 64 + lane) * 16), bv0, P2[rt]); P2[rt] = MFMA32(LFRAG(GR_A + ((rt * 4 + 1) * 64 + lane) * 16), bv1, P2[rt]);
                P2[rt] = MFMA32(LFRAG(GR_A + ((rt * 4 + 2) * 64 + lane) * 16), bv2, P2[rt]); P2[rt] = MFMA32(LFRAG(GR_A + ((rt * 4 + 3) * 64 + lane) * 16), bv3, P2[rt]);
                __builtin_amdgcn_sched_barrier(0);
            }
            {
                bf16* op = O16 + (size_t)(b * SEQ + c * 64) * 6144 + 2048 + vh * 128 + 32 * slab + r;
#pragma unroll
                for (int rt = 0; rt < 2; ++rt)
#pragma unroll
                    for (int i = 0; i < 16; ++i) op[(size_t)(32 * rt + crow_(i, h)) * 6144] = (bf16)(cvtpk(P2[rt][i], 0.f) & 0xffffu);
            }
#pragma unroll
            for (int d = 0; d < 4; ++d) {
#pragma unroll
                for (int i = 0; i < 16; ++i) S[d][i] *= dec;
                S[d] = MFMA32(LFRAG(GR_K + ((d * 4 + 0) * 64 + lane) * 16), bv0, S[d]); S[d] = MFMA32(LFRAG(GR_K + ((d * 4 + 1) * 64 + lane) * 16), bv1, S[d]);
                S[d] = MFMA32(LFRAG(GR_K + ((d * 4 + 2) * 64 + lane) * 16), bv2, S[d]); S[d] = MFMA32(LFRAG(GR_K + ((d * 4 + 3) * 64 + lane) * 16), bv3, S[d]);
                __builtin_amdgcn_sched_barrier(0);
            }
        }
    }
    if (wid < 4) {
        asm volatile("" : "+v"(lane)); const int r = lane & 31, h = lane >> 5;
        float* so = a.out() + O_GDP + (size_t)((b * 32 + vh) * 128) * 128 + 32 * slab + r;
#pragma unroll
        for (int d = 0; d < 4; ++d)
#pragma unroll
            for (int i = 0; i < 16; ++i) so[(size_t)(32 * d + crow_(i, h)) * 128] = S[d][i];
    }
    __syncthreads();
}
__device__ __forceinline__ void hgrn_seq_block(const PA& a, LAS unsigned char* lds, int u, int tid, int wid, int lane) {
    unsigned char* ws = a.ws();
    const int b = u >> 4, hd = u & 15, slab = wid;
    bf16* O16 = (bf16*)(ws + WS_O16);
    f32x16 S[4];
#pragma unroll
    for (int d = 0; d < 4; ++d)
#pragma unroll
        for (int i = 0; i < 16; ++i) S[d][i] = 0.f;
    for (int c = 0; c < 32; ++c) {
        const unsigned char* rec = ws + WS_HREC + (size_t)((b * 16 + hd) * 32 + c) * HREC_BYTES;
        stage_image<8>(lds, rec, HR_IMG, tid);
        asm volatile("" : "+v"(lane));
        const int r = lane & 31, h = lane >> 5;
        if (wid < 4) {
            f32x16 o[2];
#pragma unroll
            for (int rt = 0; rt < 2; ++rt)
#pragma unroll
                for (int i = 0; i < 16; ++i) o[rt][i] = 0.f;
#pragma unroll
            for (int d = 0; d < 4; ++d) {
                const bf16x8 b0 = pack_acc<0>(S[d]), b1 = pack_acc<1>(S[d]);
#pragma unroll
                for (int rt = 0; rt < 2; ++rt) { o[rt] = MFMA32(LFRAG(HR_Q + ((rt * 8 + 2 * d) * 64 + lane) * 16), b0, o[rt]); o[rt] = MFMA32(LFRAG(HR_Q + ((rt * 8 + 2 * d + 1) * 64 + lane) * 16), b1, o[rt]); }
                __builtin_amdgcn_sched_barrier(0);
            }
            const bf16x8 i0 = LFRAG(HR_I + ((slab * 4 + 0) * 64 + lane) * 16), i1 = LFRAG(HR_I + ((slab * 4 + 1) * 64 + lane) * 16), i2 = LFRAG(HR_I + ((slab * 4 + 2) * 64 + lane) * 16), i3 = LFRAG(HR_I + ((slab * 4 + 3) * 64 + lane) * 16);
#pragma unroll
            for (int rt = 0; rt < 2; ++rt) {
                o[rt] = MFMA32(LFRAG(HR_A + ((rt * 4 + 0) * 64 + lane) * 16), i0, o[rt]); o[rt] = MFMA32(LFRAG(HR_A + ((rt * 4 + 1) * 64 + lane) * 16), i1, o[rt]);
                o[rt] = MFMA32(LFRAG(HR_A + ((rt * 4 + 2) * 64 + lane) * 16), i2, o[rt]); o[rt] = MFMA32(LFRAG(HR_A + ((rt * 4 + 3) * 64 + lane) * 16), i3, o[rt]);
                __builtin_amdgcn_sched_barrier(0);
            }
            {
                bf16* op = O16 + (size_t)(b * SEQ + c * 64) * 6144 + hd * 128 + 32 * slab + r;
#pragma unroll
                for (int rt = 0; rt < 2; ++rt)
#pragma unroll
                    for (int i = 0; i < 16; ++i) op[(size_t)(32 * rt + crow_(i, h)) * 6144] = (bf16)(cvtpk(o[rt][i], 0.f) & 0xffffu);
            }
            const LAS float* dec = (const LAS float*)(lds + HR_DEC);
#pragma unroll
            for (int d = 0; d < 4; ++d) {
#pragma unroll
                for (int i4 = 0; i4 < 4; ++i4) { const f32x4 dv = *(const LAS f32x4*)(dec + 32 * d + 8 * i4 + 4 * h);
#pragma unroll
                    for (int e = 0; e < 4; ++e) S[d][4 * i4 + e] *= dv[e]; }
                S[d] = MFMA32(LFRAG(HR_K + ((d * 4 + 0) * 64 + lane) * 16), i0, S[d]); S[d] = MFMA32(LFRAG(HR_K + ((d * 4 + 1) * 64 + lane) * 16), i1, S[d]);
                S[d] = MFMA32(LFRAG(HR_K + ((d * 4 + 2) * 64 + lane) * 16), i2, S[d]); S[d] = MFMA32(LFRAG(HR_K + ((d * 4 + 3) * 64 + lane) * 16), i3, S[d]);
                __builtin_amdgcn_sched_barrier(0);
            }
        }
    }
    if (wid < 4) {
        asm volatile("" : "+v"(lane)); const int r = lane & 31, h = lane >> 5;
        float* so = a.out() + O_HGP + (size_t)((b * 16 + hd) * 128) * 128 + 32 * slab + r;
#pragma unroll
        for (int d = 0; d < 4; ++d)
#pragma unroll
            for (int i = 0; i < 16; ++i) so[(size_t)(32 * d + crow_(i, h)) * 128] = S[d][i];
    }
    __syncthreads();
}

#define XB_TMO      128
#define XB_XCNT(j)  (256  + 64 * (j))
#define XB_XSUB(j)  (1280 + 64 * (j))
#define XB_XGEN(j)  (2304 + 64 * (j))
#define XB_TOP      3328
#define XB_TOPGEN   3392
#define XCD_BAR_WORDS 3456
#define XB_SPIN_CAP (1u << 18)
__device__ __forceinline__ unsigned xb_ld(unsigned* p)              { return __hip_atomic_load(p, __ATOMIC_RELAXED, __HIP_MEMORY_SCOPE_AGENT); }
__device__ __forceinline__ unsigned xb_add(unsigned* p, unsigned v) { return __hip_atomic_fetch_add(p, v, __ATOMIC_RELAXED, __HIP_MEMORY_SCOPE_AGENT); }
__device__ __forceinline__ unsigned xb_xcc_id() { return (unsigned)__builtin_amdgcn_s_getreg((3 << 11) | 20) & 0xFu; }
#define XB_SPIN(cond, bar) do { unsigned _sp = 0; while (cond) { __builtin_amdgcn_s_sleep(1); \
    if ((++_sp & 255u) == 0u) { if (xb_ld(&(bar)[XB_TMO])) break; if (_sp > XB_SPIN_CAP) { atomicAdd(&(bar)[XB_TMO], 1u); break; } } } } while (0)
__device__ __forceinline__ void xcd_barrier_complete(unsigned* bar, unsigned x, unsigned G, unsigned& nloc, unsigned& nx) {
    unsigned sum, cnt, mine, sp = 0u;
    for (;;) {
        sum = 0u; cnt = 0u; mine = 0u;
#pragma unroll
        for (unsigned j = 0; j < 16; ++j) { const unsigned c = xb_ld(&bar[XB_XCNT(j)]); sum += c; cnt += (c > 0u) ? 1u : 0u; mine = (j == x) ? c : mine; }
        if (sum == G) break;
        __builtin_amdgcn_s_sleep(1);
        if ((++sp & 255u) == 0u) { if (xb_ld(&bar[XB_TMO])) break; if (sp > XB_SPIN_CAP) { atomicAdd(&bar[XB_TMO], 1u); break; } }
    }
    nloc = mine > 0u ? mine : 1u; nx = cnt > 0u ? cnt : 1u;
}
__device__ __forceinline__ void xcd_barrier(unsigned* bar, unsigned x, volatile LAS unsigned* st, int tid, unsigned G) {
    asm volatile("s_waitcnt vmcnt(0)" ::: "memory");
    __syncthreads();
    if (tid == 0) {
        __builtin_amdgcn_s_waitcnt(0);
        unsigned nloc = st[0], nx = st[1];
        if (nloc == 0u) { xcd_barrier_complete(bar, x, G, nloc, nx); st[0] = nloc; st[1] = nx; }
        const unsigned old = xb_add(&bar[XB_XSUB(x)], 1u);
        const unsigned gen = old / nloc;
        if (old + 1u == (gen + 1u) * nloc) {
            __builtin_amdgcn_fence(__ATOMIC_RELEASE, "agent");
            asm volatile("s_waitcnt vmcnt(0)" ::: "memory");
            const unsigned og = xb_add(&bar[XB_TOP], 1u);
            const unsigned tg = og / nx;
            if (og + 1u == (tg + 1u) * nx) xb_add(&bar[XB_TOPGEN], 1u);
            else XB_SPIN(xb_ld(&bar[XB_TOPGEN]) == tg, bar);
            __builtin_amdgcn_fence(__ATOMIC_ACQUIRE, "agent");
            xb_add(&bar[XB_XGEN(x)], 1u);
            asm volatile("s_waitcnt vmcnt(0)" ::: "memory");
        } else {
            XB_SPIN(xb_ld(&bar[XB_XGEN(x)]) == gen, bar);
            __builtin_amdgcn_fence(__ATOMIC_ACQUIRE, "agent");
            asm volatile("s_waitcnt vmcnt(0)" ::: "memory");
        }
    }
    __syncthreads();
}
constexpr int CW_WORK = 64;
constexpr int CW_BAR = 4096;
constexpr size_t CTL_ZERO_BYTES = 65536;
constexpr int LDS_ST_OFF = LDS_BYTES - 64;

__global__ void __launch_bounds__(NTHREADS, 2) fwd(Args args_unused) {
    extern __shared__ __attribute__((aligned(16))) unsigned char lds_raw[];
    LAS unsigned char* lds = (LAS unsigned char*)lds_raw;
    const int wid = __builtin_amdgcn_readfirstlane(threadIdx.x >> 6);
    const int G = gridDim.x, bx = blockIdx.x;
    const int vcu = (G % 8 == 0) ? (bx % 8) * (G / 8) + bx / 8 : bx;
    const int gw = vcu * NWAVES + wid, NGW = G * NWAVES;
    volatile LAS unsigned* bst = (volatile LAS unsigned*)(lds + LDS_ST_OFF);
    const unsigned xcc = xb_xcc_id();
    { const PA a0 = PA::get(); const int l0 = lane_id_(); if (wid == 0 && l0 < 2) bst[l0] = 0u;
      if (a0.ph_hi() - a0.ph_lo() > 1 && wid == 0 && l0 == 0) (void)xb_add((unsigned*)a0.ws() + CW_BAR + XB_XCNT(xcc), 1u); }
    __syncthreads();
#ifndef PH_MASK
#define PH_MASK 0xffff
#endif
#define IN(k) (((PH_MASK >> (k)) & 1) && ph_in(k))
#define SEAM(k) do { if (IN(k) && IN((k) + 1)) { if ((k) == 0) cg::this_grid().sync(); \
    else { const PA ab = PA::get(); xcd_barrier((unsigned*)ab.ws() + CW_BAR, xcc, bst, wid * 64 + lane_id_(), (unsigned)G); } } } while (0)

    if (IN(0)) { const PA a = PA::get(); unsigned char* ws = a.ws(); const int lane = lane_id_(), tid = wid * 64 + lane; (void)tid;
        for (int cb = vcu; cb < NADA / 64; cb += G) mod_item(a, lds, cb, tid, wid, lane);
        __syncthreads();
        LAS float* scr = (LAS float*)(lds + wid * 16384);
        constexpr int I0 = 32 * 770, I1 = 32 * 64, I2 = 64 * 64, I3 = 32 * 64, I4 = 32 * 256, I5 = 128 * 64, NIT = I0 + I1 + I2 + I3 + I4 + I5;
        bf16* BtIn = (bf16*)(ws + WS_BTIN); bf16* BtOut = (bf16*)(ws + WS_BTOUT); bf16* BtO = (bf16*)(ws + WS_BTO); bf16* BtUp = (bf16*)(ws + WS_BTUP); bf16* BtDn = (bf16*)(ws + WS_BTDN);
        for (int it = gw; it < NIT; it += NGW) {
            int r = it;
            if (r < I0) { const int kb = r / 770, nb = r % 770, n0 = nb * 32; const int nd = n0 < 20480 ? n0 : (n0 < 20544 ? n0 - 20480 + 24576 : n0 - 64);
                transpose_item(a.in(I_WIN), N_IN, BtIn, 2048, kb * 64, n0, nd, scr, lane); continue; } r -= I0;
            if (r < I1) { transpose_item(a.in(I_WOHG), 2048, BtOut, 6144, (r / 64) * 64, (r % 64) * 32, (r % 64) * 32, scr, lane); continue; } r -= I1;
            if (r < I2) { transpose_item(a.in(I_WOGD), 2048, BtOut + 2048, 6144, (r / 64) * 64, (r % 64) * 32, (r % 64) * 32, scr, lane); continue; } r -= I2;
            if (r < I3) { transpose_item(a.in(I_WO), 2048, BtO, 2048, (r / 64) * 64, (r % 64) * 32, (r % 64) * 32, scr, lane); continue; } r -= I3;
            if (r < I4) { transpose_item(a.in(I_WUP), 8192, BtUp, 2048, (r / 256) * 64, (r % 256) * 32, (r % 256) * 32, scr, lane); continue; } r -= I4;
            transpose_item(a.in(I_WDN), 2048, BtDn, 8192, (r / 64) * 64, (r % 64) * 32, (r % 64) * 32, scr, lane);
        }
        { u32x4* z = (u32x4*)(BtIn + (size_t)N_IN * 2048); const int nz = (N_INP - N_IN) * 2048 * 2 / 16;
          for (int i = vcu * NTHREADS + tid; i < nz; i += G * NTHREADS) z[i] = (u32x4){0u, 0u, 0u, 0u}; }
    }
    SEAM(0);
    if (IN(1)) { const PA a = PA::get(); unsigned char* ws = a.ws(); const int lane = lane_id_(), tid = wid * 64 + lane; (void)tid;
        const float* mod = (const float*)(ws + WS_MOD); const float* ng = a.in(I_NG); bf16* A1 = (bf16*)(ws + WS_A1);
        for (int row = gw; row < MROWS; row += NGW) {
            const f32x4* xr = (const f32x4*)xrow_ptr(a, row) + lane; const float* md = mod + (size_t)seq_of_row(row) * NADA;
            f32x4 v[8]; float ss = 0.f;
#pragma unroll
            for (int j = 0; j < 8; ++j) { v[j] = xr[64 * j]; ss += (v[j][0] * v[j][0] + v[j][1] * v[j][1]) + (v[j][2] * v[j][2] + v[j][3] * v[j][3]); }
            const float r = rsqrtf(wave_sum(ss) * (1.f / DM) + EPS);
            u32x2* o = (u32x2*)(A1 + (size_t)row * DM) + lane;
#pragma unroll
            for (int j = 0; j < 8; ++j) { const int c = 4 * lane + 256 * j; const f32x4 g = *(const f32x4*)(ng + c), sh = *(const f32x4*)(md + c), sc = *(const f32x4*)(md + 2048 + c);
                f32x4 y; _Pragma("unroll") for (int e = 0; e < 4; ++e) y[e] = v[j][e] * r * g[e] * (1.f + sc[e]) + sh[e];
                o[64 * j] = (u32x2){pk2(y[0], y[1]), pk2(y[2], y[3])}; }
        }
    }
    SEAM(1);
    if (IN(2)) { const PA a = PA::get(); unsigned char* ws = a.ws(); const int lane = lane_id_(), tid = wid * 64 + lane; (void)tid;
        pg8::Gemm g{(const bf16*)(ws + WS_A1), (const bf16*)(ws + WS_BTIN), 2048, 2048, 2048}; pg8::StaticOrder S; S.init(MROWS, N_INP, G, bx);
        EpiIn E{ws, a.in(I_LB), a.in(I_ALOG), a.in(I_DTB)};
        pg8::gemm_phase<EpiIn, pg8::StaticOrder, true, true>(lds, g, S, E, wid);
    }
    SEAM(2);
    if (IN(3)) { const PA a = PA::get(); unsigned char* ws = a.ws(); const int lane = lane_id_(), tid = wid * 64 + lane; (void)tid;
#ifndef NO_GP
        for (int u = bx; u < 2048; u += G) gdn_prep_unit(a, lds, u, tid, wid, lane);
#endif
#ifndef NO_HP
        for (int u = bx; u < 2048; u += G) hgrn_prep_unit(a, lds, u, tid, wid, lane);
#endif
        { const bf16* US = (const bf16*)(ws + WS_US); bf16* UCS = (bf16*)(ws + WS_UCS); const float* cw = a.in(I_CW); const float* cc = a.in(I_CC);
          for (int it = gw; it < 512 * 64; it += NGW) {
            const int row = it >> 6, g = it & 63, c = g * 128 + 2 * lane, t = row & 3, b = row >> 2;
            float x0 = 0.f, x1 = 0.f;
#pragma unroll
            for (int j = 0; j < 4; ++j) {
                const int tt = t - 3 + j; float u0, u1;
                if (tt >= 0) { const unsigned w = *(const unsigned*)(US + (size_t)(row - 3 + j) * CONVCH + c); u0 = bflo(w); u1 = bfhi(w); }
                else { const f32x2 w = *(const f32x2*)(cc + ((size_t)b * 3 + (3 + tt)) * CONVCH + c); u0 = w[0]; u1 = w[1]; }
                const f32x2 wj = *(const f32x2*)(cw + (size_t)j * CONVCH + c);
                x0 = fmaf(wj[0], u0, x0); x1 = fmaf(wj[1], u1, x1);
            }
            x0 = siluf_(x0); x1 = siluf_(x1);
            if (g < 32) { const float ss = wave_sum(x0 * x0 + x1 * x1); float r = rsqrtf(ss + EPS); if (g < 16) r *= 0.08838834764831845f; x0 *= r; x1 *= r; }
            *(unsigned*)(UCS + (size_t)row * CONVCH + c) = pk2(x0, x1);
          }
          const bf16* UPr = (const bf16*)(ws + WS_UP);
          for (int i = vcu * NTHREADS + tid; i < (12 + 384) * (CONVCH / 2); i += G * NTHREADS) {
            const int rr = i / (CONVCH / 2), c = (i % (CONVCH / 2)) * 2; const bf16* src; float* dst;
            if (rr < 12) { const int b = rr / 3, j = rr % 3; src = UPr + (size_t)(b * SEQ + SEQ - 3 + j) * CONVCH + c; dst = a.out() + O_CCP + (size_t)rr * CONVCH + c; }
            else { const int r2 = rr - 12, b = r2 / 3, j = r2 % 3; src = US + (size_t)(b * DSEQ + 1 + j) * CONVCH + c; dst = a.out() + O_CCS + (size_t)r2 * CONVCH + c; }
            const unsigned w = *(const unsigned*)src;
            *(f32x2*)dst = (f32x2){bflo(w), bfhi(w)};
          } }
    }
    SEAM(3);
    if (IN(4)) { const PA a = PA::get(); unsigned char* ws = a.ws(); const int lane = lane_id_(), tid = wid * 64 + lane; (void)tid;
#ifndef NO_GS
        if (bx < 128) gdn_seq_block(a, lds, bx, tid, wid, lane);
#endif
#ifndef NO_HS
        if (bx >= 128 && bx < 192) hgrn_seq_block(a, lds, bx - 128, tid, wid, lane);
#endif
        LAS float* wl = (LAS float*)(lds + wid * 4096);
        unsigned* ctr = (unsigned*)ws + CW_WORK;
        constexpr int NI_HS = 8192, NI_GS = 16384;
        for (;;) {
            const int ln = lane_id_();
            int it = 0; if (ln == 0) it = (int)atomicAdd(ctr, 1u);
            it = __builtin_amdgcn_readfirstlane(it);
            if (it >= NI_HS + NI_GS) break;
#ifndef NO_GI
            if (it < NI_GS) gdn_item(a, wl, it >> 7, (it >> 2) & 31, it & 3, ln);
#endif
#ifndef NO_HI
            if (it >= NI_GS) { const int r = it - NI_GS; hgrn_item(a, wl, r >> 6, (r >> 2) & 15, r & 3, ln); }
#endif
        }
    }
    SEAM(4);
    if (IN(5)) { const PA a = PA::get(); unsigned char* ws = a.ws(); const int lane = lane_id_(), tid = wid * 64 + lane; (void)tid;
        const bf16* O16 = (const bf16*)(ws + WS_O16); bf16* OA = (bf16*)(ws + WS_OA); const bf16* Gh = (const bf16*)(ws + WS_GH); const bf16* Gz = (const bf16*)(ws + WS_GZ);
        for (int it = gw; it < MROWS * 48; it += NGW) {
            const int row = it / 48, hd = it % 48; const size_t co = (size_t)row * 6144 + hd * 128 + 2 * lane;
            const unsigned ow = *(const unsigned*)(O16 + co); const float o0 = bflo(ow), o1 = bfhi(ow);
            const float r = rsqrtf(wave_sum(o0 * o0 + o1 * o1) * (1.f / 128.f) + EPS);
            const f32x2 g = *(const f32x2*)((hd < 16 ? a.in(I_HGN) : a.in(I_GDN)) + 2 * lane);
            const unsigned gt = hd < 16 ? *(const unsigned*)(Gh + (size_t)row * 2048 + hd * 128 + 2 * lane) : *(const unsigned*)(Gz + (size_t)row * 4096 + (hd - 16) * 128 + 2 * lane);
            *(unsigned*)(OA + co) = pk2(o0 * r * g[0] * bflo(gt), o1 * r * g[1] * bfhi(gt));
        }
    }
    SEAM(5);
    if (IN(6)) { const PA a = PA::get(); unsigned char* ws = a.ws(); const int lane = lane_id_(), tid = wid * 64 + lane; (void)tid;
        pg8::Gemm g{(const bf16*)(ws + WS_OA), (const bf16*)(ws + WS_BTOUT), 6144, 6144, 2048}; pg8::StaticOrder S; S.init(MROWS, 2048, G, bx);
        EpiOut1 E{(float*)(ws + WS_T1), (const bf16*)(ws + WS_SA)};
        pg8::gemm_phase<EpiOut1, pg8::StaticOrder, true, true>(lds, g, S, E, wid);
    }
    SEAM(6);
    if (IN(7)) { const PA a = PA::get(); unsigned char* ws = a.ws(); const int lane = lane_id_(), tid = wid * 64 + lane; (void)tid;
        pg8::Gemm g{(const bf16*)(ws + WS_OA) + 2048, (const bf16*)(ws + WS_BTOUT) + 2048, 6144, 6144, 4096}; pg8::StaticOrder S; S.init(MROWS, 2048, G, bx);
        EpiOut2 E{(const float*)(ws + WS_T1), (const bf16*)(ws + WS_SB), (bf16*)(ws + WS_MG)};
        pg8::gemm_phase<EpiOut2, pg8::StaticOrder, true, true>(lds, g, S, E, wid);
    }
    SEAM(7);
    if (IN(8)) { const PA a = PA::get(); unsigned char* ws = a.ws(); const int lane = lane_id_(), tid = wid * 64 + lane; (void)tid;
        pg8::Gemm g{(const bf16*)(ws + WS_MG), (const bf16*)(ws + WS_BTO), 2048, 2048, 2048}; pg8::StaticOrder S; S.init(MROWS, 2048, G, bx);
        EpiF32 E{(float*)(ws + WS_MIX), 2048};
        pg8::gemm_phase<EpiF32, pg8::StaticOrder, true, true>(lds, g, S, E, wid);
    }
    SEAM(8);
    if (IN(9)) { const PA a = PA::get(); unsigned char* ws = a.ws(); const int lane = lane_id_(), tid = wid * 64 + lane; (void)tid;
        const float* mod = (const float*)(ws + WS_MOD); const float* ng = a.in(I_NG); bf16* A1 = (bf16*)(ws + WS_A1); const float* MIX = (const float*)(ws + WS_MIX); float* H = (float*)(ws + WS_H);
        for (int row = gw; row < MROWS; row += NGW) {
            const f32x4* xr = (const f32x4*)xrow_ptr(a, row) + lane; const f32x4* mr = (const f32x4*)(MIX + (size_t)row * DM) + lane; const float* md = mod + (size_t)seq_of_row(row) * NADA;
            f32x4 v[8]; float ss = 0.f;
#pragma unroll
            for (int j = 0; j < 8; ++j) { v[j] = mr[64 * j]; ss += (v[j][0] * v[j][0] + v[j][1] * v[j][1]) + (v[j][2] * v[j][2] + v[j][3] * v[j][3]); }
            const float r1 = rsqrtf(wave_sum(ss) * (1.f / DM) + EPS);
            f32x4* ho = (f32x4*)(H + (size_t)row * DM) + lane; float s2 = 0.f;
#pragma unroll
            for (int j = 0; j < 8; ++j) { const int c = 4 * lane + 256 * j; const f32x4 g = *(const f32x4*)(ng + 2048 + c), g1 = *(const f32x4*)(md + 4096 + c), x = xr[64 * j];
                _Pragma("unroll") for (int e = 0; e < 4; ++e) { v[j][e] = x[e] + g1[e] * (v[j][e] * r1 * g[e]); s2 += v[j][e] * v[j][e]; }
                ho[64 * j] = v[j]; }
            const float r2 = rsqrtf(wave_sum(s2) * (1.f / DM) + EPS);
            u32x2* o = (u32x2*)(A1 + (size_t)row * DM) + lane;
#pragma unroll
            for (int j = 0; j < 8; ++j) { const int c = 4 * lane + 256 * j; const f32x4 g = *(const f32x4*)(ng + 4096 + c), sh = *(const f32x4*)(md + 6144 + c), sc = *(const f32x4*)(md + 8192 + c);
                f32x4 y; _Pragma("unroll") for (int e = 0; e < 4; ++e) y[e] = v[j][e] * r2 * g[e] * (1.f + sc[e]) + sh[e];
                o[64 * j] = (u32x2){pk2(y[0], y[1]), pk2(y[2], y[3])}; }
        }
    }
    SEAM(9);
    if (IN(10)) { const PA a = PA::get(); unsigned char* ws = a.ws(); const int lane = lane_id_(), tid = wid * 64 + lane; (void)tid;
        pg8::Gemm g{(const bf16*)(ws + WS_A1), (const bf16*)(ws + WS_BTUP), 2048, 2048, 2048}; pg8::StaticOrder S; S.init(MROWS, DFF, G, bx);
        EpiRelu2 E{(bf16*)(ws + WS_U2), DFF};
        pg8::gemm_phase<EpiRelu2, pg8::StaticOrder, true, true>(lds, g, S, E, wid);
    }
    SEAM(10);
    if (IN(11)) { const PA a = PA::get(); unsigned char* ws = a.ws(); const int lane = lane_id_(), tid = wid * 64 + lane; (void)tid;
        pg8::Gemm g{(const bf16*)(ws + WS_U2), (const bf16*)(ws + WS_BTDN), DFF, DFF, DFF}; pg8::StaticOrder S; S.init(MROWS, 2048, G, bx);
        EpiF32 E{(float*)(ws + WS_FF), 2048};
        pg8::gemm_phase<EpiF32, pg8::StaticOrder, true, true>(lds, g, S, E, wid);
    }
    SEAM(11);
    if (IN(12)) { const PA a = PA::get(); unsigned char* ws = a.ws(); const int lane = lane_id_(), tid = wid * 64 + lane; (void)tid;
        const float* mod = (const float*)(ws + WS_MOD); const float* ng = a.in(I_NG); const float* FF = (const float*)(ws + WS_FF); const float* H = (const float*)(ws + WS_H);
        for (int row = gw; row < MROWS; row += NGW) {
            const f32x4* fr_ = (const f32x4*)(FF + (size_t)row * DM) + lane; const f32x4* hr = (const f32x4*)(H + (size_t)row * DM) + lane; const float* md = mod + (size_t)seq_of_row(row) * NADA;
            f32x4 v[8]; float ss = 0.f;
#pragma unroll
            for (int j = 0; j < 8; ++j) { v[j] = fr_[64 * j]; ss += (v[j][0] * v[j][0] + v[j][1] * v[j][1]) + (v[j][2] * v[j][2] + v[j][3] * v[j][3]); }
            const float r = rsqrtf(wave_sum(ss) * (1.f / DM) + EPS);
            f32x4* yo = (f32x4*)(a.out() + O_Y + (size_t)row * DM) + lane;
#pragma unroll
            for (int j = 0; j < 8; ++j) { const int c = 4 * lane + 256 * j; const f32x4 g = *(const f32x4*)(ng + 6144 + c), g2 = *(const f32x4*)(md + 10240 + c), h = hr[64 * j];
                f32x4 y; _Pragma("unroll") for (int e = 0; e < 4; ++e) y[e] = h[e] + g2[e] * (v[j][e] * r * g[e]);
                yo[64 * j] = y; }
        }
    }
#undef IN
#undef SEAM
}

constexpr int N_PHASES = 13;
extern "C" void kernel_launch(void* const* d_in, const int* in_sizes, int n_in, void* d_out, int out_size, void* d_ws, size_t ws_size, hipStream_t stream) {
    static int grid = 0;
    if (grid == 0) {
        if (n_in != 22 || (size_t)out_size != O_END || ws_size < WS_END) { fprintf(stderr, "kernel_launch: unexpected shapes: n_in %d out %d ws %zu\n", n_in, out_size, ws_size); grid = -1; return; }
        int dev = 0, cus = 0, per_cu = 0;
        if (hipGetDevice(&dev) != hipSuccess || hipDeviceGetAttribute(&cus, hipDeviceAttributeMultiprocessorCount, dev) != hipSuccess) { grid = -1; return; }
        if (hipFuncSetAttribute((const void*)fwd, hipFuncAttributeMaxDynamicSharedMemorySize, LDS_BYTES) != hipSuccess) { fprintf(stderr, "kernel_launch: hipFuncSetAttribute failed\n"); grid = -1; return; }
        if (hipOccupancyMaxActiveBlocksPerMultiprocessor(&per_cu, (const void*)fwd, NTHREADS, LDS_BYTES) != hipSuccess || per_cu < 1) { fprintf(stderr, "kernel_launch: occupancy query says %d\n", per_cu); (void)hipGetLastError(); per_cu = 1; }
        grid = cus;
    }
    if (grid < 0) return;
    if (hipMemsetAsync(d_ws, 0, CTL_ZERO_BYTES, stream) != hipSuccess) { fprintf(stderr, "kernel_launch: memset failed\n"); return; }
    Args a{};
    for (int i = 0; i < 22; ++i) a.in[i] = (const float*)d_in[i];
    a.out = (float*)d_out; a.ws = (unsigned char*)d_ws;
#ifdef MULTI_LAUNCH
    for (int p = 0; p < N_PHASES; ++p) { a.ph_lo = p; a.ph_hi = p + 1; hipLaunchKernelGGL(fwd, dim3(grid), dim3(NTHREADS), LDS_BYTES, stream, a); }
#else
    a.ph_lo = 0; a.ph_hi = N_PHASES;
    void* args[] = {&a};
    hipError_t e = hipLaunchCooperativeKernel((const void*)fwd, dim3(grid), dim3(NTHREADS), args, LDS_BYTES, stream);
    if (e != hipSuccess) fprintf(stderr, "cooperative launch failed: %s (grid %d)\n", hipGetErrorString(e), grid);
#endif
}
```

```cpp
#include <hip/hip_runtime.h>
#include <hip/hip_cooperative_groups.h>
#include <cstdio>
#include <cstdint>
namespace cg = cooperative_groups;
__device__ __forceinline__ int lane_id_() { int l; asm volatile("v_mbcnt_lo_u32_b32 %0, -1, 0\n\tv_mbcnt_hi_u32_b32 %0, -1, %0" : "=v"(l)); return l; }
namespace pg8 {
#define PG8_LAS __attribute__((address_space(3)))
typedef unsigned short bf16_t;
typedef short bf16x8 __attribute__((ext_vector_type(8)));
typedef float f32x4 __attribute__((ext_vector_type(4)));
typedef unsigned u32x4 __attribute__((ext_vector_type(4)));
constexpr int BM = 256, BK = 64, HALF = 128, HTB = HALF * BK * 2  , STAGE_BYTES = 8 * HTB, NXCD = 8, WGM = 8;

__host__ __device__ __forceinline__ int lds_byte(int r, int c) { const int st = (r >> 4) * 2 + (c >> 5), rr = r & 15, cc = c & 31, ob = rr * 64 + cc * 2; return st * 1024 + (ob ^ (((ob >> 9) & 1) << 5)); }
__host__ __device__ __forceinline__ void stage_rc(int b, int& R, int& C) { const int st = b / 1024, sb = b % 1024, swz = sb ^ (((sb >> 9) & 1) << 5); R = (st >> 1) * 16 + swz / 64; C = (st & 1) * 32 + (swz % 64) / 2; }
__host__ __device__ __forceinline__ int perm32(int rho) { const int n = rho >> 4, i = rho & 15; return 8 * (i >> 2) + 4 * n + (i & 3); }

struct Unit { int pm, pn; };
struct Gemm { const bf16_t* A; const bf16_t* Bt; int lda, ldb, K; };

struct StaticOrder {
    int nM, nN, nwg, G, c;
    __host__ __device__ void init(int M, int N, int G_, int c_) { nM = M / BM; nN = N / BM; nwg = nM * nN; G = G_; c = c_; }
    __host__ __device__ bool next(int i, Unit& u) const {
        const long L = (long)i * G + c; if (L >= nwg) return false;
        int wgid = (int)L; { const int q = nwg / NXCD, r = nwg % NXCD, xcd = wgid % NXCD, off = wgid / NXCD; wgid = (xcd < r ? xcd * (q + 1) : r * (q + 1) + (xcd - r) * q) + off; }
        const int nig = WGM * nN, gid = wgid / nig, fm = gid * WGM, gsz = (nM - fm) < WGM ? (nM - fm) : WGM;
        u.pm = fm + ((wgid % nig) % gsz); u.pn = (wgid % nig) / gsz; return true;
    }
    __device__ __forceinline__ void a_ready(const Unit&) const {}
    __device__ __forceinline__ void done(const Unit&) const {}
};

__device__ __forceinline__ unsigned cvt_pk_bf16(float lo, float hi) { unsigned r; asm volatile("v_cvt_pk_bf16_f32 %0, %1, %2" : "=v"(r) : "v"(lo), "v"(hi)); return r; }

template <class Epi, class Sched, bool ALIGN_EPI = false, bool SP2 = false>
__device__ __forceinline__ void gemm_phase(PG8_LAS unsigned char* lds, const Gemm g, const Sched& S, const Epi& E, int wid_in) {
    const int wid = wid_in, lane = lane_id_(), tid = wid * 64 + lane, wr = wid >> 2, wc = wid & 3, fr = lane & 15, fq = lane >> 4;
    const int K = g.K, nt = K / BK;
    unsigned voffA[2], voffB[2];
#pragma unroll
    for (int i = 0; i < 2; ++i) { int R, C; stage_rc(tid * 16 + i * 8192, R, C); const int Rb = Epi::PERM ? ((R & ~31) + perm32(R & 31)) : R;
        voffA[i] = (unsigned)(R * g.lda + C) * 2u; voffB[i] = (unsigned)(Rb * g.ldb + C) * 2u; }
    const size_t kstep = (size_t)(BK * 2);
    const size_t hstepA = (size_t)HALF * g.lda * 2, hstepB = (size_t)HALF * g.ldb * 2;
    const size_t tstepA = 2 * hstepA, tstepB = 2 * hstepB;
    const unsigned ldsw = (unsigned)wid * 1024u;
    const int aoff = lds_byte(wr * 64 + fr, fq * 8), boff = lds_byte(wc * 32 + fr, fq * 8);
#define PG8_SA(b, h) (((b) * 2 + (h)) * HTB)
#define PG8_SB(b, h) ((4 + (b) * 2 + (h)) * HTB)
#define PG8_STAGE(bufoff, gbase, voff) do { _Pragma("unroll") for (int _i = 0; _i < 2; ++_i) \
        __builtin_amdgcn_global_load_lds((const unsigned*)((const char*)(gbase) + (voff)[_i]), (PG8_LAS unsigned*)(lds + (bufoff) + ldsw + _i * 8192), 16, 0, 0); } while (0)
#define PG8_LDA(dst, b, h) do { _Pragma("unroll") for (int m = 0; m < 4; ++m) _Pragma("unroll") for (int k = 0; k < 2; ++k) dst[m][k] = *(const PG8_LAS bf16x8*)(lds + PG8_SA(b, h) + aoff + m * 2048 + k * 1024); } while (0)
#define PG8_LDB(dst, b, h) do { _Pragma("unroll") for (int n = 0; n < 2; ++n) _Pragma("unroll") for (int k = 0; k < 2; ++k) dst[n][k] = *(const PG8_LAS bf16x8*)(lds + PG8_SB(b, h) + boff + n * 2048 + k * 1024); } while (0)
#define PG8_MMA(ai, bj, At, Bt) do { __builtin_amdgcn_s_setprio(1); _Pragma("unroll") for (int m = 0; m < 4; ++m) _Pragma("unroll") for (int n = 0; n < 2; ++n) _Pragma("unroll") for (int k = 0; k < 2; ++k) \
        acc[ai][bj][m][n] = __builtin_amdgcn_mfma_f32_16x16x32_bf16(Bt[n][k], At[m][k], acc[ai][bj][m][n], 0, 0, 0); __builtin_amdgcn_s_setprio(0); } while (0)
#define PG8_WAIT_V(n) asm volatile("s_waitcnt vmcnt(" #n ")" ::: "memory")
#define PG8_WAIT_L(n) asm volatile("s_waitcnt lgkmcnt(" #n ")" ::: "memory")
#define PG8_BAR __builtin_amdgcn_s_barrier()
#define PG8_SCHED __builtin_amdgcn_sched_barrier(0)
    Unit cur, nxt; int ui = 0;
    if (!S.next(0, cur)) return;
    f32x4 acc[2][2][4][2];
#pragma unroll
    for (int a = 0; a < 2; ++a)
#pragma unroll
        for (int b = 0; b < 2; ++b)
#pragma unroll
            for (int m = 0; m < 4; ++m)
#pragma unroll
                for (int n = 0; n < 2; ++n) acc[a][b][m][n] = (f32x4){0.f, 0.f, 0.f, 0.f};
    bf16x8 At[4][2], B0[2][2], B1[2][2];
    const char* cA = (const char*)g.A + (size_t)cur.pm * tstepA; const char* cB = (const char*)g.Bt + (size_t)cur.pn * tstepB;
    S.a_ready(cur);
    if constexpr (SP2) {
        PG8_STAGE(PG8_SB(0, 0), cB, voffB); PG8_STAGE(PG8_SB(0, 1), cB + hstepB, voffB); PG8_STAGE(PG8_SA(0, 0), cA, voffA); PG8_STAGE(PG8_SA(0, 1), cA + hstepA, voffA);
        if (wr == 1) PG8_BAR;
        PG8_WAIT_V(2); PG8_BAR;
        PG8_STAGE(PG8_SB(1, 0), cB + kstep, voffB); PG8_STAGE(PG8_SA(1, 0), cA + kstep, voffA); PG8_STAGE(PG8_SB(1, 1), cB + hstepB + kstep, voffB);
        PG8_WAIT_V(6); PG8_BAR;
    } else {
        PG8_STAGE(PG8_SB(0, 0), cB, voffB); PG8_STAGE(PG8_SA(0, 0), cA, voffA); PG8_STAGE(PG8_SB(0, 1), cB + hstepB, voffB); PG8_STAGE(PG8_SA(0, 1), cA + hstepA, voffA);
        if (wr == 1) PG8_BAR;
        PG8_WAIT_V(4); PG8_BAR;
        PG8_STAGE(PG8_SB(1, 0), cB + kstep, voffB); PG8_STAGE(PG8_SA(1, 0), cA + kstep, voffA); PG8_STAGE(PG8_SB(1, 1), cB + hstepB + kstep, voffB);
        PG8_WAIT_V(6); PG8_BAR;
    }
    for (;;) {
        const bool has_next = S.next(ui + 1, nxt);
        const char* nA = has_next ? (const char*)g.A + (size_t)nxt.pm * tstepA : cA; const char* nB = has_next ? (const char*)g.Bt + (size_t)nxt.pn * tstepB : cB;
        for (int t = 0; t < nt; t += 2) {
            const bool last = (t == nt - 2);
            const char* a1 = cA + (size_t)(t + 1) * kstep;
            const char* a2 = last ? nA : cA + (size_t)(t + 2) * kstep; const char* b2 = last ? nB : cB + (size_t)(t + 2) * kstep;
            const char* a3 = a2 + kstep; const char* b3 = b2 + kstep;
            if (last && has_next) S.a_ready(nxt);
            if constexpr (SP2) {
            PG8_LDB(B0, 0, 0); PG8_LDB(B1, 0, 1); PG8_SCHED; PG8_LDA(At, 0, 0); PG8_STAGE(PG8_SA(1, 1), a1 + hstepA, voffA);
            PG8_WAIT_V(8); PG8_WAIT_L(0); PG8_BAR; PG8_MMA(0, 0, At, B0); PG8_MMA(0, 1, At, B1); PG8_BAR; PG8_SCHED;
            PG8_LDA(At, 0, 1); PG8_STAGE(PG8_SB(0, 0), b2, voffB); PG8_STAGE(PG8_SB(0, 1), b2 + hstepB, voffB); PG8_STAGE(PG8_SA(0, 0), a2, voffA);
            PG8_WAIT_V(8); PG8_WAIT_L(0); PG8_BAR; PG8_MMA(1, 0, At, B0); PG8_MMA(1, 1, At, B1); PG8_BAR; PG8_SCHED;
            PG8_LDB(B0, 1, 0); PG8_LDB(B1, 1, 1); PG8_SCHED; PG8_LDA(At, 1, 0); PG8_STAGE(PG8_SA(0, 1), a2 + hstepA, voffA);
            PG8_WAIT_V(8); PG8_WAIT_L(0); PG8_BAR; PG8_MMA(0, 0, At, B0); PG8_MMA(0, 1, At, B1); PG8_BAR; PG8_SCHED;
            PG8_LDA(At, 1, 1); PG8_STAGE(PG8_SB(1, 0), b3, voffB); PG8_STAGE(PG8_SB(1, 1), b3 + hstepB, voffB); PG8_STAGE(PG8_SA(1, 0), a3, voffA);
            PG8_WAIT_V(8); PG8_WAIT_L(0); PG8_BAR; PG8_MMA(1, 0, At, B0); PG8_MMA(1, 1, At, B1); PG8_BAR; PG8_SCHED;
            } else {
            PG8_LDB(B0, 0, 0); PG8_SCHED; PG8_LDA(At, 0, 0); PG8_STAGE(PG8_SA(1, 1), a1 + hstepA, voffA);
            PG8_WAIT_L(8); PG8_BAR; PG8_WAIT_L(0); PG8_MMA(0, 0, At, B0); PG8_BAR; PG8_SCHED;
            PG8_LDB(B1, 0, 1); PG8_STAGE(PG8_SB(0, 0), b2, voffB);
            PG8_BAR; PG8_WAIT_L(0); PG8_MMA(0, 1, At, B1); PG8_BAR;
            PG8_LDA(At, 0, 1); PG8_STAGE(PG8_SA(0, 0), a2, voffA);
            PG8_BAR; PG8_WAIT_L(0); PG8_MMA(1, 0, At, B0); PG8_BAR; PG8_SCHED;
            PG8_STAGE(PG8_SB(0, 1), b2 + hstepB, voffB);
            PG8_WAIT_V(6); PG8_BAR; PG8_MMA(1, 1, At, B1); PG8_BAR;
            PG8_LDB(B0, 1, 0); PG8_SCHED; PG8_LDA(At, 1, 0); PG8_STAGE(PG8_SA(0, 1), a2 + hstepA, voffA);
            PG8_WAIT_L(8); PG8_BAR; PG8_WAIT_L(0); PG8_MMA(0, 0, At, B0); PG8_BAR; PG8_SCHED;
            PG8_LDB(B1, 1, 1); PG8_STAGE(PG8_SB(1, 0), b3, voffB);
            PG8_BAR; PG8_WAIT_L(0); PG8_MMA(0, 1, At, B1); PG8_BAR;
            PG8_LDA(At, 1, 1); PG8_STAGE(PG8_SA(1, 0), a3, voffA);
            PG8_BAR; PG8_WAIT_L(0); PG8_MMA(1, 0, At, B0); PG8_BAR; PG8_SCHED;
            PG8_STAGE(PG8_SB(1, 1), b3 + hstepB, voffB);
            PG8_WAIT_V(6); PG8_BAR; PG8_MMA(1, 1, At, B1); PG8_BAR;
            }
        }
        if constexpr (ALIGN_EPI) { if (wr == 0) PG8_BAR; }
        if constexpr (!Epi::AFTER_DRAIN) { E(acc, cur, wr, wc, fr, fq); S.done(cur); }
        if (!has_next) break;
#pragma unroll
        for (int a = 0; a < 2; ++a)
#pragma unroll
            for (int b = 0; b < 2; ++b)
#pragma unroll
                for (int m = 0; m < 4; ++m)
#pragma unroll
                    for (int n = 0; n < 2; ++n) acc[a][b][m][n] = (f32x4){0.f, 0.f, 0.f, 0.f};
        cur = nxt; cA = nA; cB = nB; ++ui;
        if constexpr (ALIGN_EPI) { if (wr == 1) PG8_BAR; }
    }
    PG8_WAIT_V(0);
    if constexpr (!ALIGN_EPI) { if (wr == 0) PG8_BAR; }
    PG8_BAR;
    if constexpr (Epi::AFTER_DRAIN) { E.fused(acc, cur, wr, wc, fr, fq, lds, wid, lane); S.done(cur); }
#undef PG8_SA
#undef PG8_SB
#undef PG8_STAGE
#undef PG8_LDA
#undef PG8_LDB
#undef PG8_MMA
#undef PG8_WAIT_V
#undef PG8_WAIT_L
#undef PG8_BAR
#undef PG8_SCHED
}
}


#define LAS __attribute__((address_space(3)))
typedef unsigned short bf16;
typedef float f32x4 __attribute__((ext_vector_type(4)));
typedef float f32x2 __attribute__((ext_vector_type(2)));
typedef short bf16x8 __attribute__((ext_vector_type(8)));
typedef unsigned u32x4 __attribute__((ext_vector_type(4)));
typedef unsigned u32x2 __attribute__((ext_vector_type(2)));

#ifndef REP_MASK
#define REP_MASK 0
#endif
#define NREP(k) (1 + ((REP_MASK >> (k)) & 1))
constexpr int NWAVES = 8, NTHREADS = 512;
constexpr int DM = 2048, MROWS = 8704, NPROMPT = 8192, NSEQ = 132, SEQ = 2048, DSEQ = 4;
constexpr int N_IN = 24640, N_INP = 24832, CONVCH = 8192, DFF = 8192, NADA = 12288;
constexpr float EPS = 1e-6f;
constexpr int LDS_BYTES = 147456;

enum { I_XP = 0, I_XS, I_SHG, I_SGD, I_CC, I_CP, I_CS, I_LB, I_WADA, I_BADA, I_NG, I_WIN, I_CW, I_ALOG, I_DTB, I_HGN, I_GDN, I_WOHG, I_WOGD, I_WO, I_WUP, I_WDN };
constexpr size_t O_Y = 0, O_HGP = 17825792, O_GDP = 18874368, O_CCP = 20971520, O_HGS = 21069824, O_GDS = 54624256, O_CCS = 121733120, O_END = 124878848;
constexpr size_t MiB = 1u << 20;
constexpr size_t WS_MOD = 1 * MiB, WS_BTOUT = 8 * MiB, WS_BTO = 32 * MiB, WS_BTUP = 40 * MiB, WS_BTDN = 72 * MiB, WS_BTIN = 104 * MiB, WS_A1 = 201 * MiB;
constexpr size_t WS_QHP = 235 * MiB, WS_FP = 267 * MiB, WS_IP = 331 * MiB, WS_UP = 363 * MiB, WS_GH = 491 * MiB, WS_GZ = 525 * MiB, WS_SA = 593 * MiB, WS_SB = 627 * MiB, WS_BL = 661 * MiB;
constexpr size_t WS_QHS = 664 * MiB, WS_FS = 666 * MiB, WS_IS = 670 * MiB, WS_US = 672 * MiB;
constexpr size_t WS_GREC = 680 * MiB, WS_HREC = 104 * MiB, WS_UCS = 218 * MiB, WS_O16 = 235 * MiB;
constexpr size_t WS_OA = 363 * MiB, WS_T1 = 680 * MiB, WS_MG = 748 * MiB, WS_MIX = 782 * MiB, WS_H = 850 * MiB, WS_U2 = 235 * MiB, WS_FF = 782 * MiB;
constexpr size_t WS_END = 970 * MiB;

__device__ __forceinline__ unsigned f2bf(float f) { unsigned u = __float_as_uint(f); return (u + 0x7fffu + ((u >> 16) & 1u)) >> 16; }
typedef float f32x2c_t __attribute__((ext_vector_type(2))); typedef __bf16 bf16x2c_t __attribute__((ext_vector_type(2)));
__device__ __forceinline__ unsigned pk2(float lo, float hi) { f32x2c_t v = {lo, hi}; bf16x2c_t b = __builtin_convertvector(v, bf16x2c_t); return __builtin_bit_cast(unsigned, b); }
__device__ __forceinline__ float bf2f(unsigned h) { return __uint_as_float(h << 16); }
__device__ __forceinline__ float bflo(unsigned w) { return __uint_as_float(w << 16); }
__device__ __forceinline__ float bfhi(unsigned w) { return __uint_as_float(w & 0xffff0000u); }
__device__ __forceinline__ float sigmoidf_(float x) { return __builtin_amdgcn_rcpf(1.0f + __expf(-x)); }
__device__ __forceinline__ float siluf_(float x) { return x * sigmoidf_(x); }
__device__ __forceinline__ float wave_sum(float v) {
#pragma unroll
    for (int o = 1; o < 64; o <<= 1) v += __shfl_xor(v, o);
    return v;
}
__device__ __forceinline__ float wave_sum_sw(float v) {
    v += __builtin_bit_cast(float, __builtin_amdgcn_ds_swizzle(__builtin_bit_cast(int, v), (1 << 10) | 0x1f));
    v += __builtin_bit_cast(float, __builtin_amdgcn_ds_swizzle(__builtin_bit_cast(int, v), (2 << 10) | 0x1f));
    v += __builtin_bit_cast(float, __builtin_amdgcn_ds_swizzle(__builtin_bit_cast(int, v), (4 << 10) | 0x1f));
    v += __builtin_bit_cast(float, __builtin_amdgcn_ds_swizzle(__builtin_bit_cast(int, v), (8 << 10) | 0x1f));
    v += __builtin_bit_cast(float, __builtin_amdgcn_ds_swizzle(__builtin_bit_cast(int, v), (16 << 10) | 0x1f));
    return __builtin_bit_cast(float, __builtin_amdgcn_readlane(__builtin_bit_cast(int, v), 0)) + __builtin_bit_cast(float, __builtin_amdgcn_readlane(__builtin_bit_cast(int, v), 32));
}
#define LDS_WAIT() asm volatile("s_waitcnt lgkmcnt(0)" ::: "memory")

struct Args { const float* in[22]; float* out; unsigned char* ws; int ph_lo, ph_hi; };
typedef __attribute__((address_space(4))) const unsigned char* kargp_t;
struct PA {
    kargp_t kp;
    static __device__ __forceinline__ PA get() { PA p; p.kp = (kargp_t)__builtin_amdgcn_kernarg_segment_ptr(); asm volatile("" : "+s"(p.kp)); return p; }
    __device__ __forceinline__ const float* in(int i) const { typedef const float* cfp; return ((__attribute__((address_space(4))) const cfp*)kp)[i]; }
    __device__ __forceinline__ float* out() const { typedef float* fp; return *((__attribute__((address_space(4))) const fp*)(kp + 176)); }
    __device__ __forceinline__ unsigned char* ws() const { typedef unsigned char* up; return *((__attribute__((address_space(4))) const up*)(kp + 184)); }
    __device__ __forceinline__ int ph_lo() const { return *((__attribute__((address_space(4))) const int*)(kp + 192)); }
    __device__ __forceinline__ int ph_hi() const { return *((__attribute__((address_space(4))) const int*)(kp + 196)); }
};
static_assert(sizeof(Args) == 200, "Args layout");
__device__ __forceinline__ bool ph_in(int k) { const PA p = PA::get(); return p.ph_lo() <= k && k < p.ph_hi(); }

template <int MODE> __device__ __forceinline__ float actf(float v) {
    if (MODE == 1) return siluf_(v);
    if (MODE == 2) return sigmoidf_(v);
    if (MODE == 3) { const float r = fmaxf(v, 0.f); return r * r; }
    return v;
}
template <int MODE> __device__ __forceinline__ void tile_store_bf16(const f32x4 (&acc)[2][2][4][2], bf16* base, int ld, int row0, int col0) {
#pragma unroll
    for (int ai = 0; ai < 2; ++ai)
#pragma unroll
        for (int m = 0; m < 4; ++m) {
            bf16* rowp = base + (size_t)(row0 + ai * 128 + m * 16) * ld + col0;
#pragma unroll
            for (int bj = 0; bj < 2; ++bj) {
                const f32x4 v0 = acc[ai][bj][m][0], v1 = acc[ai][bj][m][1];
                u32x4 w;
                w.x = pk2(actf<MODE>(v0[0]), actf<MODE>(v0[1])); w.y = pk2(actf<MODE>(v0[2]), actf<MODE>(v0[3]));
                w.z = pk2(actf<MODE>(v1[0]), actf<MODE>(v1[1])); w.w = pk2(actf<MODE>(v1[2]), actf<MODE>(v1[3]));
                *(u32x4*)(rowp + bj * 128) = w;
            }
        }
}
__device__ __forceinline__ void tile_store_f32(const f32x4 (&acc)[2][2][4][2], float* base, int ld, int row0, int col0) {
#pragma unroll
    for (int ai = 0; ai < 2; ++ai)
#pragma unroll
        for (int m = 0; m < 4; ++m) {
            float* rowp = base + (size_t)(row0 + ai * 128 + m * 16) * ld + col0;
#pragma unroll
            for (int bj = 0; bj < 2; ++bj) { *(f32x4*)(rowp + bj * 128) = acc[ai][bj][m][0]; *(f32x4*)(rowp + bj * 128 + 4) = acc[ai][bj][m][1]; }
        }
}

struct EpiIn {
    static constexpr bool PERM = true, AFTER_DRAIN = false;
    unsigned char* ws; const float *lbl, *alog, *dtb;
    __device__ __forceinline__ void operator()(const f32x4 (&acc)[2][2][4][2], const pg8::Unit& u, int wr, int wc, int fr, int fq) const {
        const int pn = u.pn, row0 = u.pm * 256 + wr * 64 + fr, cl = wc * 32 + 8 * fq;
        const bool smp = u.pm >= 32; const int rowq = smp ? row0 - NPROMPT : row0;
        if (pn >= 8 && pn < 16) {
            const int c0 = (pn - 8) * 256 + cl;
            float lb[2][8];
#pragma unroll
            for (int bj = 0; bj < 2; ++bj)
#pragma unroll
                for (int j = 0; j < 8; ++j) { const int c = c0 + bj * 128 + j; lb[bj][j] = sigmoidf_(lbl[c] - lbl[2048 + c]); }
#pragma unroll
            for (int ai = 0; ai < 2; ++ai)
#pragma unroll
                for (int m = 0; m < 4; ++m) {
                    float* rowp = (float*)(ws + (smp ? WS_FS : WS_FP)) + (size_t)(rowq + ai * 128 + m * 16) * 2048 + c0;
#pragma unroll
                    for (int bj = 0; bj < 2; ++bj) {
                        const f32x4 v0 = acc[ai][bj][m][0], v1 = acc[ai][bj][m][1]; f32x4 o0, o1;
#pragma unroll
                        for (int j = 0; j < 4; ++j) { o0[j] = lb[bj][j] + (1.f - lb[bj][j]) * sigmoidf_(v0[j]); o1[j] = lb[bj][4 + j] + (1.f - lb[bj][4 + j]) * sigmoidf_(v1[j]); }
                        *(f32x4*)(rowp + bj * 128) = o0; *(f32x4*)(rowp + bj * 128 + 4) = o1;
                    }
                }
            return;
        }
        if (pn == 96) {
            if (wc < 2) {
#pragma unroll
                for (int ai = 0; ai < 2; ++ai)
#pragma unroll
                    for (int m = 0; m < 4; ++m) {
                        float* rowp = (float*)(ws + WS_BL) + (size_t)(row0 + ai * 128 + m * 16) * 64 + cl;
                        const f32x4 v0 = acc[ai][0][m][0], v1 = acc[ai][0][m][1]; f32x4 o0, o1;
#pragma unroll
                        for (int j = 0; j < 4; ++j) {
                            if (wc == 0) { o0[j] = sigmoidf_(v0[j]); o1[j] = sigmoidf_(v1[j]); }
                            else { const int h0 = 8 * fq + j, h1 = 8 * fq + 4 + j; const float x0 = v0[j] + dtb[h0], x1 = v1[j] + dtb[h1];
                                   o0[j] = -expf(alog[h0]) * (fmaxf(x0, 0.f) + log1pf(expf(-fabsf(x0)))); o1[j] = -expf(alog[h1]) * (fmaxf(x1, 0.f) + log1pf(expf(-fabsf(x1)))); }
                        }
                        *(f32x4*)(rowp) = o0; *(f32x4*)(rowp + 4) = o1;
                    }
            }
            return;
        }
        size_t boff; int ld, c0, mode, rowb = row0;
        if (pn < 8)       { boff = smp ? WS_QHS : WS_QHP; ld = 2048; c0 = pn * 256; mode = 1; rowb = rowq; }
        else if (pn < 24) { boff = smp ? WS_IS : WS_IP;   ld = 2048; c0 = (pn - 16) * 256; mode = 0; rowb = rowq; }
        else if (pn < 32) { boff = WS_GH; ld = 2048; c0 = (pn - 24) * 256; mode = 1; }
        else if (pn < 64) { boff = smp ? WS_US : WS_UP;   ld = 8192; c0 = (pn - 32) * 256; mode = 0; rowb = rowq; }
        else if (pn < 80) { boff = WS_GZ; ld = 4096; c0 = (pn - 64) * 256; mode = 1; }
        else if (pn < 88) { boff = WS_SA; ld = 2048; c0 = (pn - 80) * 256; mode = 2; }
        else              { boff = WS_SB; ld = 2048; c0 = (pn - 88) * 256; mode = 2; }
        bf16* base = (bf16*)(ws + boff);
        if (mode == 0) tile_store_bf16<0>(acc, base, ld, rowb, c0 + cl);
        else if (mode == 1) tile_store_bf16<1>(acc, base, ld, rowb, c0 + cl);
        else tile_store_bf16<2>(acc, base, ld, rowb, c0 + cl);
    }
};
struct EpiOut1 {
    static constexpr bool PERM = true, AFTER_DRAIN = false;
    float* T1; const bf16* SA;
    __device__ __forceinline__ void operator()(const f32x4 (&acc)[2][2][4][2], const pg8::Unit& u, int wr, int wc, int fr, int fq) const {
        const int row0 = u.pm * 256 + wr * 64 + fr, c0 = u.pn * 256 + wc * 32 + 8 * fq;
#pragma unroll
        for (int ai = 0; ai < 2; ++ai)
#pragma unroll
            for (int m = 0; m < 4; ++m) {
                const size_t ro = (size_t)(row0 + ai * 128 + m * 16) * 2048 + c0;
#pragma unroll
                for (int bj = 0; bj < 2; ++bj) {
                    const u32x4 s = *(const u32x4*)(SA + ro + bj * 128);
                    const f32x4 v0 = acc[ai][bj][m][0], v1 = acc[ai][bj][m][1];
                    f32x4 o0 = {v0[0] * bflo(s.x), v0[1] * bfhi(s.x), v0[2] * bflo(s.y), v0[3] * bfhi(s.y)};
                    f32x4 o1 = {v1[0] * bflo(s.z), v1[1] * bfhi(s.z), v1[2] * bflo(s.w), v1[3] * bfhi(s.w)};
                    *(f32x4*)(T1 + ro + bj * 128) = o0; *(f32x4*)(T1 + ro + bj * 128 + 4) = o1;
                }
            }
    }
};
struct EpiOut2 {
    static constexpr bool PERM = true, AFTER_DRAIN = false;
    const float* T1; const bf16* SB; bf16* MG;
    __device__ __forceinline__ void operator()(const f32x4 (&acc)[2][2][4][2], const pg8::Unit& u, int wr, int wc, int fr, int fq) const {
        const int row0 = u.pm * 256 + wr * 64 + fr, c0 = u.pn * 256 + wc * 32 + 8 * fq;
#pragma unroll
        for (int ai = 0; ai < 2; ++ai)
#pragma unroll
            for (int m = 0; m < 4; ++m) {
                const size_t ro = (size_t)(row0 + ai * 128 + m * 16) * 2048 + c0;
#pragma unroll
                for (int bj = 0; bj < 2; ++bj) {
                    const u32x4 s = *(const u32x4*)(SB + ro + bj * 128);
                    const f32x4 t0 = *(const f32x4*)(T1 + ro + bj * 128), t1 = *(const f32x4*)(T1 + ro + bj * 128 + 4);
                    const f32x4 v0 = acc[ai][bj][m][0], v1 = acc[ai][bj][m][1];
                    u32x4 w;
                    w.x = pk2(t0[0] + v0[0] * bflo(s.x), t0[1] + v0[1] * bfhi(s.x)); w.y = pk2(t0[2] + v0[2] * bflo(s.y), t0[3] + v0[3] * bfhi(s.y));
                    w.z = pk2(t1[0] + v1[0] * bflo(s.z), t1[1] + v1[1] * bfhi(s.z)); w.w = pk2(t1[2] + v1[2] * bflo(s.w), t1[3] + v1[3] * bfhi(s.w));
                    *(u32x4*)(MG + ro + bj * 128) = w;
                }
            }
    }
};
struct EpiF32 {
    static constexpr bool PERM = true, AFTER_DRAIN = false;
    float* O; int ld;
    __device__ __forceinline__ void operator()(const f32x4 (&acc)[2][2][4][2], const pg8::Unit& u, int wr, int wc, int fr, int fq) const {
        tile_store_f32(acc, O, ld, u.pm * 256 + wr * 64 + fr, u.pn * 256 + wc * 32 + 8 * fq);
    }
};
struct EpiRelu2 {
    static constexpr bool PERM = true, AFTER_DRAIN = false;
    bf16* O; int ld;
    __device__ __forceinline__ void operator()(const f32x4 (&acc)[2][2][4][2], const pg8::Unit& u, int wr, int wc, int fr, int fq) const {
        tile_store_bf16<3>(acc, O, ld, u.pm * 256 + wr * 64 + fr, u.pn * 256 + wc * 32 + 8 * fq);
    }
};

__device__ __forceinline__ void transpose_item(const float* W, int N, bf16* WT, int ldk, int k0, int n0, int nrow0, LAS float* scr, int lane) {
#pragma unroll 8
    for (int i = 0; i < 32; ++i) { const int kk = 2 * i + (lane >> 5); scr[kk * 33 + (lane & 31)] = W[(size_t)(k0 + kk) * N + n0 + (lane & 31)]; }
    LDS_WAIT(); asm volatile("" ::: "memory");
    const int c = lane & 7;
#pragma unroll
    for (int j = 0; j < 4; ++j) { const int n = (lane >> 3) + 8 * j; const LAS float* s = scr + (8 * c) * 33 + n;
        u32x4 o; o.x = pk2(s[0 * 33], s[1 * 33]); o.y = pk2(s[2 * 33], s[3 * 33]); o.z = pk2(s[4 * 33], s[5 * 33]); o.w = pk2(s[6 * 33], s[7 * 33]);
        *(u32x4*)(WT + (size_t)(nrow0 + n) * ldk + k0 + 8 * c) = o; }
    LDS_WAIT(); asm volatile("" ::: "memory");
}
__device__ __forceinline__ void mod_item(const PA& a, LAS unsigned char* lds, int cb, int tid, int wid, int lane) {
    constexpr int AST = 264;
    LAS bf16* As = (LAS bf16*)lds;
    const float* cp = a.in(I_CP); const float* cs = a.in(I_CS); const float* W = a.in(I_WADA); const float* bada = a.in(I_BADA);
    float* mod = (float*)(a.ws() + WS_MOD);
    const int nt = wid & 3, mh = wid >> 2, fr = lane & 15, fq = lane >> 4, n = cb * 64 + nt * 16 + fr;
    f32x4 acc[5];
#pragma unroll
    for (int i = 0; i < 5; ++i) acc[i] = (f32x4){0.f, 0.f, 0.f, 0.f};
    for (int kc = 0; kc < 8; ++kc) {
        __syncthreads();
        for (int e = tid; e < 144 * 64; e += NTHREADS) {
            const int s = e >> 6, q = e & 63; u32x2 w = {0u, 0u};
            if (s < NSEQ) { const float* src = (s < 4 ? cp + (size_t)s * 2048 : cs + (size_t)(s - 4) * 2048) + kc * 256 + q * 4; const f32x4 x = *(const f32x4*)src;
                w.x = pk2(siluf_(x[0]), siluf_(x[1])); w.y = pk2(siluf_(x[2]), siluf_(x[3])); }
            *(LAS u32x2*)(As + s * AST + q * 4) = w;
        }
        __syncthreads();
#pragma unroll 2
        for (int ks = 0; ks < 8; ++ks) {
            const int k0 = kc * 256 + ks * 32 + 8 * fq;
            bf16x8 b;
#pragma unroll
            for (int j = 0; j < 8; ++j) b[j] = (short)f2bf(W[(size_t)(k0 + j) * NADA + n]);
#pragma unroll
            for (int i = 0; i < 5; ++i) {
                const int mt = mh * 5 + i;
                if (mt < 9) { const bf16x8 av = *(const LAS bf16x8*)(As + (mt * 16 + fr) * AST + ks * 32 + 8 * fq);
                    acc[i] = __builtin_amdgcn_mfma_f32_16x16x32_bf16(av, b, acc[i], 0, 0, 0); }
            }
        }
    }
    const float bb = bada[n];
#pragma unroll
    for (int i = 0; i < 5; ++i)
#pragma unroll
        for (int r = 0; r < 4; ++r) { const int s = (mh * 5 + i) * 16 + 4 * fq + r; if (s < NSEQ) mod[(size_t)s * NADA + n] = acc[i][r] + bb; }
}

__device__ __forceinline__ const float* xrow_ptr(const PA& a, int row) { return row < NPROMPT ? a.in(I_XP) + (size_t)row * DM : a.in(I_XS) + (size_t)(row - NPROMPT) * DM; }
__device__ __forceinline__ int seq_of_row(int row) { return row < NPROMPT ? (row >> 11) : 4 + ((row - NPROMPT) >> 2); }

__device__ __forceinline__ float ldg_agent(const float* p) { return __hip_atomic_load(p, __ATOMIC_RELAXED, __HIP_MEMORY_SCOPE_AGENT); }
__device__ __forceinline__ float xhalf_sum(float v) { return v + __shfl_xor(v, 32); }
__device__ __forceinline__ void hgrn_item(const PA& a, LAS float* wl, int b, int h, int quarter, int lane, float (&S)[64]) {
    const bf16* Qh = (const bf16*)(a.ws() + WS_QHS); const float* F = (const float*)(a.ws() + WS_FS); const bf16* Ih = (const bf16*)(a.ws() + WS_IS);
    bf16* O16 = (bf16*)(a.ws() + WS_O16);
    const int c = lane & 31, hh = lane >> 5, dv = quarter * 32 + c;
    const unsigned sidx = (unsigned)((b * 16 + h) * 128 + 64 * hh) * 128u + dv;
    LAS float* qs = wl; LAS float* fs = wl + 128;
#pragma unroll 1
    for (int t = 0; t < DSEQ; ++t) {
        const unsigned ro = (unsigned)(b * DSEQ + t) * 2048u + h * 128;
        const float q0 = bf2f(Qh[ro + lane]), q1 = bf2f(Qh[ro + 64 + lane]), f0 = F[ro + lane], f1 = F[ro + 64 + lane], iv = bf2f(Ih[ro + dv]);
        qs[lane] = q0; qs[64 + lane] = q1; fs[lane] = f0; fs[64 + lane] = f1;
        float o0 = 0.f, o1 = 0.f, o2 = 0.f, o3 = 0.f;
#pragma unroll
        for (int j4 = 0; j4 < 16; ++j4) {
            const f32x4 q4 = *(const LAS f32x4*)(qs + 64 * hh + 4 * j4), f4 = *(const LAS f32x4*)(fs + 64 * hh + 4 * j4);
            S[4 * j4 + 0] = fmaf(f4[0], S[4 * j4 + 0] - iv, iv); o0 = fmaf(q4[0], S[4 * j4 + 0], o0);
            S[4 * j4 + 1] = fmaf(f4[1], S[4 * j4 + 1] - iv, iv); o1 = fmaf(q4[1], S[4 * j4 + 1], o1);
            S[4 * j4 + 2] = fmaf(f4[2], S[4 * j4 + 2] - iv, iv); o2 = fmaf(q4[2], S[4 * j4 + 2], o2);
            S[4 * j4 + 3] = fmaf(f4[3], S[4 * j4 + 3] - iv, iv); o3 = fmaf(q4[3], S[4 * j4 + 3], o3);
        }
        const float o = xhalf_sum((o0 + o1) + (o2 + o3));
        if (hh == 0) O16[(unsigned)(NPROMPT + b * DSEQ + t) * 6144u + h * 128 + dv] = (bf16)(pk2(o, 0.f) & 0xffffu);
    }
    float* so = a.out() + O_HGS + sidx;
#pragma unroll
    for (int j = 0; j < 64; ++j) so[j * 128] = S[j];
}
__device__ __forceinline__ void gdn_item(const PA& a, LAS float* wl, int b, int vh, int quarter, int lane, float (&S)[64]) {
    const bf16* UC = (const bf16*)(a.ws() + WS_UCS); const float* BL = (const float*)(a.ws() + WS_BL);
    bf16* O16 = (bf16*)(a.ws() + WS_O16);
    const int c = lane & 31, hh = lane >> 5, dv = quarter * 32 + c, qh = vh >> 1;
    const unsigned sidx = (unsigned)((b * 32 + vh) * 128 + 64 * hh) * 128u + dv;
    LAS float* qs = wl; LAS float* ks = wl + 128;
#pragma unroll 1
    for (int t = 0; t < DSEQ; ++t) {
        const unsigned ro = (unsigned)(b * DSEQ + t) * 8192u + qh * 128, rv = (unsigned)(b * DSEQ + t) * 8192u + 4096 + vh * 128, rb = (unsigned)(NPROMPT + b * DSEQ + t) * 64u + vh;
        const float q0 = bf2f(UC[ro + lane]), q1 = bf2f(UC[ro + 64 + lane]), k0 = bf2f(UC[ro + 2048 + lane]), k1 = bf2f(UC[ro + 2048 + 64 + lane]), vv = bf2f(UC[rv + dv]);
        const float beta = ldg_agent(BL + rb), al = __expf(ldg_agent(BL + rb + 32));
        qs[lane] = q0; qs[64 + lane] = q1; ks[lane] = k0; ks[64 + lane] = k1;
        const float qk = wave_sum_sw(q0 * k0 + q1 * k1);
        float c0 = 0.f, c1 = 0.f, c2 = 0.f, c3 = 0.f, o0 = 0.f, o1 = 0.f, o2 = 0.f, o3 = 0.f;
#pragma unroll
        for (int j4 = 0; j4 < 16; ++j4) {
            const f32x4 k4 = *(const LAS f32x4*)(ks + 64 * hh + 4 * j4), q4 = *(const LAS f32x4*)(qs + 64 * hh + 4 * j4);
            c0 = fmaf(k4[0], S[4 * j4 + 0], c0); c1 = fmaf(k4[1], S[4 * j4 + 1], c1); c2 = fmaf(k4[2], S[4 * j4 + 2], c2); c3 = fmaf(k4[3], S[4 * j4 + 3], c3);
            o0 = fmaf(q4[0], S[4 * j4 + 0], o0); o1 = fmaf(q4[1], S[4 * j4 + 1], o1); o2 = fmaf(q4[2], S[4 * j4 + 2], o2); o3 = fmaf(q4[3], S[4 * j4 + 3], o3);
        }
        const float kS = xhalf_sum((c0 + c1) + (c2 + c3)), qS = xhalf_sum((o0 + o1) + (o2 + o3));
        const float dlt = beta * (vv - al * kS);
#pragma unroll
        for (int j4 = 0; j4 < 16; ++j4) {
            const f32x4 k4 = *(const LAS f32x4*)(ks + 64 * hh + 4 * j4);
            S[4 * j4 + 0] = fmaf(k4[0], dlt, al * S[4 * j4 + 0]); S[4 * j4 + 1] = fmaf(k4[1], dlt, al * S[4 * j4 + 1]);
            S[4 * j4 + 2] = fmaf(k4[2], dlt, al * S[4 * j4 + 2]); S[4 * j4 + 3] = fmaf(k4[3], dlt, al * S[4 * j4 + 3]);
        }
        if (hh == 0) O16[(unsigned)(NPROMPT + b * DSEQ + t) * 6144u + 2048 + vh * 128 + dv] = (bf16)(pk2(fmaf(al, qS, qk * dlt), 0.f) & 0xffffu);
    }
    float* so = a.out() + O_GDS + sidx;
#pragma unroll
    for (int j = 0; j < 64; ++j) so[j * 128] = S[j];
}

typedef float f32x16 __attribute__((ext_vector_type(16)));
typedef float f32x2_t __attribute__((ext_vector_type(2))); typedef __bf16 bf16x2_t __attribute__((ext_vector_type(2)));
#define MFMA32(a, b, c) __builtin_amdgcn_mfma_f32_32x32x16_bf16((a), (b), (c), 0, 0, 0)
__device__ __forceinline__ unsigned cvtpk(float lo, float hi) { f32x2_t v = {lo, hi}; bf16x2_t b = __builtin_convertvector(v, bf16x2_t); return __builtin_bit_cast(unsigned, b); }
__device__ __forceinline__ int crow_(int i, int h) { return (i & 3) + 8 * (i >> 2) + 4 * h; }
template <int S> __device__ __forceinline__ bf16x8 pack_acc(const f32x16& x) {
    u32x4 p; p.x = cvtpk(x[8 * S + 0], x[8 * S + 1]); p.y = cvtpk(x[8 * S + 2], x[8 * S + 3]); p.z = cvtpk(x[8 * S + 4], x[8 * S + 5]); p.w = cvtpk(x[8 * S + 6], x[8 * S + 7]);
    return __builtin_bit_cast(bf16x8, p);
}
__device__ __forceinline__ u32x4 afrag_rows(const LAS bf16* img, int stride, int row, int kt, int h) {
    const LAS u32x2* p = (const LAS u32x2*)(img + row * stride + 16 * kt + 4 * h);
    const u32x2 lo = p[0], hi = p[2];
    return (u32x4){lo.x, lo.y, hi.x, hi.y};
}
__device__ __forceinline__ u32x4 afrag_rows_scaled(const LAS bf16* img, int stride, int row, int kt, int h, float sc) {
    const u32x4 w = afrag_rows(img, stride, row, kt, h);
    return (u32x4){cvtpk(bflo(w.x) * sc, bfhi(w.x) * sc), cvtpk(bflo(w.y) * sc, bfhi(w.y) * sc), cvtpk(bflo(w.z) * sc, bfhi(w.z) * sc), cvtpk(bflo(w.w) * sc, bfhi(w.w) * sc)};
}
__device__ __forceinline__ int kidx_(int kt, int h, int j) { return 16 * kt + 8 * (j >> 2) + 4 * h + (j & 3); }

constexpr int GREC_BYTES = 73984;
constexpr int GR_W = 0, GR_Q = 16384, GR_K = 32768, GR_A = 49152, GR_U = 57344, GR_DEC = 73728, GR_IMG = 57344;
constexpr int HREC_BYTES = 57856;
constexpr int HR_Q = 0, HR_K = 16384, HR_A = 32768, HR_I = 40960, HR_DEC = 57344, HR_IMG = 57856;

constexpr int GP_QS = 0, GP_KS = 17408, GP_VS = 34816, GP_BG = 69632, GP_KK = 73728, GP_QK = 90368, GP_AS = 107008, GP_XL = 0, GP_ATT = 73728;
constexpr int GP_ST = 136, GP_XST = 264, GP_AST = 68, GP_KST = 65, GP_TST = 72;
__device__ __forceinline__ void gdn_prep_unit(const PA& a, LAS unsigned char* lds, int u, int tid, int wid, int lane) {
    asm volatile("" : "+v"(tid), "+v"(lane));
    unsigned char* ws = a.ws();
    const int b = u >> 9, qh = (u >> 5) & 15, c = u & 31;
    const bf16* UP = (const bf16*)(ws + WS_UP); const float* BL = (const float*)(ws + WS_BL); const float* cw = a.in(I_CW);
    LAS bf16* QS = (LAS bf16*)(lds + GP_QS); LAS bf16* KS = (LAS bf16*)(lds + GP_KS); LAS bf16* VS = (LAS bf16*)(lds + GP_VS);
    LAS float* BG = (LAS float*)(lds + GP_BG);
    LAS float* KKs = (LAS float*)(lds + GP_KK); LAS float* QKs = (LAS float*)(lds + GP_QK); LAS float* AS = (LAS float*)(lds + GP_AS);
    LAS bf16* XL = (LAS bf16*)(lds + GP_XL); LAS bf16* ATT = (LAS bf16*)(lds + GP_ATT);
    const int row0 = b * SEQ + c * 64;
    unsigned char* rec0 = ws + WS_GREC + (size_t)((b * 32 + 2 * qh) * 32 + c) * GREC_BYTES;
    for (int r0_ = 0; r0_ < NREP(20); ++r0_) {
        const int t = tid >> 3, cg = tid & 7;
#pragma unroll
        for (int m = 0; m < 2; ++m) {
            const int ch0 = m * 2048 + qh * 128 + cg * 16;
            float x[16];
#pragma unroll
            for (int e = 0; e < 16; ++e) x[e] = 0.f;
#pragma unroll
            for (int j = 0; j < 4; ++j) {
                const int tt = c * 64 + t - 3 + j;
                if (tt >= 0) {
                    const u32x4* src = (const u32x4*)(UP + (size_t)(row0 + t - 3 + j) * CONVCH + ch0);
                    const u32x4 w0 = src[0], w1 = src[1];
                    const f32x4* wp = (const f32x4*)(cw + (size_t)j * CONVCH + ch0);
                    const f32x4 c0 = wp[0], c1 = wp[1], c2 = wp[2], c3 = wp[3];
                    x[0] = fmaf(c0[0], bflo(w0.x), x[0]); x[1] = fmaf(c0[1], bfhi(w0.x), x[1]); x[2] = fmaf(c0[2], bflo(w0.y), x[2]); x[3] = fmaf(c0[3], bfhi(w0.y), x[3]);
                    x[4] = fmaf(c1[0], bflo(w0.z), x[4]); x[5] = fmaf(c1[1], bfhi(w0.z), x[5]); x[6] = fmaf(c1[2], bflo(w0.w), x[6]); x[7] = fmaf(c1[3], bfhi(w0.w), x[7]);
                    x[8] = fmaf(c2[0], bflo(w1.x), x[8]); x[9] = fmaf(c2[1], bfhi(w1.x), x[9]); x[10] = fmaf(c2[2], bflo(w1.y), x[10]); x[11] = fmaf(c2[3], bfhi(w1.y), x[11]);
                    x[12] = fmaf(c3[0], bflo(w1.z), x[12]); x[13] = fmaf(c3[1], bfhi(w1.z), x[13]); x[14] = fmaf(c3[2], bflo(w1.w), x[14]); x[15] = fmaf(c3[3], bfhi(w1.w), x[15]);
                }
            }
            float ss = 0.f;
#pragma unroll
            for (int e = 0; e < 16; ++e) { x[e] = siluf_(x[e]); ss = fmaf(x[e], x[e], ss); }
            ss += __shfl_xor(ss, 1); ss += __shfl_xor(ss, 2); ss += __shfl_xor(ss, 4);
            float r = rsqrtf(ss + EPS); if (m == 0) r *= 0.08838834764831845f;
            u32x4 o0, o1;
            o0.x = cvtpk(x[0] * r, x[1] * r); o0.y = cvtpk(x[2] * r, x[3] * r); o0.z = cvtpk(x[4] * r, x[5] * r); o0.w = cvtpk(x[6] * r, x[7] * r);
            o1.x = cvtpk(x[8] * r, x[9] * r); o1.y = cvtpk(x[10] * r, x[11] * r); o1.z = cvtpk(x[12] * r, x[13] * r); o1.w = cvtpk(x[14] * r, x[15] * r);
            LAS u32x4* dst = (LAS u32x4*)((m ? KS : QS) + t * GP_ST + cg * 16);
            dst[0] = o0; dst[1] = o1;
            asm volatile("" ::: "memory");
        }
#pragma unroll
        for (int m = 0; m < 2; ++m) {
            const int cl = cg * 32 + m * 16;
            const int ch0 = 4096 + (2 * qh) * 128 + cl;
            float x[16];
#pragma unroll
            for (int e = 0; e < 16; ++e) x[e] = 0.f;
#pragma unroll
            for (int j = 0; j < 4; ++j) {
                const int tt = c * 64 + t - 3 + j;
                if (tt >= 0) {
                    const u32x4* src = (const u32x4*)(UP + (size_t)(row0 + t - 3 + j) * CONVCH + ch0);
                    const u32x4 w0 = src[0], w1 = src[1];
                    const f32x4* wp = (const f32x4*)(cw + (size_t)j * CONVCH + ch0);
                    const f32x4 c0 = wp[0], c1 = wp[1], c2 = wp[2], c3 = wp[3];
                    x[0] = fmaf(c0[0], bflo(w0.x), x[0]); x[1] = fmaf(c0[1], bfhi(w0.x), x[1]); x[2] = fmaf(c0[2], bflo(w0.y), x[2]); x[3] = fmaf(c0[3], bfhi(w0.y), x[3]);
                    x[4] = fmaf(c1[0], bflo(w0.z), x[4]); x[5] = fmaf(c1[1], bfhi(w0.z), x[5]); x[6] = fmaf(c1[2], bflo(w0.w), x[6]); x[7] = fmaf(c1[3], bfhi(w0.w), x[7]);
                    x[8] = fmaf(c2[0], bflo(w1.x), x[8]); x[9] = fmaf(c2[1], bfhi(w1.x), x[9]); x[10] = fmaf(c2[2], bflo(w1.y), x[10]); x[11] = fmaf(c2[3], bfhi(w1.y), x[11]);
                    x[12] = fmaf(c3[0], bflo(w1.z), x[12]); x[13] = fmaf(c3[1], bfhi(w1.z), x[13]); x[14] = fmaf(c3[2], bflo(w1.w), x[14]); x[15] = fmaf(c3[3], bfhi(w1.w), x[15]);
                }
            }
#pragma unroll
            for (int e = 0; e < 16; ++e) x[e] = siluf_(x[e]);
            u32x4 o0, o1;
            o0.x = cvtpk(x[0], x[1]); o0.y = cvtpk(x[2], x[3]); o0.z = cvtpk(x[4], x[5]); o0.w = cvtpk(x[6], x[7]);
            o1.x = cvtpk(x[8], x[9]); o1.y = cvtpk(x[10], x[11]); o1.z = cvtpk(x[12], x[13]); o1.w = cvtpk(x[14], x[15]);
            LAS u32x4* dst = (LAS u32x4*)(VS + (cl >> 7) * (64 * GP_ST) + t * GP_ST + (cl & 127));
            dst[0] = o0; dst[1] = o1;
            asm volatile("" ::: "memory");
        }
        if (tid < 256) { const int vhh = tid >> 7, k = (tid >> 6) & 1, tt = tid & 63;
            BG[k * 128 + vhh * 64 + tt] = BL[(size_t)(row0 + tt) * 64 + k * 32 + 2 * qh + vhh]; }
    }
    __syncthreads(); asm volatile("" : "+v"(tid), "+v"(lane));
    if (wid < 2) {
        float g = BG[128 + wid * 64 + lane];
#pragma unroll
        for (int o = 1; o < 64; o <<= 1) { const float v = __shfl_up(g, o); if (lane >= o) g += v; }
        const float g63 = __shfl(g, 63);
        BG[256 + wid * 64 + lane] = g; BG[384 + wid * 64 + lane] = __expf(g); BG[512 + wid * 64 + lane] = __expf(g63 - g);
        if (lane == 63) *(float*)(rec0 + (size_t)wid * 32 * GREC_BYTES + GR_DEC) = __expf(g63);
    }
    {
        const int m = wid >> 2, rt = (wid >> 1) & 1, ct = wid & 1, r = lane & 31, h = lane >> 5;
        const LAS bf16* Am = (m ? QS : KS) + (32 * rt + r) * GP_ST + 8 * h; const LAS bf16* Bm = KS + (32 * ct + r) * GP_ST + 8 * h;
        f32x16 acc;
#pragma unroll
        for (int i = 0; i < 16; ++i) acc[i] = 0.f;
#pragma unroll
        for (int kt = 0; kt < 8; ++kt) acc = MFMA32(*(const LAS bf16x8*)(Am + 16 * kt), *(const LAS bf16x8*)(Bm + 16 * kt), acc);
        LAS float* dst = (m ? QKs : KKs) + 32 * ct + r;
#pragma unroll
        for (int i = 0; i < 16; ++i) dst[(32 * rt + crow_(i, h)) * GP_KST] = acc[i];
    }
    __syncthreads(); asm volatile("" : "+v"(tid), "+v"(lane));
    float att[16];
    for (int r2_ = 0; r2_ < NREP(23); ++r2_) {
        const int vhh = tid >> 8, e = tid & 255;
        const LAS float* bet = BG + vhh * 64; const LAS float* gam = BG + 256 + vhh * 64;
#pragma unroll
        for (int n = 0; n < 16; ++n) {
            const int idx = e + 256 * n, t = idx >> 6, s = idx & 63;
            const float L = (t >= s) ? __expf(gam[t] - gam[s]) : 0.f;
            AS[(vhh * 64 + t) * GP_AST + s] = (t > s) ? bet[t] * KKs[t * GP_KST + s] * L : 0.f;
            att[n] = -QKs[t * GP_KST + s] * L;
        }
#pragma unroll
        for (int n = 0; n < 4; ++n) {
            const int task = tid + 512 * n, vh2 = task >> 10, f = (task >> 6) & 15, l = task & 63, rt = f >> 3, kt = f & 7, r = l & 31, h = l >> 5;
            const u32x4 w = afrag_rows_scaled(QS, GP_ST, 32 * rt + r, kt, h, BG[384 + vh2 * 64 + 32 * rt + r]);
            *(u32x4*)(rec0 + (size_t)vh2 * 32 * GREC_BYTES + GR_Q + (f * 64 + l) * 16) = w;
        }
#pragma unroll
        for (int n = 0; n < 4; ++n) {
            const int task = tid + 512 * n, vh2 = task >> 10, f = (task >> 6) & 15, l = task & 63, dt = f >> 2, ts = f & 3, r = l & 31, h = l >> 5;
            float v[8];
#pragma unroll
            for (int j = 0; j < 8; ++j) { const int tok = kidx_(ts, h, j); v[j] = -bf2f(KS[tok * GP_ST + 32 * dt + r]) * BG[512 + vh2 * 64 + tok]; }
            *(u32x4*)(rec0 + (size_t)vh2 * 32 * GREC_BYTES + GR_K + (f * 64 + l) * 16) = (u32x4){cvtpk(v[0], v[1]), cvtpk(v[2], v[3]), cvtpk(v[4], v[5]), cvtpk(v[6], v[7])};
        }
    }
    __syncthreads(); asm volatile("" : "+v"(tid), "+v"(lane));
    {
        const int vhh = tid >> 8, e = tid & 255;
#pragma unroll
        for (int n = 0; n < 16; ++n) { const int idx = e + 256 * n, t = idx >> 6, s = idx & 63; ATT[(vhh * 64 + t) * GP_TST + s] = (bf16)(cvtpk(att[n], 0.f) & 0xffffu); }
    }
    float X[64];
    for (int r3_ = 0; r3_ < NREP(21); ++r3_) {
#pragma unroll
        for (int i = 0; i < 64; ++i) X[i] = 0.f;
        const int vhh = tid >> 8, cc = tid & 255;
        const LAS float* bet = BG + vhh * 64; const LAS float* eg = BG + 384 + vhh * 64;
        const LAS bf16* src = (cc < 128) ? (VS + vhh * (64 * GP_ST) + cc) : (KS + (cc - 128));
        const bool isw = cc >= 128;
#define GDN_SOLVE_QUARTER(QQ) \
        _Pragma("unroll 1") for (int tb = 4 * (QQ); tb < 4 * (QQ) + 4; ++tb) { \
            float rr[4]; \
            _Pragma("unroll") for (int i = 0; i < 4; ++i) { const int t = 4 * tb + i; const float bt = bet[t] * (isw ? eg[t] : 1.f); rr[i] = bf2f(src[t * GP_ST]) * bt; } \
            const LAS float* ar = AS + (vhh * 64 + 4 * tb) * GP_AST; \
            _Pragma("unroll") for (int s4 = 0; s4 < 4 * (QQ) + 4; ++s4) { \
                const f32x4 a0 = *(const LAS f32x4*)(ar + 4 * s4), a1 = *(const LAS f32x4*)(ar + GP_AST + 4 * s4), a2 = *(const LAS f32x4*)(ar + 2 * GP_AST + 4 * s4), a3 = *(const LAS f32x4*)(ar + 3 * GP_AST + 4 * s4); \
                _Pragma("unroll") for (int e = 0; e < 4; ++e) { const float x = X[4 * s4 + e]; rr[0] = fmaf(-a0[e], x, rr[0]); rr[1] = fmaf(-a1[e], x, rr[1]); rr[2] = fmaf(-a2[e], x, rr[2]); rr[3] = fmaf(-a3[e], x, rr[3]); } \
                if ((s4 & 1) == 1) asm volatile("" : "+v"(ar) : "v"(rr[0])); \
            } \
            const f32x4 d1 = *(const LAS f32x4*)(ar + GP_AST + 4 * tb), d2 = *(const LAS f32x4*)(ar + 2 * GP_AST + 4 * tb), d3 = *(const LAS f32x4*)(ar + 3 * GP_AST + 4 * tb); \
            rr[1] = fmaf(-d1[0], rr[0], rr[1]); \
            rr[2] = fmaf(-d2[0], rr[0], rr[2]); rr[2] = fmaf(-d2[1], rr[1], rr[2]); \
            rr[3] = fmaf(-d3[0], rr[0], rr[3]); rr[3] = fmaf(-d3[1], rr[1], rr[3]); rr[3] = fmaf(-d3[2], rr[2], rr[3]); \
            _Pragma("unroll") for (int j = 4 * (QQ); j < 4 * (QQ) + 4; ++j) if (j == tb) { X[4 * j] = rr[0]; X[4 * j + 1] = rr[1]; X[4 * j + 2] = rr[2]; X[4 * j + 3] = rr[3]; } \
        }
        GDN_SOLVE_QUARTER(0) GDN_SOLVE_QUARTER(1) GDN_SOLVE_QUARTER(2) GDN_SOLVE_QUARTER(3)
#undef GDN_SOLVE_QUARTER
    }
    __syncthreads(); asm volatile("" : "+v"(tid), "+v"(lane));
    {
        const int vhh = tid >> 8, cc = tid & 255; const float sg = (cc < 128) ? -1.f : 1.f;
#pragma unroll
        for (int t = 0; t < 64; ++t) XL[(vhh * 64 + t) * GP_XST + cc] = (bf16)(cvtpk(X[t] * sg, 0.f) & 0xffffu);
    }
    __syncthreads(); asm volatile("" : "+v"(tid), "+v"(lane));
    for (int r4_ = 0; r4_ < NREP(22); ++r4_) {
#pragma unroll
        for (int n = 0; n < 4; ++n) {
            const int task = tid + 512 * n, vh2 = task >> 10, f = (task >> 6) & 15, l = task & 63, rt = f >> 3, kt = f & 7, r = l & 31, h = l >> 5;
            const u32x4 w = afrag_rows(XL + vh2 * (64 * GP_XST) + 128, GP_XST, 32 * rt + r, kt, h);
            *(u32x4*)(rec0 + (size_t)vh2 * 32 * GREC_BYTES + GR_W + (f * 64 + l) * 16) = w;
        }
#pragma unroll
        for (int n = 0; n < 2; ++n) {
            const int task = tid + 512 * n, vh2 = task >> 9, f = (task >> 6) & 7, l = task & 63, slab = f >> 1, rt = f & 1, r = l & 31, h = l >> 5;
            const LAS bf16* src = XL + (vh2 * 64 + 32 * rt) * GP_XST + 32 * slab + r;
            unsigned w[8];
#pragma unroll
            for (int i2 = 0; i2 < 8; ++i2) w[i2] = (unsigned)src[crow_(2 * i2, h) * GP_XST] | ((unsigned)src[crow_(2 * i2 + 1, h) * GP_XST] << 16);
            u32x4* dst = (u32x4*)(rec0 + (size_t)vh2 * 32 * GREC_BYTES + GR_U + (f * 64 + l) * 32);
            dst[0] = (u32x4){w[0], w[1], w[2], w[3]}; dst[1] = (u32x4){w[4], w[5], w[6], w[7]};
        }
#pragma unroll
        for (int n = 0; n < 2; ++n) {
            const int task = tid + 512 * n, vh2 = task >> 9, f = (task >> 6) & 7, l = task & 63, rt = f >> 2, ts = f & 3, r = l & 31, h = l >> 5;
            const u32x4 w = afrag_rows(ATT + vh2 * (64 * GP_TST), GP_TST, 32 * rt + r, ts, h);
            *(u32x4*)(rec0 + (size_t)vh2 * 32 * GREC_BYTES + GR_A + (f * 64 + l) * 16) = w;
        }
    }
    __syncthreads(); asm volatile("" : "+v"(tid), "+v"(lane));
}

constexpr int HP_QT = 0, HP_KT = 17408, HP_QH = 34816, HP_KH = 52224, HP_IS = 69632, HP_GS = 87040, HP_AT = 90112;
__device__ __forceinline__ void hgrn_prep_unit(const PA& a, LAS unsigned char* lds, int u, int tid, int wid, int lane) {
    asm volatile("" : "+v"(tid), "+v"(lane));
    unsigned char* ws = a.ws();
    const int b = u >> 9, hd = (u >> 5) & 15, c = u & 31;
    const bf16* QhP = (const bf16*)(ws + WS_QHP); const float* FP = (const float*)(ws + WS_FP); const bf16* IP = (const bf16*)(ws + WS_IP);
    LAS bf16* QT = (LAS bf16*)(lds + HP_QT); LAS bf16* KT = (LAS bf16*)(lds + HP_KT); LAS bf16* QH = (LAS bf16*)(lds + HP_QH); LAS bf16* KH = (LAS bf16*)(lds + HP_KH);
    LAS bf16* IS = (LAS bf16*)(lds + HP_IS); LAS float* GS = (LAS float*)(lds + HP_GS); LAS bf16* AT = (LAS bf16*)(lds + HP_AT);
    const int row0 = b * SEQ + c * 64;
    unsigned char* rec = ws + WS_HREC + (size_t)((b * 16 + hd) * 32 + c) * HREC_BYTES;
    {
        const int d = tid & 127, tq = tid >> 7;
        float G[16], qv[16], kv[16];
        const size_t base = (size_t)(row0 + 16 * tq) * 2048 + hd * 128 + d;
        float run = 0.f;
#pragma unroll
        for (int j = 0; j < 16; ++j) { const float f = FP[base + (size_t)j * 2048]; run += __logf(f); G[j] = run; kv[j] = 1.f - f; qv[j] = bf2f(QhP[base + (size_t)j * 2048]);
            IS[(16 * tq + j) * GP_ST + d] = IP[base + (size_t)j * 2048]; }
        GS[256 + tq * 128 + d] = run;
        __syncthreads(); asm volatile("" : "+v"(tid), "+v"(lane));
        float off = 0.f;
#pragma unroll
        for (int q = 0; q < 3; ++q) if (q < tq) off += GS[256 + q * 128 + d];
        if (tq == 2) GS[128 + d] = off + G[0];
        if (tq == 3) { const float g63 = off + G[15]; GS[d] = g63; *(float*)(rec + HR_DEC + d * 4) = __expf(g63); }
        __syncthreads(); asm volatile("" : "+v"(tid), "+v"(lane));
        const float gref = GS[128 + d], g63 = GS[d];
#pragma unroll
        for (int j = 0; j < 16; ++j) {
            const float g = off + G[j]; const int t = 16 * tq + j;
            QT[t * GP_ST + d] = (bf16)(cvtpk(qv[j] * __expf(g - gref), 0.f) & 0xffffu);
            KT[t * GP_ST + d] = (bf16)(cvtpk(kv[j] * __expf(gref - g), 0.f) & 0xffffu);
            QH[t * GP_ST + d] = (bf16)(cvtpk(qv[j] * __expf(g), 0.f) & 0xffffu);
            KH[t * GP_ST + d] = (bf16)(cvtpk(kv[j] * __expf(g63 - g), 0.f) & 0xffffu);
        }
    }
    __syncthreads(); asm volatile("" : "+v"(tid), "+v"(lane));
    if (wid < 4) {
        const int rt = wid >> 1, ct = wid & 1, r = lane & 31, h = lane >> 5;
        const LAS bf16* Am = QT + (32 * rt + r) * GP_ST + 8 * h; const LAS bf16* Bm = KT + (32 * ct + r) * GP_ST + 8 * h;
        f32x16 acc;
#pragma unroll
        for (int i = 0; i < 16; ++i) acc[i] = 0.f;
#pragma unroll
        for (int kt = 0; kt < 8; ++kt) acc = MFMA32(*(const LAS bf16x8*)(Am + 16 * kt), *(const LAS bf16x8*)(Bm + 16 * kt), acc);
#pragma unroll
        for (int i = 0; i < 16; ++i) { const int t = 32 * rt + crow_(i, h), s = 32 * ct + r; AT[t * GP_TST + s] = (bf16)(cvtpk(t >= s ? acc[i] : 0.f, 0.f) & 0xffffu); }
    } else {
        const int t2 = tid - 256;
#pragma unroll
        for (int n = 0; n < 4; ++n) { const int task = t2 + 256 * n, f = task >> 6, l = task & 63, rt = f >> 3, kt = f & 7, r = l & 31, h = l >> 5;
            *(u32x4*)(rec + HR_Q + (f * 64 + l) * 16) = afrag_rows(QH, GP_ST, 32 * rt + r, kt, h); }
    }
    __syncthreads(); asm volatile("" : "+v"(tid), "+v"(lane));
    {
#pragma unroll
        for (int n = 0; n < 2; ++n) {
            const int task = tid + 512 * n, f = task >> 6, l = task & 63, dt = f >> 2, ts = f & 3, r = l & 31, h = l >> 5;
            unsigned short v[8];
#pragma unroll
            for (int j = 0; j < 8; ++j) v[j] = KH[kidx_(ts, h, j) * GP_ST + 32 * dt + r];
            *(u32x4*)(rec + HR_K + (f * 64 + l) * 16) = (u32x4){(unsigned)v[0] | ((unsigned)v[1] << 16), (unsigned)v[2] | ((unsigned)v[3] << 16), (unsigned)v[4] | ((unsigned)v[5] << 16), (unsigned)v[6] | ((unsigned)v[7] << 16)};
        }
#pragma unroll
        for (int n = 0; n < 2; ++n) {
            const int task = tid + 512 * n, f = task >> 6, l = task & 63, slab = f >> 2, ts = f & 3, r = l & 31, h = l >> 5;
            unsigned short v[8];
#pragma unroll
            for (int j = 0; j < 8; ++j) v[j] = IS[kidx_(ts, h, j) * GP_ST + 32 * slab + r];
            *(u32x4*)(rec + HR_I + (f * 64 + l) * 16) = (u32x4){(unsigned)v[0] | ((unsigned)v[1] << 16), (unsigned)v[2] | ((unsigned)v[3] << 16), (unsigned)v[4] | ((unsigned)v[5] << 16), (unsigned)v[6] | ((unsigned)v[7] << 16)};
        }
        {
            const int f = tid >> 6, l = tid & 63, rt = f >> 2, ts = f & 3, r = l & 31, h = l >> 5;
            *(u32x4*)(rec + HR_A + (f * 64 + l) * 16) = afrag_rows(AT, GP_TST, 32 * rt + r, ts, h);
        }
    }
    __syncthreads(); asm volatile("" : "+v"(tid), "+v"(lane));
}

template <int NP> __device__ __forceinline__ void stage_image(LAS unsigned char* lds, const unsigned char* rec, unsigned nbytes, int tid) {
    unsigned off0 = (unsigned)tid * 16u; asm volatile("" : "+v"(off0));
    u32x4 v[NP];
#pragma unroll
    for (int i = 0; i < NP; ++i) { if (i * (NTHREADS * 16) + (NTHREADS * 16) <= (int)nbytes || off0 + i * (NTHREADS * 16) < nbytes) v[i] = *(const u32x4*)(rec + i * (NTHREADS * 16) + off0); }
    __syncthreads();
#pragma unroll
    for (int i = 0; i < NP; ++i) { if (i * (NTHREADS * 16) + (NTHREADS * 16) <= (int)nbytes || off0 + i * (NTHREADS * 16) < nbytes) *(LAS u32x4*)(lds + i * (NTHREADS * 16) + off0) = v[i]; }
    __syncthreads();
}
#define LFRAG(off) (*(const LAS bf16x8*)(lds + (off)))
__device__ __forceinline__ void gdn_seq_block(const PA& a, LAS unsigned char* lds, int u, int tid, int wid, int lane) {
    unsigned char* ws = a.ws();
    const int b = u >> 5, vh = u & 31, slab = wid;
    bf16* O16 = (bf16*)(ws + WS_O16);
    f32x16 S[4];
#pragma unroll
    for (int d = 0; d < 4; ++d)
#pragma unroll
        for (int i = 0; i < 16; ++i) S[d][i] = 0.f;
    for (int c = 0; c < 32; ++c) {
        const unsigned char* rec = ws + WS_GREC + (size_t)((b * 32 + vh) * 32 + c) * GREC_BYTES;
        stage_image<7>(lds, rec, GR_IMG, tid);
        asm volatile("" : "+v"(lane));
        const int r = lane & 31, h = lane >> 5;
        if (wid < 4) {
            const float dec = ldg_agent((const float*)(rec + GR_DEC));
            f32x16 P1[2], P2[2];
#pragma unroll
            for (int rt = 0; rt < 2; ++rt) {
                const u32x4* up = (const u32x4*)(rec + GR_U + ((slab * 2 + rt) * 64 + lane) * 32);
                const u32x4 u0 = up[0], u1 = up[1];
                P1[rt][0] = bflo(u0.x); P1[rt][1] = bfhi(u0.x); P1[rt][2] = bflo(u0.y); P1[rt][3] = bfhi(u0.y); P1[rt][4] = bflo(u0.z); P1[rt][5] = bfhi(u0.z); P1[rt][6] = bflo(u0.w); P1[rt][7] = bfhi(u0.w);
                P1[rt][8] = bflo(u1.x); P1[rt][9] = bfhi(u1.x); P1[rt][10] = bflo(u1.y); P1[rt][11] = bfhi(u1.y); P1[rt][12] = bflo(u1.z); P1[rt][13] = bfhi(u1.z); P1[rt][14] = bflo(u1.w); P1[rt][15] = bfhi(u1.w);
#pragma unroll
                for (int i = 0; i < 16; ++i) P2[rt][i] = 0.f;
            }
#pragma unroll
            for (int d = 0; d < 4; ++d) {
                const bf16x8 b0 = pack_acc<0>(S[d]), b1 = pack_acc<1>(S[d]);
#pragma unroll
                for (int rt = 0; rt < 2; ++rt) {
                    P1[rt] = MFMA32(LFRAG(GR_W + ((rt * 8 + 2 * d) * 64 + lane) * 16), b0, P1[rt]);     P2[rt] = MFMA32(LFRAG(GR_Q + ((rt * 8 + 2 * d) * 64 + lane) * 16), b0, P2[rt]);
                    P1[rt] = MFMA32(LFRAG(GR_W + ((rt * 8 + 2 * d + 1) * 64 + lane) * 16), b1, P1[rt]); P2[rt] = MFMA32(LFRAG(GR_Q + ((rt * 8 + 2 * d + 1) * 64 + lane) * 16), b1, P2[rt]);
                }
                __builtin_amdgcn_sched_barrier(0);
            }
            const bf16x8 bv0 = pack_acc<0>(P1[0]), bv1 = pack_acc<1>(P1[0]), bv2 = pack_acc<0>(P1[1]), bv3 = pack_acc<1>(P1[1]);
#pragma unroll
            for (int rt = 0; rt < 2; ++rt) {
                P2[rt] = MFMA32(LFRAG(GR_A + ((rt * 4 + 0) * 64 + lane) * 16), bv0, P2[rt]); P2[rt] = MFMA32(LFRAG(GR_A + ((rt * 4 + 1) * 64 + lane) * 16), bv1, P2[rt]);
                P2[rt] = MFMA32(LFRAG(GR_A + ((rt * 4 + 2) * 64 + lane) * 16), bv2, P2[rt]); P2[rt] = MFMA32(LFRAG(GR_A + ((rt * 4 + 3) * 64 + lane) * 16), bv3, P2[rt]);
                __builtin_amdgcn_sched_barrier(0);
            }
            {
                bf16* op = O16 + (size_t)(b * SEQ + c * 64) * 6144 + 2048 + vh * 128 + 32 * slab + r;
#pragma unroll
                for (int rt = 0; rt < 2; ++rt)
#pragma unroll
                    for (int i = 0; i < 16; ++i) op[(size_t)(32 * rt + crow_(i, h)) * 6144] = (bf16)(cvtpk(P2[rt][i], 0.f) & 0xffffu);
            }
#pragma unroll
            for (int d = 0; d < 4; ++d) {
#pragma unroll
                for (int i = 0; i < 16; ++i) S[d][i] *= dec;
                S[d] = MFMA32(LFRAG(GR_K + ((d * 4 + 0) * 64 + lane) * 16), bv0, S[d]); S[d] = MFMA32(LFRAG(GR_K + ((d * 4 + 1) * 64 + lane) * 16), bv1, S[d]);
                S[d] = MFMA32(LFRAG(GR_K + ((d * 4 + 2) * 64 + lane) * 16), bv2, S[d]); S[d] = MFMA32(LFRAG(GR_K + ((d * 4 + 3) * 64 + lane) * 16), bv3, S[d]);
                __builtin_amdgcn_sched_barrier(0);
            }
        }
    }
    if (wid < 4) {
        asm volatile("" : "+v"(lane)); const int r = lane & 31, h = lane >> 5;
        float* so = a.out() + O_GDP + (size_t)((b * 32 + vh) * 128) * 128 + 32 * slab + r;
#pragma unroll
        for (int d = 0; d < 4; ++d)
#pragma unroll
            for (int i = 0; i < 16; ++i) so[(size_t)(32 * d + crow_(i, h)) * 128] = S[d][i];
    }
    __syncthreads();
}
__device__ __forceinline__ void hgrn_seq_block(const PA& a, LAS unsigned char* lds, int u, int tid, int wid, int lane) {
    unsigned char* ws = a.ws();
    const int b = u >> 4, hd = u & 15, slab = wid;
    bf16* O16 = (bf16*)(ws + WS_O16);
    f32x16 S[4];
#pragma unroll
    for (int d = 0; d < 4; ++d)
#pragma unroll
        for (int i = 0; i < 16; ++i) S[d][i] = 0.f;
    for (int c = 0; c < 32; ++c) {
        const unsigned char* rec = ws + WS_HREC + (size_t)((b * 16 + hd) * 32 + c) * HREC_BYTES;
        stage_image<8>(lds, rec, HR_IMG, tid);
        asm volatile("" : "+v"(lane));
        const int r = lane & 31, h = lane >> 5;
        if (wid < 4) {
            f32x16 o[2];
#pragma unroll
            for (int rt = 0; rt < 2; ++rt)
#pragma unroll
                for (int i = 0; i < 16; ++i) o[rt][i] = 0.f;
#pragma unroll
            for (int d = 0; d < 4; ++d) {
                const bf16x8 b0 = pack_acc<0>(S[d]), b1 = pack_acc<1>(S[d]);
#pragma unroll
                for (int rt = 0; rt < 2; ++rt) { o[rt] = MFMA32(LFRAG(HR_Q + ((rt * 8 + 2 * d) * 64 + lane) * 16), b0, o[rt]); o[rt] = MFMA32(LFRAG(HR_Q + ((rt * 8 + 2 * d + 1) * 64 + lane) * 16), b1, o[rt]); }
                __builtin_amdgcn_sched_barrier(0);
            }
            const bf16x8 i0 = LFRAG(HR_I + ((slab * 4 + 0) * 64 + lane) * 16), i1 = LFRAG(HR_I + ((slab * 4 + 1) * 64 + lane) * 16), i2 = LFRAG(HR_I + ((slab * 4 + 2) * 64 + lane) * 16), i3 = LFRAG(HR_I + ((slab * 4 + 3) * 64 + lane) * 16);
#pragma unroll
            for (int rt = 0; rt < 2; ++rt) {
                o[rt] = MFMA32(LFRAG(HR_A + ((rt * 4 + 0) * 64 + lane) * 16), i0, o[rt]); o[rt] = MFMA32(LFRAG(HR_A + ((rt * 4 + 1) * 64 + lane) * 16), i1, o[rt]);
                o[rt] = MFMA32(LFRAG(HR_A + ((rt * 4 + 2) * 64 + lane) * 16), i2, o[rt]); o[rt] = MFMA32(LFRAG(HR_A + ((rt * 4 + 3) * 64 + lane) * 16), i3, o[rt]);
                __builtin_amdgcn_sched_barrier(0);
            }
            {
                bf16* op = O16 + (size_t)(b * SEQ + c * 64) * 6144 + hd * 128 + 32 * slab + r;
#pragma unroll
                for (int rt = 0; rt < 2; ++rt)
#pragma unroll
                    for (int i = 0; i < 16; ++i) op[(size_t)(32 * rt + crow_(i, h)) * 6144] = (bf16)(cvtpk(o[rt][i], 0.f) & 0xffffu);
            }
            const LAS float* dec = (const LAS float*)(lds + HR_DEC);
#pragma unroll
            for (int d = 0; d < 4; ++d) {
#pragma unroll
                for (int i4 = 0; i4 < 4; ++i4) { const f32x4 dv = *(const LAS f32x4*)(dec + 32 * d + 8 * i4 + 4 * h);
#pragma unroll
                    for (int e = 0; e < 4; ++e) S[d][4 * i4 + e] *= dv[e]; }
                S[d] = MFMA32(LFRAG(HR_K + ((d * 4 + 0) * 64 + lane) * 16), i0, S[d]); S[d] = MFMA32(LFRAG(HR_K + ((d * 4 + 1) * 64 + lane) * 16), i1, S[d]);
                S[d] = MFMA32(LFRAG(HR_K + ((d * 4 + 2) * 64 + lane) * 16), i2, S[d]); S[d] = MFMA32(LFRAG(HR_K + ((d * 4 + 3) * 64 + lane) * 16), i3, S[d]);
                __builtin_amdgcn_sched_barrier(0);
            }
        }
    }
    if (wid < 4) {
        asm volatile("" : "+v"(lane)); const int r = lane & 31, h = lane >> 5;
        float* so = a.out() + O_HGP + (size_t)((b * 16 + hd) * 128) * 128 + 32 * slab + r;
#pragma unroll
        for (int d = 0; d < 4; ++d)
#pragma unroll
            for (int i = 0; i < 16; ++i) so[(size_t)(32 * d + crow_(i, h)) * 128] = S[d][i];
    }
    __syncthreads();
}

#define XB_TMO      128
#define XB_XCNT(j)  (256  + 64 * (j))
#define XB_XSUB(j)  (1280 + 64 * (j))
#define XB_XGEN(j)  (2304 + 64 * (j))
#define XB_TOP      3328
#define XB_TOPGEN   3392
#define XCD_BAR_WORDS 3456
#define XB_SPIN_CAP (1u << 18)
__device__ __forceinline__ unsigned xb_ld(unsigned* p)              { return __hip_atomic_load(p, __ATOMIC_RELAXED, __HIP_MEMORY_SCOPE_AGENT); }
__device__ __forceinline__ unsigned xb_add(unsigned* p, unsigned v) { return __hip_atomic_fetch_add(p, v, __ATOMIC_RELAXED, __HIP_MEMORY_SCOPE_AGENT); }
__device__ __forceinline__ unsigned xb_xcc_id() { return (unsigned)__builtin_amdgcn_s_getreg((3 << 11) | 20) & 0xFu; }
#define XB_SPIN(cond, bar) do { unsigned _sp = 0; while (cond) { __builtin_amdgcn_s_sleep(1); \
    if ((++_sp & 255u) == 0u) { if (xb_ld(&(bar)[XB_TMO])) break; if (_sp > XB_SPIN_CAP) { atomicAdd(&(bar)[XB_TMO], 1u); break; } } } } while (0)
__device__ __forceinline__ void xcd_barrier_complete(unsigned* bar, unsigned x, unsigned G, unsigned& nloc, unsigned& nx) {
    unsigned sum, cnt, mine, sp = 0u;
    for (;;) {
        sum = 0u; cnt = 0u; mine = 0u;
#pragma unroll
        for (unsigned j = 0; j < 16; ++j) { const unsigned c = xb_ld(&bar[XB_XCNT(j)]); sum += c; cnt += (c > 0u) ? 1u : 0u; mine = (j == x) ? c : mine; }
        if (sum == G) break;
        __builtin_amdgcn_s_sleep(1);
        if ((++sp & 255u) == 0u) { if (xb_ld(&bar[XB_TMO])) break; if (sp > XB_SPIN_CAP) { atomicAdd(&bar[XB_TMO], 1u); break; } }
    }
    nloc = mine > 0u ? mine : 1u; nx = cnt > 0u ? cnt : 1u;
}
__device__ __forceinline__ void xcd_barrier(unsigned* bar, unsigned x, volatile LAS unsigned* st, int tid, unsigned G) {
    asm volatile("s_waitcnt vmcnt(0)" ::: "memory");
    __syncthreads();
    if (tid == 0) {
        __builtin_amdgcn_s_waitcnt(0);
        unsigned nloc = st[0], nx = st[1];
        if (nloc == 0u) { xcd_barrier_complete(bar, x, G, nloc, nx); st[0] = nloc; st[1] = nx; }
        const unsigned old = xb_add(&bar[XB_XSUB(x)], 1u);
        const unsigned gen = old / nloc;
        if (old + 1u == (gen + 1u) * nloc) {
            __builtin_amdgcn_fence(__ATOMIC_RELEASE, "agent");
            asm volatile("s_waitcnt vmcnt(0)" ::: "memory");
            const unsigned og = xb_add(&bar[XB_TOP], 1u);
            const unsigned tg = og / nx;
            if (og + 1u == (tg + 1u) * nx) xb_add(&bar[XB_TOPGEN], 1u);
            else XB_SPIN(xb_ld(&bar[XB_TOPGEN]) == tg, bar);
            __builtin_amdgcn_fence(__ATOMIC_ACQUIRE, "agent");
            xb_add(&bar[XB_XGEN(x)], 1u);
            asm volatile("s_waitcnt vmcnt(0)" ::: "memory");
        } else {
            XB_SPIN(xb_ld(&bar[XB_XGEN(x)]) == gen, bar);
            __builtin_amdgcn_fence(__ATOMIC_ACQUIRE, "agent");
            asm volatile("s_waitcnt vmcnt(0)" ::: "memory");
        }
    }
    __syncthreads();
}
constexpr int CW_WORK = 64;
constexpr int CW_BAR = 4096;
constexpr size_t CTL_ZERO_BYTES = 65536;
constexpr int LDS_ST_OFF = LDS_BYTES - 64;

__global__ void __launch_bounds__(NTHREADS, 2) fwd(Args args_unused) {
    extern __shared__ __attribute__((aligned(16))) unsigned char lds_raw[];
    LAS unsigned char* lds = (LAS unsigned char*)lds_raw;
    const int wid = __builtin_amdgcn_readfirstlane(threadIdx.x >> 6);
    const int G = gridDim.x, bx = blockIdx.x;
    const int vcu = (G % 8 == 0) ? (bx % 8) * (G / 8) + bx / 8 : bx;
    const int gw = vcu * NWAVES + wid, NGW = G * NWAVES;
    volatile LAS unsigned* bst = (volatile LAS unsigned*)(lds + LDS_ST_OFF);
    const unsigned xcc = xb_xcc_id();
    { const PA a0 = PA::get(); const int l0 = lane_id_(); if (wid == 0 && l0 < 2) bst[l0] = 0u;
      if (a0.ph_hi() - a0.ph_lo() > 1 && wid == 0 && l0 == 0) (void)xb_add((unsigned*)a0.ws() + CW_BAR + XB_XCNT(xcc), 1u); }
    __syncthreads();
#ifndef PH_MASK
#define PH_MASK 0xffff
#endif
#define IN(k) (((PH_MASK >> (k)) & 1) && ph_in(k))
#define SEAM(k) do { if (IN(k) && IN((k) + 1)) { if ((k) == 0) cg::this_grid().sync(); \
    else { const PA ab = PA::get(); xcd_barrier((unsigned*)ab.ws() + CW_BAR, xcc, bst, wid * 64 + lane_id_(), (unsigned)G); } } } while (0)

    if (IN(0)) for (int rep_ = 0; rep_ < NREP(0); ++rep_) { if (rep_) { const PA ab = PA::get(); xcd_barrier((unsigned*)ab.ws() + CW_BAR, xcc, bst, wid * 64 + lane_id_(), (unsigned)G); }
        const PA a = PA::get(); unsigned char* ws = a.ws(); const int lane = lane_id_(), tid = wid * 64 + lane; (void)tid;
        for (int cb = vcu; cb < NADA / 64; cb += G) mod_item(a, lds, cb, tid, wid, lane);
        __syncthreads();
        LAS float* scr = (LAS float*)(lds + wid * 16384);
        constexpr int I0 = 32 * 770, I1 = 32 * 64, I2 = 64 * 64, I3 = 32 * 64, I4 = 32 * 256, I5 = 128 * 64, NIT = I0 + I1 + I2 + I3 + I4 + I5;
        bf16* BtIn = (bf16*)(ws + WS_BTIN); bf16* BtOut = (bf16*)(ws + WS_BTOUT); bf16* BtO = (bf16*)(ws + WS_BTO); bf16* BtUp = (bf16*)(ws + WS_BTUP); bf16* BtDn = (bf16*)(ws + WS_BTDN);
        for (int it = gw; it < NIT; it += NGW) {
            int r = it;
            if (r < I0) { const int kb = r / 770, nb = r % 770, n0 = nb * 32; const int nd = n0 < 20480 ? n0 : (n0 < 20544 ? n0 - 20480 + 24576 : n0 - 64);
                transpose_item(a.in(I_WIN), N_IN, BtIn, 2048, kb * 64, n0, nd, scr, lane); continue; } r -= I0;
            if (r < I1) { transpose_item(a.in(I_WOHG), 2048, BtOut, 6144, (r / 64) * 64, (r % 64) * 32, (r % 64) * 32, scr, lane); continue; } r -= I1;
            if (r < I2) { transpose_item(a.in(I_WOGD), 2048, BtOut + 2048, 6144, (r / 64) * 64, (r % 64) * 32, (r % 64) * 32, scr, lane); continue; } r -= I2;
            if (r < I3) { transpose_item(a.in(I_WO), 2048, BtO, 2048, (r / 64) * 64, (r % 64) * 32, (r % 64) * 32, scr, lane); continue; } r -= I3;
            if (r < I4) { transpose_item(a.in(I_WUP), 8192, BtUp, 2048, (r / 256) * 64, (r % 256) * 32, (r % 256) * 32, scr, lane); continue; } r -= I4;
            transpose_item(a.in(I_WDN), 2048, BtDn, 8192, (r / 64) * 64, (r % 64) * 32, (r % 64) * 32, scr, lane);
        }
        { u32x4* z = (u32x4*)(BtIn + (size_t)N_IN * 2048); const int nz = (N_INP - N_IN) * 2048 * 2 / 16;
          for (int i = vcu * NTHREADS + tid; i < nz; i += G * NTHREADS) z[i] = (u32x4){0u, 0u, 0u, 0u}; }
    }
    SEAM(0);
    if (IN(1)) for (int rep_ = 0; rep_ < NREP(1); ++rep_) { if (rep_) { const PA ab = PA::get(); xcd_barrier((unsigned*)ab.ws() + CW_BAR, xcc, bst, wid * 64 + lane_id_(), (unsigned)G); }
        const PA a = PA::get(); unsigned char* ws = a.ws(); const int lane = lane_id_(), tid = wid * 64 + lane; (void)tid;
        const float* mod = (const float*)(ws + WS_MOD); const float* ng = a.in(I_NG); bf16* A1 = (bf16*)(ws + WS_A1);
        for (int row = gw; row < MROWS; row += NGW) {
            const f32x4* xr = (const f32x4*)xrow_ptr(a, row) + lane; const float* md = mod + (size_t)seq_of_row(row) * NADA;
            f32x4 v[8]; float ss = 0.f;
#pragma unroll
            for (int j = 0; j < 8; ++j) { v[j] = xr[64 * j]; ss += (v[j][0] * v[j][0] + v[j][1] * v[j][1]) + (v[j][2] * v[j][2] + v[j][3] * v[j][3]); }
            const float r = rsqrtf(wave_sum(ss) * (1.f / DM) + EPS);
            u32x2* o = (u32x2*)(A1 + (size_t)row * DM) + lane;
#pragma unroll
            for (int j = 0; j < 8; ++j) { const int c = 4 * lane + 256 * j; const f32x4 g = *(const f32x4*)(ng + c), sh = *(const f32x4*)(md + c), sc = *(const f32x4*)(md + 2048 + c);
                f32x4 y; _Pragma("unroll") for (int e = 0; e < 4; ++e) y[e] = v[j][e] * r * g[e] * (1.f + sc[e]) + sh[e];
                o[64 * j] = (u32x2){pk2(y[0], y[1]), pk2(y[2], y[3])}; }
        }
    }
    SEAM(1);
    if (IN(2)) for (int rep_ = 0; rep_ < NREP(2); ++rep_) { if (rep_) { const PA ab = PA::get(); xcd_barrier((unsigned*)ab.ws() + CW_BAR, xcc, bst, wid * 64 + lane_id_(), (unsigned)G); }
        const PA a = PA::get(); unsigned char* ws = a.ws(); const int lane = lane_id_(), tid = wid * 64 + lane; (void)tid;
        pg8::Gemm g{(const bf16*)(ws + WS_A1), (const bf16*)(ws + WS_BTIN), 2048, 2048, 2048}; pg8::StaticOrder S; S.init(MROWS, N_INP, G, bx);
        EpiIn E{ws, a.in(I_LB), a.in(I_ALOG), a.in(I_DTB)};
        pg8::gemm_phase<EpiIn, pg8::StaticOrder, true, true>(lds, g, S, E, wid);
    }
    SEAM(2);
    if (IN(3)) for (int rep_ = 0; rep_ < NREP(3); ++rep_) { if (rep_) { const PA ab = PA::get(); xcd_barrier((unsigned*)ab.ws() + CW_BAR, xcc, bst, wid * 64 + lane_id_(), (unsigned)G); }
        const PA a = PA::get(); unsigned char* ws = a.ws(); const int lane = lane_id_(), tid = wid * 64 + lane; (void)tid;
#ifndef NO_GP
        for (int rr_ = 0; rr_ < NREP(16); ++rr_) for (int u = bx; u < 2048; u += G) gdn_prep_unit(a, lds, u, tid, wid, lane);
#endif
#ifndef NO_HP
        for (int rr_ = 0; rr_ < NREP(17); ++rr_) for (int u = bx; u < 2048; u += G) hgrn_prep_unit(a, lds, u, tid, wid, lane);
#endif
        { const bf16* US = (const bf16*)(ws + WS_US); bf16* UCS = (bf16*)(ws + WS_UCS); const float* cw = a.in(I_CW); const float* cc = a.in(I_CC);
          for (int it = gw; it < 512 * 16; it += NGW) {
            const int row = it >> 4, g = it & 15, c = g * 512 + 8 * lane, t = row & 3, b = row >> 2;
            float x[8];
#pragma unroll
            for (int e = 0; e < 8; ++e) x[e] = 0.f;
#pragma unroll
            for (int j = 0; j < 4; ++j) {
                const int tt = t - 3 + j; float u[8];
                if (tt >= 0) { const u32x4 w = *(const u32x4*)(US + (size_t)(row - 3 + j) * CONVCH + c);
                    u[0] = bflo(w.x); u[1] = bfhi(w.x); u[2] = bflo(w.y); u[3] = bfhi(w.y); u[4] = bflo(w.z); u[5] = bfhi(w.z); u[6] = bflo(w.w); u[7] = bfhi(w.w); }
                else { const f32x4* cp = (const f32x4*)(cc + ((size_t)b * 3 + (3 + tt)) * CONVCH + c); const f32x4 w0 = cp[0], w1 = cp[1];
                    u[0] = w0[0]; u[1] = w0[1]; u[2] = w0[2]; u[3] = w0[3]; u[4] = w1[0]; u[5] = w1[1]; u[6] = w1[2]; u[7] = w1[3]; }
                const f32x4* wp = (const f32x4*)(cw + (size_t)j * CONVCH + c); const f32x4 c0 = wp[0], c1 = wp[1];
                x[0] = fmaf(c0[0], u[0], x[0]); x[1] = fmaf(c0[1], u[1], x[1]); x[2] = fmaf(c0[2], u[2], x[2]); x[3] = fmaf(c0[3], u[3], x[3]);
                x[4] = fmaf(c1[0], u[4], x[4]); x[5] = fmaf(c1[1], u[5], x[5]); x[6] = fmaf(c1[2], u[6], x[6]); x[7] = fmaf(c1[3], u[7], x[7]);
            }
            float ss = 0.f;
#pragma unroll
            for (int e = 0; e < 8; ++e) { x[e] = siluf_(x[e]); ss = fmaf(x[e], x[e], ss); }
            if (g < 8) { ss += __shfl_xor(ss, 1); ss += __shfl_xor(ss, 2); ss += __shfl_xor(ss, 4); ss += __shfl_xor(ss, 8);
                float r = rsqrtf(ss + EPS); if (g < 4) r *= 0.08838834764831845f;
#pragma unroll
                for (int e = 0; e < 8; ++e) x[e] *= r; }
            *(u32x4*)(UCS + (size_t)row * CONVCH + c) = (u32x4){pk2(x[0], x[1]), pk2(x[2], x[3]), pk2(x[4], x[5]), pk2(x[6], x[7])};
          }
          const bf16* UPr = (const bf16*)(ws + WS_UP);
          for (int i = vcu * NTHREADS + tid; i < (12 + 384) * (CONVCH / 8); i += G * NTHREADS) {
            const int rr = i / (CONVCH / 8), c = (i % (CONVCH / 8)) * 8; const bf16* src; float* dst;
            if (rr < 12) { const int b = rr / 3, j = rr % 3; src = UPr + (size_t)(b * SEQ + SEQ - 3 + j) * CONVCH + c; dst = a.out() + O_CCP + (size_t)rr * CONVCH + c; }
            else { const int r2 = rr - 12, b = r2 / 3, j = r2 % 3; src = US + (size_t)(b * DSEQ + 1 + j) * CONVCH + c; dst = a.out() + O_CCS + (size_t)r2 * CONVCH + c; }
            const u32x4 w = *(const u32x4*)src;
            ((f32x4*)dst)[0] = (f32x4){bflo(w.x), bfhi(w.x), bflo(w.y), bfhi(w.y)}; ((f32x4*)dst)[1] = (f32x4){bflo(w.z), bfhi(w.z), bflo(w.w), bfhi(w.w)};
          } }
    }
    SEAM(3);
    if (IN(4)) for (int rep_ = 0; rep_ < NREP(4); ++rep_) { if (rep_) { const PA ab = PA::get(); xcd_barrier((unsigned*)ab.ws() + CW_BAR, xcc, bst, wid * 64 + lane_id_(), (unsigned)G); }
        const PA a = PA::get(); unsigned char* ws = a.ws(); const int lane = lane_id_(), tid = wid * 64 + lane; (void)tid;
        for (int rr_ = 0; rr_ < NREP(19); ++rr_) {
#ifndef NO_GS
        if (bx < 128) gdn_seq_block(a, lds, bx, tid, wid, lane);
#endif
#ifndef NO_HS
        if (bx >= 128 && bx < 192) hgrn_seq_block(a, lds, bx - 128, tid, wid, lane);
#endif
        }
        LAS float* wl = (LAS float*)(lds + wid * 4096);
        unsigned* ctr = (unsigned*)ws + CW_WORK + rep_;
        constexpr int NI_HS = 8192, NI_GS = 16384;
#define SAMPLE_LOAD(itv, SS) do { const int ln_ = lane_id_(); const bool gd_ = (itv) < NI_GS; const int r_ = gd_ ? (itv) : (itv) - NI_GS; \
            const float* s0_ = (gd_ ? a.in(I_SGD) : a.in(I_SHG)) + (size_t)(((r_ >> 2) * 128 + 64 * (ln_ >> 5)) * 128 + 32 * (r_ & 3) + (ln_ & 31)); \
            _Pragma("unroll") for (int j = 0; j < 64; ++j) SS[j] = s0_[j * 128]; } while (0)
#define SAMPLE_RUN(itv, SS) do { const int ln = lane_id_(); if ((itv) < NI_GS) gdn_item(a, wl, (itv) >> 7, ((itv) >> 2) & 31, (itv) & 3, ln, SS); \
            else { const int r = (itv) - NI_GS; hgrn_item(a, wl, r >> 6, (r >> 2) & 15, r & 3, ln, SS); } } while (0)
        {
            volatile LAS int* tk = (volatile LAS int*)(lds + LDS_ST_OFF + 16);
            for (;;) {
                __syncthreads();
                if (wid == 0 && lane_id_() == 0) tk[0] = (int)atomicAdd(ctr, 16u);
                __syncthreads();
                const int base = __builtin_amdgcn_readfirstlane(tk[0]);
                if (base >= NI_HS + NI_GS) break;
                const int i0 = base + 2 * wid, i1 = i0 + 1;
                float Sa[64], Sb[64];
                SAMPLE_LOAD(i0, Sa); SAMPLE_LOAD(i1, Sb);
                SAMPLE_RUN(i0, Sa);
                SAMPLE_RUN(i1, Sb);
            }
        }
#undef SAMPLE_RUN
#undef SAMPLE_LOAD
    }
    SEAM(4);
    if (IN(5)) for (int rep_ = 0; rep_ < NREP(5); ++rep_) { if (rep_) { const PA ab = PA::get(); xcd_barrier((unsigned*)ab.ws() + CW_BAR, xcc, bst, wid * 64 + lane_id_(), (unsigned)G); }
        const PA a = PA::get(); unsigned char* ws = a.ws(); const int lane = lane_id_(), tid = wid * 64 + lane; (void)tid;
        const bf16* O16 = (const bf16*)(ws + WS_O16); bf16* OA = (bf16*)(ws + WS_OA); const bf16* Gh = (const bf16*)(ws + WS_GH); const bf16* Gz = (const bf16*)(ws + WS_GZ);
        for (int row = gw; row < MROWS; row += NGW) {
            const u32x4* op = (const u32x4*)(O16 + (size_t)row * 6144) + lane; u32x4* dp = (u32x4*)(OA + (size_t)row * 6144) + lane;
            const u32x4* ghp = (const u32x4*)(Gh + (size_t)row * 2048) + lane; const u32x4* gzp = (const u32x4*)(Gz + (size_t)row * 4096) + lane;
#pragma unroll
            for (int kg = 0; kg < 3; ++kg) {
                u32x4 ov[4], gv[4];
#pragma unroll
                for (int k4 = 0; k4 < 4; ++k4) { const int k = 4 * kg + k4; ov[k4] = op[64 * k]; gv[k4] = kg == 0 ? ghp[64 * k] : gzp[64 * (k - 4)]; }
                const f32x4* np = (const f32x4*)((kg == 0 ? a.in(I_HGN) : a.in(I_GDN)) + 8 * (lane & 15)); const f32x4 n0 = np[0], n1 = np[1];
#pragma unroll
                for (int k4 = 0; k4 < 4; ++k4) {
                    const int k = 4 * kg + k4;
                    float o[8] = {bflo(ov[k4].x), bfhi(ov[k4].x), bflo(ov[k4].y), bfhi(ov[k4].y), bflo(ov[k4].z), bfhi(ov[k4].z), bflo(ov[k4].w), bfhi(ov[k4].w)};
                    const float g[8] = {bflo(gv[k4].x), bfhi(gv[k4].x), bflo(gv[k4].y), bfhi(gv[k4].y), bflo(gv[k4].z), bfhi(gv[k4].z), bflo(gv[k4].w), bfhi(gv[k4].w)};
                    float ss = 0.f;
#pragma unroll
                    for (int e = 0; e < 8; ++e) ss = fmaf(o[e], o[e], ss);
                    ss += __shfl_xor(ss, 1); ss += __shfl_xor(ss, 2); ss += __shfl_xor(ss, 4); ss += __shfl_xor(ss, 8);
                    const float r = rsqrtf(ss * (1.f / 128.f) + EPS);
                    dp[64 * k] = (u32x4){pk2(o[0] * r * n0[0] * g[0], o[1] * r * n0[1] * g[1]), pk2(o[2] * r * n0[2] * g[2], o[3] * r * n0[3] * g[3]),
                                         pk2(o[4] * r * n1[0] * g[4], o[5] * r * n1[1] * g[5]), pk2(o[6] * r * n1[2] * g[6], o[7] * r * n1[3] * g[7])};
                }
                asm volatile("" ::: "memory");
            }
        }
    }
    SEAM(5);
    if (IN(6)) for (int rep_ = 0; rep_ < NREP(6); ++rep_) { if (rep_) { const PA ab = PA::get(); xcd_barrier((unsigned*)ab.ws() + CW_BAR, xcc, bst, wid * 64 + lane_id_(), (unsigned)G); }
        const PA a = PA::get(); unsigned char* ws = a.ws(); const int lane = lane_id_(), tid = wid * 64 + lane; (void)tid;
        pg8::Gemm g{(const bf16*)(ws + WS_OA), (const bf16*)(ws + WS_BTOUT), 6144, 6144, 2048}; pg8::StaticOrder S; S.init(MROWS, 2048, G, bx);
        EpiOut1 E{(float*)(ws + WS_T1), (const bf16*)(ws + WS_SA)};
        pg8::gemm_phase<EpiOut1, pg8::StaticOrder, true, true>(lds, g, S, E, wid);
    }
    SEAM(6);
    if (IN(7)) for (int rep_ = 0; rep_ < NREP(7); ++rep_) { if (rep_) { const PA ab = PA::get(); xcd_barrier((unsigned*)ab.ws() + CW_BAR, xcc, bst, wid * 64 + lane_id_(), (unsigned)G); }
        const PA a = PA::get(); unsigned char* ws = a.ws(); const int lane = lane_id_(), tid = wid * 64 + lane; (void)tid;
        pg8::Gemm g{(const bf16*)(ws + WS_OA) + 2048, (const bf16*)(ws + WS_BTOUT) + 2048, 6144, 6144, 4096}; pg8::StaticOrder S; S.init(MROWS, 2048, G, bx);
        EpiOut2 E{(const float*)(ws + WS_T1), (const bf16*)(ws + WS_SB), (bf16*)(ws + WS_MG)};
        pg8::gemm_phase<EpiOut2, pg8::StaticOrder, true, true>(lds, g, S, E, wid);
    }
    SEAM(7);
    if (IN(8)) for (int rep_ = 0; rep_ < NREP(8); ++rep_) { if (rep_) { const PA ab = PA::get(); xcd_barrier((unsigned*)ab.ws() + CW_BAR, xcc, bst, wid * 64 + lane_id_(), (unsigned)G); }
        const PA a = PA::get(); unsigned char* ws = a.ws(); const int lane = lane_id_(), tid = wid * 64 + lane; (void)tid;
        pg8::Gemm g{(const bf16*)(ws + WS_MG), (const bf16*)(ws + WS_BTO), 2048, 2048, 2048}; pg8::StaticOrder S; S.init(MROWS, 2048, G, bx);
        EpiF32 E{(float*)(ws + WS_MIX), 2048};
        pg8::gemm_phase<EpiF32, pg8::StaticOrder, true, true>(lds, g, S, E, wid);
    }
    SEAM(8);
    if (IN(9)) for (int rep_ = 0; rep_ < NREP(9); ++rep_) { if (rep_) { const PA ab = PA::get(); xcd_barrier((unsigned*)ab.ws() + CW_BAR, xcc, bst, wid * 64 + lane_id_(), (unsigned)G); }
        const PA a = PA::get(); unsigned char* ws = a.ws(); const int lane = lane_id_(), tid = wid * 64 + lane; (void)tid;
        const float* mod = (const float*)(ws + WS_MOD); const float* ng = a.in(I_NG); bf16* A1 = (bf16*)(ws + WS_A1); const float* MIX = (const float*)(ws + WS_MIX); float* H = (float*)(ws + WS_H);
        for (int row = gw; row < MROWS; row += NGW) {
            const f32x4* xr = (const f32x4*)xrow_ptr(a, row) + lane; const f32x4* mr = (const f32x4*)(MIX + (size_t)row * DM) + lane; const float* md = mod + (size_t)seq_of_row(row) * NADA;
            f32x4 v[8]; float ss = 0.f;
#pragma unroll
            for (int j = 0; j < 8; ++j) { v[j] = mr[64 * j]; ss += (v[j][0] * v[j][0] + v[j][1] * v[j][1]) + (v[j][2] * v[j][2] + v[j][3] * v[j][3]); }
            const float r1 = rsqrtf(wave_sum(ss) * (1.f / DM) + EPS);
            f32x4* ho = (f32x4*)(H + (size_t)row * DM) + lane; float s2 = 0.f;
#pragma unroll
            for (int j = 0; j < 8; ++j) { const int c = 4 * lane + 256 * j; const f32x4 g = *(const f32x4*)(ng + 2048 + c), g1 = *(const f32x4*)(md + 4096 + c), x = xr[64 * j];
                _Pragma("unroll") for (int e = 0; e < 4; ++e) { v[j][e] = x[e] + g1[e] * (v[j][e] * r1 * g[e]); s2 += v[j][e] * v[j][e]; }
                ho[64 * j] = v[j]; }
            const float r2 = rsqrtf(wave_sum(s2) * (1.f / DM) + EPS);
            u32x2* o = (u32x2*)(A1 + (size_t)row * DM) + lane;
#pragma unroll
            for (int j = 0; j < 8; ++j) { const int c = 4 * lane + 256 * j; const f32x4 g = *(const f32x4*)(ng + 4096 + c), sh = *(const f32x4*)(md + 6144 + c), sc = *(const f32x4*)(md + 8192 + c);
                f32x4 y; _Pragma("unroll") for (int e = 0; e < 4; ++e) y[e] = v[j][e] * r2 * g[e] * (1.f + sc[e]) + sh[e];
                o[64 * j] = (u32x2){pk2(y[0], y[1]), pk2(y[2], y[3])}; }
        }
    }
    SEAM(9);
    if (IN(10)) for (int rep_ = 0; rep_ < NREP(10); ++rep_) { if (rep_) { const PA ab = PA::get(); xcd_barrier((unsigned*)ab.ws() + CW_BAR, xcc, bst, wid * 64 + lane_id_(), (unsigned)G); }
        const PA a = PA::get(); unsigned char* ws = a.ws(); const int lane = lane_id_(), tid = wid * 64 + lane; (void)tid;
        pg8::Gemm g{(const bf16*)(ws + WS_A1), (const bf16*)(ws + WS_BTUP), 2048, 2048, 2048}; pg8::StaticOrder S; S.init(MROWS, DFF, G, bx);
        EpiRelu2 E{(bf16*)(ws + WS_U2), DFF};
        pg8::gemm_phase<EpiRelu2, pg8::StaticOrder, true, true>(lds, g, S, E, wid);
    }
    SEAM(10);
    if (IN(11)) for (int rep_ = 0; rep_ < NREP(11); ++rep_) { if (rep_) { const PA ab = PA::get(); xcd_barrier((unsigned*)ab.ws() + CW_BAR, xcc, bst, wid * 64 + lane_id_(), (unsigned)G); }
        const PA a = PA::get(); unsigned char* ws = a.ws(); const int lane = lane_id_(), tid = wid * 64 + lane; (void)tid;
        pg8::Gemm g{(const bf16*)(ws + WS_U2), (const bf16*)(ws + WS_BTDN), DFF, DFF, DFF}; pg8::StaticOrder S; S.init(MROWS, 2048, G, bx);
        EpiF32 E{(float*)(ws + WS_FF), 2048};
        pg8::gemm_phase<EpiF32, pg8::StaticOrder, true, true>(lds, g, S, E, wid);
    }
    SEAM(11);
    if (IN(12)) for (int rep_ = 0; rep_ < NREP(12); ++rep_) { if (rep_) { const PA ab = PA::get(); xcd_barrier((unsigned*)ab.ws() + CW_BAR, xcc, bst, wid * 64 + lane_id_(), (unsigned)G); }
        const PA a = PA::get(); unsigned char* ws = a.ws(); const int lane = lane_id_(), tid = wid * 64 + lane; (void)tid;
        const float* mod = (const float*)(ws + WS_MOD); const float* ng = a.in(I_NG); const float* FF = (const float*)(ws + WS_FF); const float* H = (const float*)(ws + WS_H);
        for (int row = gw; row < MROWS; row += NGW) {
            const f32x4* fr_ = (const f32x4*)(FF + (size_t)row * DM) + lane; const f32x4* hr = (const f32x4*)(H + (size_t)row * DM) + lane; const float* md = mod + (size_t)seq_of_row(row) * NADA;
            f32x4 v[8]; float ss = 0.f;
#pragma unroll
            for (int j = 0; j < 8; ++j) { v[j] = fr_[64 * j]; ss += (v[j][0] * v[j][0] + v[j][1] * v[j][1]) + (v[j][2] * v[j][2] + v[j][3] * v[j][3]); }
            const float r = rsqrtf(wave_sum(ss) * (1.f / DM) + EPS);
            f32x4* yo = (f32x4*)(a.out() + O_Y + (size_t)row * DM) + lane;
#pragma unroll
            for (int j = 0; j < 8; ++j) { const int c = 4 * lane + 256 * j; const f32x4 g = *(const f32x4*)(ng + 6144 + c), g2 = *(const f32x4*)(md + 10240 + c), h = hr[64 * j];
                f32x4 y; _Pragma("unroll") for (int e = 0; e < 4; ++e) y[e] = h[e] + g2[e] * (v[j][e] * r * g[e]);
                yo[64 * j] = y; }
        }
    }
#undef IN
#undef SEAM
}

constexpr int N_PHASES = 13;
extern "C" void kernel_launch(void* const* d_in, const int* in_sizes, int n_in, void* d_out, int out_size, void* d_ws, size_t ws_size, hipStream_t stream) {
    static int grid = 0;
    if (grid == 0) {
        if (n_in != 22 || (size_t)out_size != O_END || ws_size < WS_END) { fprintf(stderr, "kernel_launch: unexpected shapes: n_in %d out %d ws %zu\n", n_in, out_size, ws_size); grid = -1; return; }
        int dev = 0, cus = 0, per_cu = 0;
        if (hipGetDevice(&dev) != hipSuccess || hipDeviceGetAttribute(&cus, hipDeviceAttributeMultiprocessorCount, dev) != hipSuccess) { grid = -1; return; }
        if (hipFuncSetAttribute((const void*)fwd, hipFuncAttributeMaxDynamicSharedMemorySize, LDS_BYTES) != hipSuccess) { fprintf(stderr, "kernel_launch: hipFuncSetAttribute failed\n"); grid = -1; return; }
        if (hipOccupancyMaxActiveBlocksPerMultiprocessor(&per_cu, (const void*)fwd, NTHREADS, LDS_BYTES) != hipSuccess || per_cu < 1) { fprintf(stderr, "kernel_launch: occupancy query says %d\n", per_cu); (void)hipGetLastError(); per_cu = 1; }
        grid = cus;
    }
    if (grid < 0) return;
    if (hipMemsetAsync(d_ws, 0, CTL_ZERO_BYTES, stream) != hipSuccess) { fprintf(stderr, "kernel_launch: memset failed\n"); return; }
    Args a{};
    for (int i = 0; i < 22; ++i) a.in[i] = (const float*)d_in[i];
    a.out = (float*)d_out; a.ws = (unsigned char*)d_ws;
#ifdef MULTI_LAUNCH
    for (int p = 0; p < N_PHASES; ++p) { a.ph_lo = p; a.ph_hi = p + 1; hipLaunchKernelGGL(fwd, dim3(grid), dim3(NTHREADS), LDS_BYTES, stream, a); }
#else
    a.ph_lo = 0; a.ph_hi = N_PHASES;
    void* args[] = {&a};
    hipError_t e = hipLaunchCooperativeKernel((const void*)fwd, dim3(grid), dim3(NTHREADS), args, LDS_BYTES, stream);
    if (e != hipSuccess) fprintf(stderr, "cooperative launch failed: %s (grid %d)\n", hipGetErrorString(e), grid);
#endif
}
```

```cpp
#include <hip/hip_runtime.h>
#include <hip/hip_cooperative_groups.h>
#include <cstdio>
#include <cstdint>
namespace cg = cooperative_groups;
__device__ __forceinline__ int lane_id_() { int l; asm volatile("v_mbcnt_lo_u32_b32 %0, -1, 0\n\tv_mbcnt_hi_u32_b32 %0, -1, %0" : "=v"(l)); return l; }
namespace pg8 {
#define PG8_LAS __attribute__((address_space(3)))
typedef unsigned short bf16_t;
typedef short bf16x8 __attribute__((ext_vector_type(8)));
typedef float f32x4 __attribute__((ext_vector_type(4)));
typedef unsigned u32x4 __attribute__((ext_vector_type(4)));
constexpr int BM = 256, BK = 64, HALF = 128, HTB = HALF * BK * 2  , STAGE_BYTES = 8 * HTB, NXCD = 8, WGM = 8;

__host__ __device__ __forceinline__ int lds_byte(int r, int c) { const int st = (r >> 4) * 2 + (c >> 5), rr = r & 15, cc = c & 31, ob = rr * 64 + cc * 2; return st * 1024 + (ob ^ (((ob >> 9) & 1) << 5)); }
__host__ __device__ __forceinline__ void stage_rc(int b, int& R, int& C) { const int st = b / 1024, sb = b % 1024, swz = sb ^ (((sb >> 9) & 1) << 5); R = (st >> 1) * 16 + swz / 64; C = (st & 1) * 32 + (swz % 64) / 2; }
__host__ __device__ __forceinline__ int perm32(int rho) { const int n = rho >> 4, i = rho & 15; return 8 * (i >> 2) + 4 * n + (i & 3); }

struct Unit { int pm, pn, k0, nt, kind; };
struct Gemm { const bf16_t* A; const bf16_t* Bt; int lda, ldb, K; };

struct StaticOrder {
    int nM, nN, nwg, G, c, ntk;
    __host__ __device__ void init(int M, int N, int G_, int c_, int K_) { nM = M / BM; nN = N / BM; nwg = nM * nN; G = G_; c = c_; ntk = K_ / BK; }
    __host__ __device__ bool next(int i, Unit& u) const {
        const long L = (long)i * G + c; if (L >= nwg) return false;
        int wgid = (int)L; { const int q = nwg / NXCD, r = nwg % NXCD, xcd = wgid % NXCD, off = wgid / NXCD; wgid = (xcd < r ? xcd * (q + 1) : r * (q + 1) + (xcd - r) * q) + off; }
        const int nig = WGM * nN, gid = wgid / nig, fm = gid * WGM, gsz = (nM - fm) < WGM ? (nM - fm) : WGM;
        u.pm = fm + ((wgid % nig) % gsz); u.pn = (wgid % nig) / gsz; u.k0 = 0; u.nt = ntk; u.kind = 0; return true;
    }
    __device__ __forceinline__ void a_ready(const Unit&) const {}
    __device__ __forceinline__ void done(const Unit&) const {}
};

__device__ __forceinline__ unsigned cvt_pk_bf16(float lo, float hi) { unsigned r; asm volatile("v_cvt_pk_bf16_f32 %0, %1, %2" : "=v"(r) : "v"(lo), "v"(hi)); return r; }

template <class Epi, class Sched, bool ALIGN_EPI = false, bool SP2 = false>
__device__ __forceinline__ void gemm_phase(PG8_LAS unsigned char* lds, const Gemm g, const Sched& S, const Epi& E, int wid_in) {
    const int wid = wid_in, lane = lane_id_(), tid = wid * 64 + lane, wr = wid >> 2, wc = wid & 3, fr = lane & 15, fq = lane >> 4;
    unsigned voffA[2], voffB[2];
#pragma unroll
    for (int i = 0; i < 2; ++i) { int R, C; stage_rc(tid * 16 + i * 8192, R, C); const int Rb = Epi::PERM ? ((R & ~31) + perm32(R & 31)) : R;
        voffA[i] = (unsigned)(R * g.lda + C) * 2u; voffB[i] = (unsigned)(Rb * g.ldb + C) * 2u; }
    const size_t kstep = (size_t)(BK * 2);
    const size_t hstepA = (size_t)HALF * g.lda * 2, hstepB = (size_t)HALF * g.ldb * 2;
    const size_t tstepA = 2 * hstepA, tstepB = 2 * hstepB;
    const unsigned ldsw = (unsigned)wid * 1024u;
    const int aoff = lds_byte(wr * 64 + fr, fq * 8), boff = lds_byte(wc * 32 + fr, fq * 8);
#define PG8_SA(b, h) (((b) * 2 + (h)) * HTB)
#define PG8_SB(b, h) ((4 + (b) * 2 + (h)) * HTB)
#define PG8_STAGE(bufoff, gbase, voff) do { _Pragma("unroll") for (int _i = 0; _i < 2; ++_i) \
        __builtin_amdgcn_global_load_lds((const unsigned*)((const char*)(gbase) + (voff)[_i]), (PG8_LAS unsigned*)(lds + (bufoff) + ldsw + _i * 8192), 16, 0, 0); } while (0)
#define PG8_LDA(dst, b, h) do { _Pragma("unroll") for (int m = 0; m < 4; ++m) _Pragma("unroll") for (int k = 0; k < 2; ++k) dst[m][k] = *(const PG8_LAS bf16x8*)(lds + PG8_SA(b, h) + aoff + m * 2048 + k * 1024); } while (0)
#define PG8_LDB(dst, b, h) do { _Pragma("unroll") for (int n = 0; n < 2; ++n) _Pragma("unroll") for (int k = 0; k < 2; ++k) dst[n][k] = *(const PG8_LAS bf16x8*)(lds + PG8_SB(b, h) + boff + n * 2048 + k * 1024); } while (0)
#define PG8_MMA(ai, bj, At, Bt) do { __builtin_amdgcn_s_setprio(1); _Pragma("unroll") for (int m = 0; m < 4; ++m) _Pragma("unroll") for (int n = 0; n < 2; ++n) _Pragma("unroll") for (int k = 0; k < 2; ++k) \
        acc[ai][bj][m][n] = __builtin_amdgcn_mfma_f32_16x16x32_bf16(Bt[n][k], At[m][k], acc[ai][bj][m][n], 0, 0, 0); __builtin_amdgcn_s_setprio(0); } while (0)
#define PG8_WAIT_V(n) asm volatile("s_waitcnt vmcnt(" #n ")" ::: "memory")
#define PG8_WAIT_L(n) asm volatile("s_waitcnt lgkmcnt(" #n ")" ::: "memory")
#define PG8_BAR __builtin_amdgcn_s_barrier()
#define PG8_SCHED __builtin_amdgcn_sched_barrier(0)
    Unit cur, nxt; int ui = 0;
    if (!S.next(0, cur)) return;
    f32x4 acc[2][2][4][2];
#pragma unroll
    for (int a = 0; a < 2; ++a)
#pragma unroll
        for (int b = 0; b < 2; ++b)
#pragma unroll
            for (int m = 0; m < 4; ++m)
#pragma unroll
                for (int n = 0; n < 2; ++n) acc[a][b][m][n] = (f32x4){0.f, 0.f, 0.f, 0.f};
    bf16x8 At[4][2], B0[2][2], B1[2][2];
    const char* cA = (const char*)g.A + (size_t)cur.pm * tstepA + (size_t)cur.k0 * 2; const char* cB = (const char*)g.Bt + (size_t)cur.pn * tstepB + (size_t)cur.k0 * 2;
    S.a_ready(cur);
    if constexpr (SP2) {
        PG8_STAGE(PG8_SB(0, 0), cB, voffB); PG8_STAGE(PG8_SB(0, 1), cB + hstepB, voffB); PG8_STAGE(PG8_SA(0, 0), cA, voffA); PG8_STAGE(PG8_SA(0, 1), cA + hstepA, voffA);
        if (wr == 1) PG8_BAR;
        PG8_WAIT_V(2); PG8_BAR;
        PG8_STAGE(PG8_SB(1, 0), cB + kstep, voffB); PG8_STAGE(PG8_SA(1, 0), cA + kstep, voffA); PG8_STAGE(PG8_SB(1, 1), cB + hstepB + kstep, voffB);
        PG8_WAIT_V(6); PG8_BAR;
    } else {
        PG8_STAGE(PG8_SB(0, 0), cB, voffB); PG8_STAGE(PG8_SA(0, 0), cA, voffA); PG8_STAGE(PG8_SB(0, 1), cB + hstepB, voffB); PG8_STAGE(PG8_SA(0, 1), cA + hstepA, voffA);
        if (wr == 1) PG8_BAR;
        PG8_WAIT_V(4); PG8_BAR;
        PG8_STAGE(PG8_SB(1, 0), cB + kstep, voffB); PG8_STAGE(PG8_SA(1, 0), cA + kstep, voffA); PG8_STAGE(PG8_SB(1, 1), cB + hstepB + kstep, voffB);
        PG8_WAIT_V(6); PG8_BAR;
    }
    for (;;) {
        const bool has_next = S.next(ui + 1, nxt);
        const char* nA = has_next ? (const char*)g.A + (size_t)nxt.pm * tstepA + (size_t)nxt.k0 * 2 : cA; const char* nB = has_next ? (const char*)g.Bt + (size_t)nxt.pn * tstepB + (size_t)nxt.k0 * 2 : cB;
        const int nt = cur.nt;
        for (int t = 0; t < nt; t += 2) {
            const bool last = (t == nt - 2);
            const char* a1 = cA + (size_t)(t + 1) * kstep;
            const char* a2 = last ? nA : cA + (size_t)(t + 2) * kstep; const char* b2 = last ? nB : cB + (size_t)(t + 2) * kstep;
            const char* a3 = a2 + kstep; const char* b3 = b2 + kstep;
            if (last && has_next) S.a_ready(nxt);
            if constexpr (SP2) {
            PG8_LDB(B0, 0, 0); PG8_LDB(B1, 0, 1); PG8_SCHED; PG8_LDA(At, 0, 0); PG8_STAGE(PG8_SA(1, 1), a1 + hstepA, voffA);
            PG8_WAIT_V(8); PG8_WAIT_L(0); PG8_BAR; PG8_MMA(0, 0, At, B0); PG8_MMA(0, 1, At, B1); PG8_BAR; PG8_SCHED;
            PG8_LDA(At, 0, 1); PG8_STAGE(PG8_SB(0, 0), b2, voffB); PG8_STAGE(PG8_SB(0, 1), b2 + hstepB, voffB); PG8_STAGE(PG8_SA(0, 0), a2, voffA);
            PG8_WAIT_V(8); PG8_WAIT_L(0); PG8_BAR; PG8_MMA(1, 0, At, B0); PG8_MMA(1, 1, At, B1); PG8_BAR; PG8_SCHED;
            PG8_LDB(B0, 1, 0); PG8_LDB(B1, 1, 1); PG8_SCHED; PG8_LDA(At, 1, 0); PG8_STAGE(PG8_SA(0, 1), a2 + hstepA, voffA);
            PG8_WAIT_V(8); PG8_WAIT_L(0); PG8_BAR; PG8_MMA(0, 0, At, B0); PG8_MMA(0, 1, At, B1); PG8_BAR; PG8_SCHED;
            PG8_LDA(At, 1, 1); PG8_STAGE(PG8_SB(1, 0), b3, voffB); PG8_STAGE(PG8_SB(1, 1), b3 + hstepB, voffB); PG8_STAGE(PG8_SA(1, 0), a3, voffA);
            PG8_WAIT_V(8); PG8_WAIT_L(0); PG8_BAR; PG8_MMA(1, 0, At, B0); PG8_MMA(1, 1, At, B1); PG8_BAR; PG8_SCHED;
            } else {
            PG8_LDB(B0, 0, 0); PG8_SCHED; PG8_LDA(At, 0, 0); PG8_STAGE(PG8_SA(1, 1), a1 + hstepA, voffA);
            PG8_WAIT_L(8); PG8_BAR; PG8_WAIT_L(0); PG8_MMA(0, 0, At, B0); PG8_BAR; PG8_SCHED;
            PG8_LDB(B1, 0, 1); PG8_STAGE(PG8_SB(0, 0), b2, voffB);
            PG8_BAR; PG8_WAIT_L(0); PG8_MMA(0, 1, At, B1); PG8_BAR;
            PG8_LDA(At, 0, 1); PG8_STAGE(PG8_SA(0, 0), a2, voffA);
            PG8_BAR; PG8_WAIT_L(0); PG8_MMA(1, 0, At, B0); PG8_BAR; PG8_SCHED;
            PG8_STAGE(PG8_SB(0, 1), b2 + hstepB, voffB);
            PG8_WAIT_V(6); PG8_BAR; PG8_MMA(1, 1, At, B1); PG8_BAR;
            PG8_LDB(B0, 1, 0); PG8_SCHED; PG8_LDA(At, 1, 0); PG8_STAGE(PG8_SA(0, 1), a2 + hstepA, voffA);
            PG8_WAIT_L(8); PG8_BAR; PG8_WAIT_L(0); PG8_MMA(0, 0, At, B0); PG8_BAR; PG8_SCHED;
            PG8_LDB(B1, 1, 1); PG8_STAGE(PG8_SB(1, 0), b3, voffB);
            PG8_BAR; PG8_WAIT_L(0); PG8_MMA(0, 1, At, B1); PG8_BAR;
            PG8_LDA(At, 1, 1); PG8_STAGE(PG8_SA(1, 0), a3, voffA);
            PG8_BAR; PG8_WAIT_L(0); PG8_MMA(1, 0, At, B0); PG8_BAR; PG8_SCHED;
            PG8_STAGE(PG8_SB(1, 1), b3 + hstepB, voffB);
            PG8_WAIT_V(6); PG8_BAR; PG8_MMA(1, 1, At, B1); PG8_BAR;
            }
        }
        if constexpr (ALIGN_EPI) { if (wr == 0) PG8_BAR; }
        if constexpr (!Epi::AFTER_DRAIN) { E(acc, cur, wr, wc, fr, fq); S.done(cur); }
        if (!has_next) break;
#pragma unroll
        for (int a = 0; a < 2; ++a)
#pragma unroll
            for (int b = 0; b < 2; ++b)
#pragma unroll
                for (int m = 0; m < 4; ++m)
#pragma unroll
                    for (int n = 0; n < 2; ++n) acc[a][b][m][n] = (f32x4){0.f, 0.f, 0.f, 0.f};
        cur = nxt; cA = nA; cB = nB; ++ui;
        if constexpr (ALIGN_EPI) { if (wr == 1) PG8_BAR; }
    }
    PG8_WAIT_V(0);
    if constexpr (!ALIGN_EPI) { if (wr == 0) PG8_BAR; }
    PG8_BAR;
    if constexpr (Epi::AFTER_DRAIN) { E.fused(acc, cur, wr, wc, fr, fq, lds, wid, lane); S.done(cur); }
#undef PG8_SA
#undef PG8_SB
#undef PG8_STAGE
#undef PG8_LDA
#undef PG8_LDB
#undef PG8_MMA
#undef PG8_WAIT_V
#undef PG8_WAIT_L
#undef PG8_BAR
#undef PG8_SCHED
}
}


#define LAS __attribute__((address_space(3)))
typedef unsigned short bf16;
typedef float f32x4 __attribute__((ext_vector_type(4)));
typedef float f32x2 __attribute__((ext_vector_type(2)));
typedef short bf16x8 __attribute__((ext_vector_type(8)));
typedef unsigned u32x4 __attribute__((ext_vector_type(4)));
typedef unsigned u32x2 __attribute__((ext_vector_type(2)));

#ifndef REP_MASK
#define REP_MASK 0
#endif
#define NREP(k) (1 + ((REP_MASK >> (k)) & 1))
constexpr int NWAVES = 8, NTHREADS = 512;
constexpr int DM = 2048, MROWS = 8704, NPROMPT = 8192, NSEQ = 132, SEQ = 2048, DSEQ = 4;
constexpr int N_IN = 24640, N_INP = 24832, CONVCH = 8192, DFF = 8192, NADA = 12288;
constexpr float EPS = 1e-6f;
constexpr int LDS_BYTES = 147456;

enum { I_XP = 0, I_XS, I_SHG, I_SGD, I_CC, I_CP, I_CS, I_LB, I_WADA, I_BADA, I_NG, I_WIN, I_CW, I_ALOG, I_DTB, I_HGN, I_GDN, I_WOHG, I_WOGD, I_WO, I_WUP, I_WDN };
constexpr size_t O_Y = 0, O_HGP = 17825792, O_GDP = 18874368, O_CCP = 20971520, O_HGS = 21069824, O_GDS = 54624256, O_CCS = 121733120, O_END = 124878848;
constexpr size_t MiB = 1u << 20;
constexpr size_t WS_MOD = 1 * MiB, WS_BTOUT = 8 * MiB, WS_BTO = 32 * MiB, WS_BTUP = 40 * MiB, WS_BTDN = 72 * MiB, WS_BTIN = 104 * MiB, WS_A1 = 201 * MiB;
constexpr size_t WS_QHP = 235 * MiB, WS_FP = 267 * MiB, WS_IP = 331 * MiB, WS_UP = 363 * MiB, WS_GH = 491 * MiB, WS_GZ = 525 * MiB, WS_SA = 593 * MiB, WS_SB = 627 * MiB, WS_BL = 661 * MiB;
constexpr size_t WS_QHS = 664 * MiB, WS_FS = 666 * MiB, WS_IS = 670 * MiB, WS_US = 672 * MiB;
constexpr size_t WS_GREC = 680 * MiB, WS_HREC = 104 * MiB, WS_UCS = 218 * MiB, WS_O16 = 235 * MiB;
constexpr size_t WS_OA = 363 * MiB, WS_T1 = 680 * MiB, WS_MG = 748 * MiB, WS_MIX = 782 * MiB, WS_H = 850 * MiB, WS_U2 = 235 * MiB, WS_FF = 782 * MiB;
constexpr size_t WS_SLO = 465 * MiB, WS_SLW = 104 * MiB, WS_SLD = 465 * MiB;
constexpr size_t WS_END = 970 * MiB;

__device__ __forceinline__ unsigned f2bf(float f) { unsigned u = __float_as_uint(f); return (u + 0x7fffu + ((u >> 16) & 1u)) >> 16; }
typedef float f32x2c_t __attribute__((ext_vector_type(2))); typedef __bf16 bf16x2c_t __attribute__((ext_vector_type(2)));
__device__ __forceinline__ unsigned pk2(float lo, float hi) { f32x2c_t v = {lo, hi}; bf16x2c_t b = __builtin_convertvector(v, bf16x2c_t); return __builtin_bit_cast(unsigned, b); }
__device__ __forceinline__ float bf2f(unsigned h) { return __uint_as_float(h << 16); }
__device__ __forceinline__ float bflo(unsigned w) { return __uint_as_float(w << 16); }
__device__ __forceinline__ float bfhi(unsigned w) { return __uint_as_float(w & 0xffff0000u); }
__device__ __forceinline__ float sigmoidf_(float x) { return __builtin_amdgcn_rcpf(1.0f + __expf(-x)); }
__device__ __forceinline__ float siluf_(float x) { return x * sigmoidf_(x); }
__device__ __forceinline__ float wave_sum(float v) {
#pragma unroll
    for (int o = 1; o < 64; o <<= 1) v += __shfl_xor(v, o);
    return v;
}
__device__ __forceinline__ float wave_sum_sw(float v) {
    v += __builtin_bit_cast(float, __builtin_amdgcn_ds_swizzle(__builtin_bit_cast(int, v), (1 << 10) | 0x1f));
    v += __builtin_bit_cast(float, __builtin_amdgcn_ds_swizzle(__builtin_bit_cast(int, v), (2 << 10) | 0x1f));
    v += __builtin_bit_cast(float, __builtin_amdgcn_ds_swizzle(__builtin_bit_cast(int, v), (4 << 10) | 0x1f));
    v += __builtin_bit_cast(float, __builtin_amdgcn_ds_swizzle(__builtin_bit_cast(int, v), (8 << 10) | 0x1f));
    v += __builtin_bit_cast(float, __builtin_amdgcn_ds_swizzle(__builtin_bit_cast(int, v), (16 << 10) | 0x1f));
    return __builtin_bit_cast(float, __builtin_amdgcn_readlane(__builtin_bit_cast(int, v), 0)) + __builtin_bit_cast(float, __builtin_amdgcn_readlane(__builtin_bit_cast(int, v), 32));
}
#define LDS_WAIT() asm volatile("s_waitcnt lgkmcnt(0)" ::: "memory")

struct Args { const float* in[22]; float* out; unsigned char* ws; int ph_lo, ph_hi; };
typedef __attribute__((address_space(4))) const unsigned char* kargp_t;
struct PA {
    kargp_t kp;
    static __device__ __forceinline__ PA get() { PA p; p.kp = (kargp_t)__builtin_amdgcn_kernarg_segment_ptr(); asm volatile("" : "+s"(p.kp)); return p; }
    __device__ __forceinline__ const float* in(int i) const { typedef const float* cfp; return ((__attribute__((address_space(4))) const cfp*)kp)[i]; }
    __device__ __forceinline__ float* out() const { typedef float* fp; return *((__attribute__((address_space(4))) const fp*)(kp + 176)); }
    __device__ __forceinline__ unsigned char* ws() const { typedef unsigned char* up; return *((__attribute__((address_space(4))) const up*)(kp + 184)); }
    __device__ __forceinline__ int ph_lo() const { return *((__attribute__((address_space(4))) const int*)(kp + 192)); }
    __device__ __forceinline__ int ph_hi() const { return *((__attribute__((address_space(4))) const int*)(kp + 196)); }
};
static_assert(sizeof(Args) == 200, "Args layout");
__device__ __forceinline__ bool ph_in(int k) { const PA p = PA::get(); return p.ph_lo() <= k && k < p.ph_hi(); }

template <int MODE> __device__ __forceinline__ float actf(float v) {
    if (MODE == 1) return siluf_(v);
    if (MODE == 2) return sigmoidf_(v);
    if (MODE == 3) { const float r = fmaxf(v, 0.f); return r * r; }
    return v;
}
template <int MODE> __device__ __forceinline__ void tile_store_bf16(const f32x4 (&acc)[2][2][4][2], bf16* base, int ld, int row0, int col0) {
#pragma unroll
    for (int ai = 0; ai < 2; ++ai)
#pragma unroll
        for (int m = 0; m < 4; ++m) {
            bf16* rowp = base + (size_t)(row0 + ai * 128 + m * 16) * ld + col0;
#pragma unroll
            for (int bj = 0; bj < 2; ++bj) {
                const f32x4 v0 = acc[ai][bj][m][0], v1 = acc[ai][bj][m][1];
                u32x4 w;
                w.x = pk2(actf<MODE>(v0[0]), actf<MODE>(v0[1])); w.y = pk2(actf<MODE>(v0[2]), actf<MODE>(v0[3]));
                w.z = pk2(actf<MODE>(v1[0]), actf<MODE>(v1[1])); w.w = pk2(actf<MODE>(v1[2]), actf<MODE>(v1[3]));
                *(u32x4*)(rowp + bj * 128) = w;
            }
        }
}
__device__ __forceinline__ void tile_store_f32(const f32x4 (&acc)[2][2][4][2], float* base, int ld, int row0, int col0) {
#pragma unroll
    for (int ai = 0; ai < 2; ++ai)
#pragma unroll
        for (int m = 0; m < 4; ++m) {
            float* rowp = base + (size_t)(row0 + ai * 128 + m * 16) * ld + col0;
#pragma unroll
            for (int bj = 0; bj < 2; ++bj) { *(f32x4*)(rowp + bj * 128) = acc[ai][bj][m][0]; *(f32x4*)(rowp + bj * 128 + 4) = acc[ai][bj][m][1]; }
        }
}

struct EpiIn {
    static constexpr bool PERM = true, AFTER_DRAIN = false;
    unsigned char* ws; const float *lbl, *alog, *dtb;
    __device__ __forceinline__ void operator()(const f32x4 (&acc)[2][2][4][2], const pg8::Unit& u, int wr, int wc, int fr, int fq) const {
        const int pn = u.pn, row0 = u.pm * 256 + wr * 64 + fr, cl = wc * 32 + 8 * fq;
        const bool smp = u.pm >= 32; const int rowq = smp ? row0 - NPROMPT : row0;
        if (pn >= 8 && pn < 16) {
            const int c0 = (pn - 8) * 256 + cl;
            float lb[2][8];
#pragma unroll
            for (int bj = 0; bj < 2; ++bj)
#pragma unroll
                for (int j = 0; j < 8; ++j) { const int c = c0 + bj * 128 + j; lb[bj][j] = sigmoidf_(lbl[c] - lbl[2048 + c]); }
#pragma unroll
            for (int ai = 0; ai < 2; ++ai)
#pragma unroll
                for (int m = 0; m < 4; ++m) {
                    float* rowp = (float*)(ws + (smp ? WS_FS : WS_FP)) + (size_t)(rowq + ai * 128 + m * 16) * 2048 + c0;
#pragma unroll
                    for (int bj = 0; bj < 2; ++bj) {
                        const f32x4 v0 = acc[ai][bj][m][0], v1 = acc[ai][bj][m][1]; f32x4 o0, o1;
#pragma unroll
                        for (int j = 0; j < 4; ++j) { o0[j] = lb[bj][j] + (1.f - lb[bj][j]) * sigmoidf_(v0[j]); o1[j] = lb[bj][4 + j] + (1.f - lb[bj][4 + j]) * sigmoidf_(v1[j]); }
                        *(f32x4*)(rowp + bj * 128) = o0; *(f32x4*)(rowp + bj * 128 + 4) = o1;
                    }
                }
            return;
        }
        if (pn == 96) {
            if (wc < 2) {
#pragma unroll
                for (int ai = 0; ai < 2; ++ai)
#pragma unroll
                    for (int m = 0; m < 4; ++m) {
                        float* rowp = (float*)(ws + WS_BL) + (size_t)(row0 + ai * 128 + m * 16) * 64 + cl;
                        const f32x4 v0 = acc[ai][0][m][0], v1 = acc[ai][0][m][1]; f32x4 o0, o1;
#pragma unroll
                        for (int j = 0; j < 4; ++j) {
                            if (wc == 0) { o0[j] = sigmoidf_(v0[j]); o1[j] = sigmoidf_(v1[j]); }
                            else { const int h0 = 8 * fq + j, h1 = 8 * fq + 4 + j; const float x0 = v0[j] + dtb[h0], x1 = v1[j] + dtb[h1];
                                   o0[j] = -expf(alog[h0]) * (fmaxf(x0, 0.f) + log1pf(expf(-fabsf(x0)))); o1[j] = -expf(alog[h1]) * (fmaxf(x1, 0.f) + log1pf(expf(-fabsf(x1)))); }
                        }
                        *(f32x4*)(rowp) = o0; *(f32x4*)(rowp + 4) = o1;
                    }
            }
            return;
        }
        size_t boff; int ld, c0, mode, rowb = row0;
        if (pn < 8)       { boff = smp ? WS_QHS : WS_QHP; ld = 2048; c0 = pn * 256; mode = 1; rowb = rowq; }
        else if (pn < 24) { boff = smp ? WS_IS : WS_IP;   ld = 2048; c0 = (pn - 16) * 256; mode = 0; rowb = rowq; }
        else if (pn < 32) { boff = WS_GH; ld = 2048; c0 = (pn - 24) * 256; mode = 1; }
        else if (pn < 64) { boff = smp ? WS_US : WS_UP;   ld = 8192; c0 = (pn - 32) * 256; mode = 0; rowb = rowq; }
        else if (pn < 80) { boff = WS_GZ; ld = 4096; c0 = (pn - 64) * 256; mode = 1; }
        else if (pn < 88) { boff = WS_SA; ld = 2048; c0 = (pn - 80) * 256; mode = 2; }
        else              { boff = WS_SB; ld = 2048; c0 = (pn - 88) * 256; mode = 2; }
        bf16* base = (bf16*)(ws + boff);
        if (mode == 0) tile_store_bf16<0>(acc, base, ld, rowb, c0 + cl);
        else if (mode == 1) tile_store_bf16<1>(acc, base, ld, rowb, c0 + cl);
        else tile_store_bf16<2>(acc, base, ld, rowb, c0 + cl);
    }
};
struct EpiOut1 {
    static constexpr bool PERM = true, AFTER_DRAIN = false;
    float* T1; const bf16* SA;
    __device__ __forceinline__ void operator()(const f32x4 (&acc)[2][2][4][2], const pg8::Unit& u, int wr, int wc, int fr, int fq) const {
        const int row0 = u.pm * 256 + wr * 64 + fr, c0 = u.pn * 256 + wc * 32 + 8 * fq;
#pragma unroll
        for (int ai = 0; ai < 2; ++ai)
#pragma unroll
            for (int m = 0; m < 4; ++m) {
                const size_t ro = (size_t)(row0 + ai * 128 + m * 16) * 2048 + c0;
#pragma unroll
                for (int bj = 0; bj < 2; ++bj) {
                    const u32x4 s = *(const u32x4*)(SA + ro + bj * 128);
                    const f32x4 v0 = acc[ai][bj][m][0], v1 = acc[ai][bj][m][1];
                    f32x4 o0 = {v0[0] * bflo(s.x), v0[1] * bfhi(s.x), v0[2] * bflo(s.y), v0[3] * bfhi(s.y)};
                    f32x4 o1 = {v1[0] * bflo(s.z), v1[1] * bfhi(s.z), v1[2] * bflo(s.w), v1[3] * bfhi(s.w)};
                    *(f32x4*)(T1 + ro + bj * 128) = o0; *(f32x4*)(T1 + ro + bj * 128 + 4) = o1;
                }
            }
    }
};
struct EpiOut2 {
    static constexpr bool PERM = true, AFTER_DRAIN = false;
    const float* T1; const bf16* SB; bf16* MG;
    __device__ __forceinline__ void operator()(const f32x4 (&acc)[2][2][4][2], const pg8::Unit& u, int wr, int wc, int fr, int fq) const {
        const int row0 = u.pm * 256 + wr * 64 + fr, c0 = u.pn * 256 + wc * 32 + 8 * fq;
#pragma unroll
        for (int ai = 0; ai < 2; ++ai)
#pragma unroll
            for (int m = 0; m < 4; ++m) {
                const size_t ro = (size_t)(row0 + ai * 128 + m * 16) * 2048 + c0;
#pragma unroll
                for (int bj = 0; bj < 2; ++bj) {
                    const u32x4 s = *(const u32x4*)(SB + ro + bj * 128);
                    const f32x4 t0 = *(const f32x4*)(T1 + ro + bj * 128), t1 = *(const f32x4*)(T1 + ro + bj * 128 + 4);
                    const f32x4 v0 = acc[ai][bj][m][0], v1 = acc[ai][bj][m][1];
                    u32x4 w;
                    w.x = pk2(t0[0] + v0[0] * bflo(s.x), t0[1] + v0[1] * bfhi(s.x)); w.y = pk2(t0[2] + v0[2] * bflo(s.y), t0[3] + v0[3] * bfhi(s.y));
                    w.z = pk2(t1[0] + v1[0] * bflo(s.z), t1[1] + v1[1] * bfhi(s.z)); w.w = pk2(t1[2] + v1[2] * bflo(s.w), t1[3] + v1[3] * bfhi(s.w));
                    *(u32x4*)(MG + ro + bj * 128) = w;
                }
            }
    }
};
struct EpiF32 {
    static constexpr bool PERM = true, AFTER_DRAIN = false;
    float* O; int ld;
    __device__ __forceinline__ void operator()(const f32x4 (&acc)[2][2][4][2], const pg8::Unit& u, int wr, int wc, int fr, int fq) const {
        tile_store_f32(acc, O, ld, u.pm * 256 + wr * 64 + fr, u.pn * 256 + wc * 32 + 8 * fq);
    }
};
struct EpiRelu2 {
    static constexpr bool PERM = true, AFTER_DRAIN = false;
    bf16* O; int ld;
    __device__ __forceinline__ void operator()(const f32x4 (&acc)[2][2][4][2], const pg8::Unit& u, int wr, int wc, int fr, int fq) const {
        tile_store_bf16<3>(acc, O, ld, u.pm * 256 + wr * 64 + fr, u.pn * 256 + wc * 32 + 8 * fq);
    }
};

struct TailOrder {
    pg8::StaticOrder so; int c, npass, k0a, nta, k0b, ntb;
    __device__ __forceinline__ void init(int G_, int c_, int npass_, int k0a_, int nta_, int k0b_, int ntb_) { so.init(NPROMPT, 2048, G_, c_, 2048); c = c_; npass = npass_; k0a = k0a_; nta = nta_; k0b = k0b_; ntb = ntb_; }
    __device__ __forceinline__ bool next(int i, pg8::Unit& u) const {
        if (i < npass) { so.next(0, u); u.k0 = i ? k0b : k0a; u.nt = i ? ntb : nta; u.kind = i; return true; }
        const int j = i - npass; if (j >= npass) return false;
        const int tile = c & 15, sl = c >> 4, nts = (j ? ntb : nta) >> 4;
        u.pm = 32 + (tile >> 3); u.pn = tile & 7; u.nt = nts; u.k0 = (j ? k0b : k0a) + sl * nts * 64; u.kind = (2 + j) | (sl << 8); return true;
    }
    __device__ __forceinline__ void a_ready(const pg8::Unit&) const {}
    __device__ __forceinline__ void done(const pg8::Unit&) const {}
};
struct EpiOutC {
    static constexpr bool PERM = true, AFTER_DRAIN = false;
    float* T1; const bf16* SA; const bf16* SB; bf16* MG; float* SL;
    __device__ __forceinline__ void operator()(const f32x4 (&acc)[2][2][4][2], const pg8::Unit& u, int wr, int wc, int fr, int fq) const {
        const int kind = u.kind & 255, sl = u.kind >> 8, row0 = u.pm * 256 + wr * 64 + fr, c0 = u.pn * 256 + wc * 32 + 8 * fq;
        const bf16* GT = (kind & 1) ? SB : SA;
        float* slab = SL + (size_t)(((kind & 1) * 16 + sl) * 512) * 2048;
#pragma unroll
        for (int ai = 0; ai < 2; ++ai)
#pragma unroll
            for (int m = 0; m < 4; ++m) {
                const int row = row0 + ai * 128 + m * 16; const size_t ro = (size_t)row * 2048 + c0;
#pragma unroll
                for (int bj = 0; bj < 2; ++bj) {
                    const u32x4 g = *(const u32x4*)(GT + ro + bj * 128);
                    const f32x4 v0 = acc[ai][bj][m][0], v1 = acc[ai][bj][m][1];
                    f32x4 o0 = {v0[0] * bflo(g.x), v0[1] * bfhi(g.x), v0[2] * bflo(g.y), v0[3] * bfhi(g.y)};
                    f32x4 o1 = {v1[0] * bflo(g.z), v1[1] * bfhi(g.z), v1[2] * bflo(g.w), v1[3] * bfhi(g.w)};
                    if (kind == 0) { *(f32x4*)(T1 + ro + bj * 128) = o0; *(f32x4*)(T1 + ro + bj * 128 + 4) = o1; }
                    else if (kind == 1) { const f32x4 t0 = *(const f32x4*)(T1 + ro + bj * 128), t1 = *(const f32x4*)(T1 + ro + bj * 128 + 4);
                        *(u32x4*)(MG + ro + bj * 128) = (u32x4){pk2(t0[0] + o0[0], t0[1] + o0[1]), pk2(t0[2] + o0[2], t0[3] + o0[3]), pk2(t1[0] + o1[0], t1[1] + o1[1]), pk2(t1[2] + o1[2], t1[3] + o1[3])}; }
                    else { float* d = slab + (size_t)(row - NPROMPT) * 2048 + c0 + bj * 128; *(f32x4*)d = o0; *(f32x4*)(d + 4) = o1; }
                }
            }
    }
};
struct EpiF32S {
    static constexpr bool PERM = true, AFTER_DRAIN = false;
    float* O; float* SL;
    __device__ __forceinline__ void operator()(const f32x4 (&acc)[2][2][4][2], const pg8::Unit& u, int wr, int wc, int fr, int fq) const {
        const int kind = u.kind & 255, sl = u.kind >> 8, row0 = u.pm * 256 + wr * 64 + fr, c0 = u.pn * 256 + wc * 32 + 8 * fq;
        if (kind == 0) tile_store_f32(acc, O, 2048, row0, c0);
        else tile_store_f32(acc, SL + (size_t)(sl * 512) * 2048, 2048, row0 - NPROMPT, c0);
    }
};

__device__ __forceinline__ void transpose_item(const float* W, int N, bf16* WT, int ldk, int k0, int n0, int nrow0, LAS float* scr, int lane) {
#pragma unroll 8
    for (int i = 0; i < 32; ++i) { const int kk = 2 * i + (lane >> 5); scr[kk * 33 + (lane & 31)] = W[(size_t)(k0 + kk) * N + n0 + (lane & 31)]; }
    LDS_WAIT(); asm volatile("" ::: "memory");
    const int c = lane & 7;
#pragma unroll
    for (int j = 0; j < 4; ++j) { const int n = (lane >> 3) + 8 * j; const LAS float* s = scr + (8 * c) * 33 + n;
        u32x4 o; o.x = pk2(s[0 * 33], s[1 * 33]); o.y = pk2(s[2 * 33], s[3 * 33]); o.z = pk2(s[4 * 33], s[5 * 33]); o.w = pk2(s[6 * 33], s[7 * 33]);
        *(u32x4*)(WT + (size_t)(nrow0 + n) * ldk + k0 + 8 * c) = o; }
    LDS_WAIT(); asm volatile("" ::: "memory");
}
__device__ __forceinline__ void mod_item(const PA& a, LAS unsigned char* lds, int cb, int tid, int wid, int lane) {
    constexpr int AST = 264;
    LAS bf16* As = (LAS bf16*)lds;
    const float* cp = a.in(I_CP); const float* cs = a.in(I_CS); const float* W = a.in(I_WADA); const float* bada = a.in(I_BADA);
    float* mod = (float*)(a.ws() + WS_MOD);
    const int nt = wid & 3, mh = wid >> 2, fr = lane & 15, fq = lane >> 4, n = cb * 64 + nt * 16 + fr;
    f32x4 acc[5];
#pragma unroll
    for (int i = 0; i < 5; ++i) acc[i] = (f32x4){0.f, 0.f, 0.f, 0.f};
    for (int kc = 0; kc < 8; ++kc) {
        __syncthreads();
        for (int e = tid; e < 144 * 64; e += NTHREADS) {
            const int s = e >> 6, q = e & 63; u32x2 w = {0u, 0u};
            if (s < NSEQ) { const float* src = (s < 4 ? cp + (size_t)s * 2048 : cs + (size_t)(s - 4) * 2048) + kc * 256 + q * 4; const f32x4 x = *(const f32x4*)src;
                w.x = pk2(siluf_(x[0]), siluf_(x[1])); w.y = pk2(siluf_(x[2]), siluf_(x[3])); }
            *(LAS u32x2*)(As + s * AST + q * 4) = w;
        }
        __syncthreads();
#pragma unroll 2
        for (int ks = 0; ks < 8; ++ks) {
            const int k0 = kc * 256 + ks * 32 + 8 * fq;
            bf16x8 b;
#pragma unroll
            for (int j = 0; j < 8; ++j) b[j] = (short)f2bf(W[(size_t)(k0 + j) * NADA + n]);
#pragma unroll
            for (int i = 0; i < 5; ++i) {
                const int mt = mh * 5 + i;
                if (mt < 9) { const bf16x8 av = *(const LAS bf16x8*)(As + (mt * 16 + fr) * AST + ks * 32 + 8 * fq);
                    acc[i] = __builtin_amdgcn_mfma_f32_16x16x32_bf16(av, b, acc[i], 0, 0, 0); }
            }
        }
    }
    const float bb = bada[n];
#pragma unroll
    for (int i = 0; i < 5; ++i)
#pragma unroll
        for (int r = 0; r < 4; ++r) { const int s = (mh * 5 + i) * 16 + 4 * fq + r; if (s < NSEQ) mod[(size_t)s * NADA + n] = acc[i][r] + bb; }
}

__device__ __forceinline__ const float* xrow_ptr(const PA& a, int row) { return row < NPROMPT ? a.in(I_XP) + (size_t)row * DM : a.in(I_XS) + (size_t)(row - NPROMPT) * DM; }
__device__ __forceinline__ int seq_of_row(int row) { return row < NPROMPT ? (row >> 11) : 4 + ((row - NPROMPT) >> 2); }

__device__ __forceinline__ float ldg_agent(const float* p) { return __hip_atomic_load(p, __ATOMIC_RELAXED, __HIP_MEMORY_SCOPE_AGENT); }
__device__ __forceinline__ float xhalf_sum(float v) { return v + __shfl_xor(v, 32); }
__device__ __forceinline__ void hgrn_item(const PA& a, LAS float* wl, int b, int h, int quarter, int lane, float (&S)[64]) {
    const bf16* Qh = (const bf16*)(a.ws() + WS_QHS); const float* F = (const float*)(a.ws() + WS_FS); const bf16* Ih = (const bf16*)(a.ws() + WS_IS);
    bf16* O16 = (bf16*)(a.ws() + WS_O16);
    const int c = lane & 31, hh = lane >> 5, dv = quarter * 32 + c;
    const unsigned sidx = (unsigned)((b * 16 + h) * 128 + 64 * hh) * 128u + dv;
    LAS float* qs = wl; LAS float* fs = wl + 128;
#pragma unroll 1
    for (int t = 0; t < DSEQ; ++t) {
        const unsigned ro = (unsigned)(b * DSEQ + t) * 2048u + h * 128;
        const float q0 = bf2f(Qh[ro + lane]), q1 = bf2f(Qh[ro + 64 + lane]), f0 = F[ro + lane], f1 = F[ro + 64 + lane], iv = bf2f(Ih[ro + dv]);
        qs[lane] = q0; qs[64 + lane] = q1; fs[lane] = f0; fs[64 + lane] = f1;
        float o0 = 0.f, o1 = 0.f, o2 = 0.f, o3 = 0.f;
#pragma unroll
        for (int j4 = 0; j4 < 16; ++j4) {
            const f32x4 q4 = *(const LAS f32x4*)(qs + 64 * hh + 4 * j4), f4 = *(const LAS f32x4*)(fs + 64 * hh + 4 * j4);
            S[4 * j4 + 0] = fmaf(f4[0], S[4 * j4 + 0] - iv, iv); o0 = fmaf(q4[0], S[4 * j4 + 0], o0);
            S[4 * j4 + 1] = fmaf(f4[1], S[4 * j4 + 1] - iv, iv); o1 = fmaf(q4[1], S[4 * j4 + 1], o1);
            S[4 * j4 + 2] = fmaf(f4[2], S[4 * j4 + 2] - iv, iv); o2 = fmaf(q4[2], S[4 * j4 + 2], o2);
            S[4 * j4 + 3] = fmaf(f4[3], S[4 * j4 + 3] - iv, iv); o3 = fmaf(q4[3], S[4 * j4 + 3], o3);
        }
        const float o = xhalf_sum((o0 + o1) + (o2 + o3));
        if (hh == 0) O16[(unsigned)(NPROMPT + b * DSEQ + t) * 6144u + h * 128 + dv] = (bf16)(pk2(o, 0.f) & 0xffffu);
    }
    float* so = a.out() + O_HGS + sidx;
#pragma unroll
    for (int j = 0; j < 64; ++j) so[j * 128] = S[j];
}
__device__ __forceinline__ void gdn_item(const PA& a, LAS float* wl, int b, int vh, int quarter, int lane, float (&S)[64]) {
    const bf16* UC = (const bf16*)(a.ws() + WS_UCS); const float* BL = (const float*)(a.ws() + WS_BL);
    bf16* O16 = (bf16*)(a.ws() + WS_O16);
    const int c = lane & 31, hh = lane >> 5, dv = quarter * 32 + c, qh = vh >> 1;
    const unsigned sidx = (unsigned)((b * 32 + vh) * 128 + 64 * hh) * 128u + dv;
    LAS float* qs = wl; LAS float* ks = wl + 128;
#pragma unroll 1
    for (int t = 0; t < DSEQ; ++t) {
        const unsigned ro = (unsigned)(b * DSEQ + t) * 8192u + qh * 128, rv = (unsigned)(b * DSEQ + t) * 8192u + 4096 + vh * 128, rb = (unsigned)(NPROMPT + b * DSEQ + t) * 64u + vh;
        const float q0 = bf2f(UC[ro + lane]), q1 = bf2f(UC[ro + 64 + lane]), k0 = bf2f(UC[ro + 2048 + lane]), k1 = bf2f(UC[ro + 2048 + 64 + lane]), vv = bf2f(UC[rv + dv]);
        const float beta = ldg_agent(BL + rb), al = __expf(ldg_agent(BL + rb + 32));
        qs[lane] = q0; qs[64 + lane] = q1; ks[lane] = k0; ks[64 + lane] = k1;
        const float qk = wave_sum_sw(q0 * k0 + q1 * k1);
        float c0 = 0.f, c1 = 0.f, c2 = 0.f, c3 = 0.f, o0 = 0.f, o1 = 0.f, o2 = 0.f, o3 = 0.f;
#pragma unroll
        for (int j4 = 0; j4 < 16; ++j4) {
            const f32x4 k4 = *(const LAS f32x4*)(ks + 64 * hh + 4 * j4), q4 = *(const LAS f32x4*)(qs + 64 * hh + 4 * j4);
            c0 = fmaf(k4[0], S[4 * j4 + 0], c0); c1 = fmaf(k4[1], S[4 * j4 + 1], c1); c2 = fmaf(k4[2], S[4 * j4 + 2], c2); c3 = fmaf(k4[3], S[4 * j4 + 3], c3);
            o0 = fmaf(q4[0], S[4 * j4 + 0], o0); o1 = fmaf(q4[1], S[4 * j4 + 1], o1); o2 = fmaf(q4[2], S[4 * j4 + 2], o2); o3 = fmaf(q4[3], S[4 * j4 + 3], o3);
        }
        const float kS = xhalf_sum((c0 + c1) + (c2 + c3)), qS = xhalf_sum((o0 + o1) + (o2 + o3));
        const float dlt = beta * (vv - al * kS);
#pragma unroll
        for (int j4 = 0; j4 < 16; ++j4) {
            const f32x4 k4 = *(const LAS f32x4*)(ks + 64 * hh + 4 * j4);
            S[4 * j4 + 0] = fmaf(k4[0], dlt, al * S[4 * j4 + 0]); S[4 * j4 + 1] = fmaf(k4[1], dlt, al * S[4 * j4 + 1]);
            S[4 * j4 + 2] = fmaf(k4[2], dlt, al * S[4 * j4 + 2]); S[4 * j4 + 3] = fmaf(k4[3], dlt, al * S[4 * j4 + 3]);
        }
        if (hh == 0) O16[(unsigned)(NPROMPT + b * DSEQ + t) * 6144u + 2048 + vh * 128 + dv] = (bf16)(pk2(fmaf(al, qS, qk * dlt), 0.f) & 0xffffu);
    }
    float* so = a.out() + O_GDS + sidx;
#pragma unroll
    for (int j = 0; j < 64; ++j) so[j * 128] = S[j];
}

typedef float f32x16 __attribute__((ext_vector_type(16)));
typedef float f32x2_t __attribute__((ext_vector_type(2))); typedef __bf16 bf16x2_t __attribute__((ext_vector_type(2)));
#define MFMA32(a, b, c) __builtin_amdgcn_mfma_f32_32x32x16_bf16((a), (b), (c), 0, 0, 0)
__device__ __forceinline__ unsigned cvtpk(float lo, float hi) { f32x2_t v = {lo, hi}; bf16x2_t b = __builtin_convertvector(v, bf16x2_t); return __builtin_bit_cast(unsigned, b); }
__device__ __forceinline__ int crow_(int i, int h) { return (i & 3) + 8 * (i >> 2) + 4 * h; }
template <int S> __device__ __forceinline__ bf16x8 pack_acc(const f32x16& x) {
    u32x4 p; p.x = cvtpk(x[8 * S + 0], x[8 * S + 1]); p.y = cvtpk(x[8 * S + 2], x[8 * S + 3]); p.z = cvtpk(x[8 * S + 4], x[8 * S + 5]); p.w = cvtpk(x[8 * S + 6], x[8 * S + 7]);
    return __builtin_bit_cast(bf16x8, p);
}
__device__ __forceinline__ u32x4 afrag_rows(const LAS bf16* img, int stride, int row, int kt, int h) {
    const LAS u32x2* p = (const LAS u32x2*)(img + row * stride + 16 * kt + 4 * h);
    const u32x2 lo = p[0], hi = p[2];
    return (u32x4){lo.x, lo.y, hi.x, hi.y};
}
__device__ __forceinline__ u32x4 afrag_rows_scaled(const LAS bf16* img, int stride, int row, int kt, int h, float sc) {
    const u32x4 w = afrag_rows(img, stride, row, kt, h);
    return (u32x4){cvtpk(bflo(w.x) * sc, bfhi(w.x) * sc), cvtpk(bflo(w.y) * sc, bfhi(w.y) * sc), cvtpk(bflo(w.z) * sc, bfhi(w.z) * sc), cvtpk(bflo(w.w) * sc, bfhi(w.w) * sc)};
}
__device__ __forceinline__ int kidx_(int kt, int h, int j) { return 16 * kt + 8 * (j >> 2) + 4 * h + (j & 3); }

constexpr int GREC_BYTES = 73984;
constexpr int GR_W = 0, GR_Q = 16384, GR_K = 32768, GR_A = 49152, GR_U = 57344, GR_DEC = 73728, GR_IMG = 57344;
constexpr int HREC_BYTES = 57856;
constexpr int HR_Q = 0, HR_K = 16384, HR_A = 32768, HR_I = 40960, HR_DEC = 57344, HR_IMG = 57856;

constexpr int GP_QS = 0, GP_KS = 17408, GP_VS = 34816, GP_BG = 69632, GP_KK = 73728, GP_QK = 90368, GP_AS = 107008, GP_XL = 0, GP_ATT = 73728;
constexpr int GP_ST = 136, GP_XST = 264, GP_AST = 68, GP_KST = 65, GP_TST = 72;
__device__ __forceinline__ void gdn_prep_unit(const PA& a, LAS unsigned char* lds, int u, int tid, int wid, int lane) {
    asm volatile("" : "+v"(tid), "+v"(lane));
    unsigned char* ws = a.ws();
    const int b = u >> 9, qh = (u >> 5) & 15, c = u & 31;
    const bf16* UP = (const bf16*)(ws + WS_UP); const float* BL = (const float*)(ws + WS_BL); const float* cw = a.in(I_CW);
    LAS bf16* QS = (LAS bf16*)(lds + GP_QS); LAS bf16* KS = (LAS bf16*)(lds + GP_KS); LAS bf16* VS = (LAS bf16*)(lds + GP_VS);
    LAS float* BG = (LAS float*)(lds + GP_BG);
    LAS float* KKs = (LAS float*)(lds + GP_KK); LAS float* QKs = (LAS float*)(lds + GP_QK); LAS float* AS = (LAS float*)(lds + GP_AS);
    LAS bf16* XL = (LAS bf16*)(lds + GP_XL); LAS bf16* ATT = (LAS bf16*)(lds + GP_ATT);
    const int row0 = b * SEQ + c * 64;
    unsigned char* rec0 = ws + WS_GREC + (size_t)((b * 32 + 2 * qh) * 32 + c) * GREC_BYTES;
    for (int r0_ = 0; r0_ < NREP(20); ++r0_) {
        const int cg = tid & 31, rb = tid >> 5, t0 = 4 * rb;
        const int ch0 = cg < 8 ? qh * 128 + cg * 16 : (cg < 16 ? 2048 + qh * 128 + (cg - 8) * 16 : 4096 + (2 * qh) * 128 + (cg - 16) * 16);
        f32x4 wt[4][4];
#pragma unroll
        for (int j = 0; j < 4; ++j) { const f32x4* wp = (const f32x4*)(cw + (size_t)j * CONVCH + ch0); wt[j][0] = wp[0]; wt[j][1] = wp[1]; wt[j][2] = wp[2]; wt[j][3] = wp[3]; }
        u32x4 rw[7][2];
#pragma unroll
        for (int q = 0; q < 7; ++q) {
            if (c * 64 + t0 - 3 + q >= 0) { const u32x4* src = (const u32x4*)(UP + (size_t)(row0 + t0 - 3 + q) * CONVCH + ch0); rw[q][0] = src[0]; rw[q][1] = src[1]; }
            else { rw[q][0] = (u32x4){0u, 0u, 0u, 0u}; rw[q][1] = (u32x4){0u, 0u, 0u, 0u}; }
        }
#pragma unroll
        for (int i = 0; i < 4; ++i) {
            float x[16];
#pragma unroll
            for (int e = 0; e < 16; ++e) x[e] = 0.f;
#pragma unroll
            for (int j = 0; j < 4; ++j) {
                const u32x4 w0 = rw[i + j][0], w1 = rw[i + j][1];
                x[0] = fmaf(wt[j][0][0], bflo(w0.x), x[0]); x[1] = fmaf(wt[j][0][1], bfhi(w0.x), x[1]); x[2] = fmaf(wt[j][0][2], bflo(w0.y), x[2]); x[3] = fmaf(wt[j][0][3], bfhi(w0.y), x[3]);
                x[4] = fmaf(wt[j][1][0], bflo(w0.z), x[4]); x[5] = fmaf(wt[j][1][1], bfhi(w0.z), x[5]); x[6] = fmaf(wt[j][1][2], bflo(w0.w), x[6]); x[7] = fmaf(wt[j][1][3], bfhi(w0.w), x[7]);
                x[8] = fmaf(wt[j][2][0], bflo(w1.x), x[8]); x[9] = fmaf(wt[j][2][1], bfhi(w1.x), x[9]); x[10] = fmaf(wt[j][2][2], bflo(w1.y), x[10]); x[11] = fmaf(wt[j][2][3], bfhi(w1.y), x[11]);
                x[12] = fmaf(wt[j][3][0], bflo(w1.z), x[12]); x[13] = fmaf(wt[j][3][1], bfhi(w1.z), x[13]); x[14] = fmaf(wt[j][3][2], bflo(w1.w), x[14]); x[15] = fmaf(wt[j][3][3], bfhi(w1.w), x[15]);
            }
            float ss = 0.f;
#pragma unroll
            for (int e = 0; e < 16; ++e) { x[e] = siluf_(x[e]); ss = fmaf(x[e], x[e], ss); }
            ss += __shfl_xor(ss, 1); ss += __shfl_xor(ss, 2); ss += __shfl_xor(ss, 4);
            float r = 1.f;
            if (cg < 16) { r = rsqrtf(ss + EPS); if (cg < 8) r *= 0.08838834764831845f; }
            u32x4 o0, o1;
            o0.x = cvtpk(x[0] * r, x[1] * r); o0.y = cvtpk(x[2] * r, x[3] * r); o0.z = cvtpk(x[4] * r, x[5] * r); o0.w = cvtpk(x[6] * r, x[7] * r);
            o1.x = cvtpk(x[8] * r, x[9] * r); o1.y = cvtpk(x[10] * r, x[11] * r); o1.z = cvtpk(x[12] * r, x[13] * r); o1.w = cvtpk(x[14] * r, x[15] * r);
            LAS bf16* img = cg < 8 ? QS + cg * 16 : (cg < 16 ? KS + (cg - 8) * 16 : VS + ((cg - 16) >> 3) * (64 * GP_ST) + ((cg - 16) & 7) * 16);
            LAS u32x4* dst = (LAS u32x4*)(img + (t0 + i) * GP_ST);
            dst[0] = o0; dst[1] = o1;
        }
        if (tid < 256) { const int vhh = tid >> 7, k = (tid >> 6) & 1, tt = tid & 63;
            BG[k * 128 + vhh * 64 + tt] = BL[(size_t)(row0 + tt) * 64 + k * 32 + 2 * qh + vhh]; }
    }
    __syncthreads(); asm volatile("" : "+v"(tid), "+v"(lane));
    if (wid < 2) {
        float g = BG[128 + wid * 64 + lane];
#pragma unroll
        for (int o = 1; o < 64; o <<= 1) { const float v = __shfl_up(g, o); if (lane >= o) g += v; }
        const float g63 = __shfl(g, 63);
        BG[256 + wid * 64 + lane] = g; BG[384 + wid * 64 + lane] = __expf(g); BG[512 + wid * 64 + lane] = __expf(g63 - g);
        if (lane == 63) *(float*)(rec0 + (size_t)wid * 32 * GREC_BYTES + GR_DEC) = __expf(g63);
    }
    {
        const int m = wid >> 2, rt = (wid >> 1) & 1, ct = wid & 1, r = lane & 31, h = lane >> 5;
        const LAS bf16* Am = (m ? QS : KS) + (32 * rt + r) * GP_ST + 8 * h; const LAS bf16* Bm = KS + (32 * ct + r) * GP_ST + 8 * h;
        f32x16 acc;
#pragma unroll
        for (int i = 0; i < 16; ++i) acc[i] = 0.f;
#pragma unroll
        for (int kt = 0; kt < 8; ++kt) acc = MFMA32(*(const LAS bf16x8*)(Am + 16 * kt), *(const LAS bf16x8*)(Bm + 16 * kt), acc);
        LAS float* dst = (m ? QKs : KKs) + 32 * ct + r;
#pragma unroll
        for (int i = 0; i < 16; ++i) dst[(32 * rt + crow_(i, h)) * GP_KST] = acc[i];
    }
    __syncthreads(); asm volatile("" : "+v"(tid), "+v"(lane));
    float att[16];
    for (int r2_ = 0; r2_ < NREP(23); ++r2_) {
        const int vhh = tid >> 8, e = tid & 255;
        const LAS float* bet = BG + vhh * 64; const LAS float* gam = BG + 256 + vhh * 64;
#pragma unroll
        for (int n = 0; n < 16; ++n) {
            const int idx = e + 256 * n, t = idx >> 6, s = idx & 63;
            const float L = (t >= s) ? __expf(gam[t] - gam[s]) : 0.f;
            AS[(vhh * 64 + t) * GP_AST + s] = (t > s) ? bet[t] * KKs[t * GP_KST + s] * L : 0.f;
            att[n] = -QKs[t * GP_KST + s] * L;
        }
#pragma unroll
        for (int n = 0; n < 4; ++n) {
            const int task = tid + 512 * n, vh2 = task >> 10, f = (task >> 6) & 15, l = task & 63, rt = f >> 3, kt = f & 7, r = l & 31, h = l >> 5;
            const u32x4 w = afrag_rows_scaled(QS, GP_ST, 32 * rt + r, kt, h, BG[384 + vh2 * 64 + 32 * rt + r]);
            *(u32x4*)(rec0 + (size_t)vh2 * 32 * GREC_BYTES + GR_Q + (f * 64 + l) * 16) = w;
        }
#pragma unroll
        for (int n = 0; n < 4; ++n) {
            const int task = tid + 512 * n, vh2 = task >> 10, f = (task >> 6) & 15, l = task & 63, dt = f >> 2, ts = f & 3, r = l & 31, h = l >> 5;
            float v[8];
#pragma unroll
            for (int j = 0; j < 8; ++j) { const int tok = kidx_(ts, h, j); v[j] = -bf2f(KS[tok * GP_ST + 32 * dt + r]) * BG[512 + vh2 * 64 + tok]; }
            *(u32x4*)(rec0 + (size_t)vh2 * 32 * GREC_BYTES + GR_K + (f * 64 + l) * 16) = (u32x4){cvtpk(v[0], v[1]), cvtpk(v[2], v[3]), cvtpk(v[4], v[5]), cvtpk(v[6], v[7])};
        }
    }
    __syncthreads(); asm volatile("" : "+v"(tid), "+v"(lane));
    {
        const int vhh = tid >> 8, e = tid & 255;
#pragma unroll
        for (int n = 0; n < 16; ++n) { const int idx = e + 256 * n, t = idx >> 6, s = idx & 63; ATT[(vhh * 64 + t) * GP_TST + s] = (bf16)(cvtpk(att[n], 0.f) & 0xffffu); }
    }
    float X[64];
    for (int r3_ = 0; r3_ < NREP(21); ++r3_) {
        const int vhh = tid >> 8, cc = tid & 255;
        {
            const LAS float* bet = BG + vhh * 64; const LAS float* eg = BG + 384 + vhh * 64;
            const LAS bf16* src = (cc < 128) ? (VS + vhh * (64 * GP_ST) + cc) : (KS + (cc - 128));
            const bool isw = cc >= 128;
#pragma unroll
            for (int t = 0; t < 64; ++t) { const float bt = bet[t] * (isw ? eg[t] : 1.f); X[t] = bf2f(src[t * GP_ST]) * bt; }
        }
        __syncthreads();
#define GDN_SOLVE_QUARTER(QQ, S4LO) \
        _Pragma("unroll 1") for (int tb = 4 * (QQ); tb < 4 * (QQ) + 4; ++tb) { \
            float rr[4]; \
            _Pragma("unroll") for (int j = 4 * (QQ); j < 4 * (QQ) + 4; ++j) if (j == tb) { rr[0] = X[4 * j]; rr[1] = X[4 * j + 1]; rr[2] = X[4 * j + 2]; rr[3] = X[4 * j + 3]; } \
            const LAS float* ar = AS + (vhh * 64 + 4 * tb) * GP_AST; \
            _Pragma("unroll") for (int s4 = (S4LO); s4 < 4 * (QQ) + 4; ++s4) { \
                if (s4 < 4 * (QQ) || s4 < tb) { \
                    const f32x4 a0 = *(const LAS f32x4*)(ar + 4 * s4), a1 = *(const LAS f32x4*)(ar + GP_AST + 4 * s4), a2 = *(const LAS f32x4*)(ar + 2 * GP_AST + 4 * s4), a3 = *(const LAS f32x4*)(ar + 3 * GP_AST + 4 * s4); \
                    _Pragma("unroll") for (int e = 0; e < 4; ++e) { const float x = X[4 * s4 + e]; rr[0] = fmaf(-a0[e], x, rr[0]); rr[1] = fmaf(-a1[e], x, rr[1]); rr[2] = fmaf(-a2[e], x, rr[2]); rr[3] = fmaf(-a3[e], x, rr[3]); } \
                } \
                if ((s4 & 1) == 1) asm volatile("" : "+v"(ar) : "v"(rr[0])); \
            } \
            const f32x4 d1 = *(const LAS f32x4*)(ar + GP_AST + 4 * tb), d2 = *(const LAS f32x4*)(ar + 2 * GP_AST + 4 * tb), d3 = *(const LAS f32x4*)(ar + 3 * GP_AST + 4 * tb); \
            rr[1] = fmaf(-d1[0], rr[0], rr[1]); \
            rr[2] = fmaf(-d2[0], rr[0], rr[2]); rr[2] = fmaf(-d2[1], rr[1], rr[2]); \
            rr[3] = fmaf(-d3[0], rr[0], rr[3]); rr[3] = fmaf(-d3[1], rr[1], rr[3]); rr[3] = fmaf(-d3[2], rr[2], rr[3]); \
            _Pragma("unroll") for (int j = 4 * (QQ); j < 4 * (QQ) + 4; ++j) if (j == tb) { X[4 * j] = rr[0]; X[4 * j + 1] = rr[1]; X[4 * j + 2] = rr[2]; X[4 * j + 3] = rr[3]; } \
        }
        GDN_SOLVE_QUARTER(0, 0) GDN_SOLVE_QUARTER(1, 0)
        const float sg = (cc < 128) ? -1.f : 1.f;
#pragma unroll
        for (int t = 0; t < 32; ++t) XL[(vhh * 64 + t) * GP_XST + cc] = (bf16)(cvtpk(X[t] * sg, 0.f) & 0xffffu);
        __syncthreads();
        {
            const int r = lane & 31, h = lane >> 5, ct0 = 2 * (wid & 3);
            f32x16 Pe, Po;
#pragma unroll
            for (int i = 0; i < 16; ++i) { Pe[i] = 0.f; Po[i] = 0.f; }
#pragma unroll
            for (int ks = 0; ks < 2; ++ks) {
                const LAS float* ap = AS + (vhh * 64 + 32 + r) * GP_AST + 16 * ks + 8 * h;
                const f32x4 a0 = *(const LAS f32x4*)ap, a1 = *(const LAS f32x4*)(ap + 4);
                const u32x4 au = {cvtpk(a0[0], a0[1]), cvtpk(a0[2], a0[3]), cvtpk(a1[0], a1[1]), cvtpk(a1[2], a1[3])};
                const LAS bf16* bp = XL + (vhh * 64 + 16 * ks + 8 * h) * GP_XST + 32 * ct0 + r;
                unsigned be[4], bo[4];
#pragma unroll
                for (int j2 = 0; j2 < 4; ++j2) { be[j2] = (unsigned)bp[(2 * j2) * GP_XST] | ((unsigned)bp[(2 * j2 + 1) * GP_XST] << 16); bo[j2] = (unsigned)bp[(2 * j2) * GP_XST + 32] | ((unsigned)bp[(2 * j2 + 1) * GP_XST + 32] << 16); }
                Pe = MFMA32(__builtin_bit_cast(bf16x8, au), __builtin_bit_cast(bf16x8, ((u32x4){be[0], be[1], be[2], be[3]})), Pe);
                Po = MFMA32(__builtin_bit_cast(bf16x8, au), __builtin_bit_cast(bf16x8, ((u32x4){bo[0], bo[1], bo[2], bo[3]})), Po);
            }
#pragma unroll
            for (int i = 0; i < 16; ++i) {
                const float xe = __shfl_xor(Pe[i], 32), xo = __shfl_xor(Po[i], 32);
                const float pa = h ? xo : Pe[i], pb = h ? Po[i] : xe;
                const int ra = 32 + (i & 3) + 8 * (i >> 2);
                X[ra] = fmaf(-sg, pa, X[ra]); X[ra + 4] = fmaf(-sg, pb, X[ra + 4]);
            }
        }
        GDN_SOLVE_QUARTER(2, 8) GDN_SOLVE_QUARTER(3, 8)
#undef GDN_SOLVE_QUARTER
#pragma unroll
        for (int t = 32; t < 64; ++t) XL[(vhh * 64 + t) * GP_XST + cc] = (bf16)(cvtpk(X[t] * sg, 0.f) & 0xffffu);
    }
    __syncthreads(); asm volatile("" : "+v"(tid), "+v"(lane));
    for (int r4_ = 0; r4_ < NREP(22); ++r4_) {
#pragma unroll
        for (int n = 0; n < 4; ++n) {
            const int task = tid + 512 * n, vh2 = task >> 10, f = (task >> 6) & 15, l = task & 63, rt = f >> 3, kt = f & 7, r = l & 31, h = l >> 5;
            const u32x4 w = afrag_rows(XL + vh2 * (64 * GP_XST) + 128, GP_XST, 32 * rt + r, kt, h);
            *(u32x4*)(rec0 + (size_t)vh2 * 32 * GREC_BYTES + GR_W + (f * 64 + l) * 16) = w;
        }
#pragma unroll
        for (int n = 0; n < 2; ++n) {
            const int task = tid + 512 * n, vh2 = task >> 9, f = (task >> 6) & 7, l = task & 63, slab = f >> 1, rt = f & 1, r = l & 31, h = l >> 5;
            const LAS bf16* src = XL + (vh2 * 64 + 32 * rt) * GP_XST + 32 * slab + r;
            unsigned w[8];
#pragma unroll
            for (int i2 = 0; i2 < 8; ++i2) w[i2] = (unsigned)src[crow_(2 * i2, h) * GP_XST] | ((unsigned)src[crow_(2 * i2 + 1, h) * GP_XST] << 16);
            u32x4* dst = (u32x4*)(rec0 + (size_t)vh2 * 32 * GREC_BYTES + GR_U + (f * 64 + l) * 32);
            dst[0] = (u32x4){w[0], w[1], w[2], w[3]}; dst[1] = (u32x4){w[4], w[5], w[6], w[7]};
        }
#pragma unroll
        for (int n = 0; n < 2; ++n) {
            const int task = tid + 512 * n, vh2 = task >> 9, f = (task >> 6) & 7, l = task & 63, rt = f >> 2, ts = f & 3, r = l & 31, h = l >> 5;
            const u32x4 w = afrag_rows(ATT + vh2 * (64 * GP_TST), GP_TST, 32 * rt + r, ts, h);
            *(u32x4*)(rec0 + (size_t)vh2 * 32 * GREC_BYTES + GR_A + (f * 64 + l) * 16) = w;
        }
    }
    __syncthreads(); asm volatile("" : "+v"(tid), "+v"(lane));
}

constexpr int HP_QT = 0, HP_KT = 17408, HP_QH = 34816, HP_KH = 52224, HP_IS = 69632, HP_GS = 87040, HP_AT = 90112;
__device__ __forceinline__ void hgrn_prep_unit(const PA& a, LAS unsigned char* lds, int u, int tid, int wid, int lane) {
    asm volatile("" : "+v"(tid), "+v"(lane));
    unsigned char* ws = a.ws();
    const int b = u >> 9, hd = (u >> 5) & 15, c = u & 31;
    const bf16* QhP = (const bf16*)(ws + WS_QHP); const float* FP = (const float*)(ws + WS_FP); const bf16* IP = (const bf16*)(ws + WS_IP);
    LAS bf16* QT = (LAS bf16*)(lds + HP_QT); LAS bf16* KT = (LAS bf16*)(lds + HP_KT); LAS bf16* QH = (LAS bf16*)(lds + HP_QH); LAS bf16* KH = (LAS bf16*)(lds + HP_KH);
    LAS bf16* IS = (LAS bf16*)(lds + HP_IS); LAS float* GS = (LAS float*)(lds + HP_GS); LAS bf16* AT = (LAS bf16*)(lds + HP_AT);
    const int row0 = b * SEQ + c * 64;
    unsigned char* rec = ws + WS_HREC + (size_t)((b * 16 + hd) * 32 + c) * HREC_BYTES;
    {
        const int d = tid & 127, tq = tid >> 7;
        float G[16], qv[16], kv[16];
        const size_t base = (size_t)(row0 + 16 * tq) * 2048 + hd * 128 + d;
        float run = 0.f;
#pragma unroll
        for (int j = 0; j < 16; ++j) { const float f = FP[base + (size_t)j * 2048]; run += __logf(f); G[j] = run; kv[j] = 1.f - f; qv[j] = bf2f(QhP[base + (size_t)j * 2048]);
            IS[(16 * tq + j) * GP_ST + d] = IP[base + (size_t)j * 2048]; }
        GS[256 + tq * 128 + d] = run;
        __syncthreads(); asm volatile("" : "+v"(tid), "+v"(lane));
        float off = 0.f;
#pragma unroll
        for (int q = 0; q < 3; ++q) if (q < tq) off += GS[256 + q * 128 + d];
        if (tq == 2) GS[128 + d] = off + G[0];
        if (tq == 3) { const float g63 = off + G[15]; GS[d] = g63; *(float*)(rec + HR_DEC + d * 4) = __expf(g63); }
        __syncthreads(); asm volatile("" : "+v"(tid), "+v"(lane));
        const float gref = GS[128 + d], g63 = GS[d];
#pragma unroll
        for (int j = 0; j < 16; ++j) {
            const float g = off + G[j]; const int t = 16 * tq + j;
            QT[t * GP_ST + d] = (bf16)(cvtpk(qv[j] * __expf(g - gref), 0.f) & 0xffffu);
            KT[t * GP_ST + d] = (bf16)(cvtpk(kv[j] * __expf(gref - g), 0.f) & 0xffffu);
            QH[t * GP_ST + d] = (bf16)(cvtpk(qv[j] * __expf(g), 0.f) & 0xffffu);
            KH[t * GP_ST + d] = (bf16)(cvtpk(kv[j] * __expf(g63 - g), 0.f) & 0xffffu);
        }
    }
    __syncthreads(); asm volatile("" : "+v"(tid), "+v"(lane));
    if (wid < 4) {
        const int rt = wid >> 1, ct = wid & 1, r = lane & 31, h = lane >> 5;
        const LAS bf16* Am = QT + (32 * rt + r) * GP_ST + 8 * h; const LAS bf16* Bm = KT + (32 * ct + r) * GP_ST + 8 * h;
        f32x16 acc;
#pragma unroll
        for (int i = 0; i < 16; ++i) acc[i] = 0.f;
#pragma unroll
        for (int kt = 0; kt < 8; ++kt) acc = MFMA32(*(const LAS bf16x8*)(Am + 16 * kt), *(const LAS bf16x8*)(Bm + 16 * kt), acc);
#pragma unroll
        for (int i = 0; i < 16; ++i) { const int t = 32 * rt + crow_(i, h), s = 32 * ct + r; AT[t * GP_TST + s] = (bf16)(cvtpk(t >= s ? acc[i] : 0.f, 0.f) & 0xffffu); }
    } else {
        const int t2 = tid - 256;
#pragma unroll
        for (int n = 0; n < 4; ++n) { const int task = t2 + 256 * n, f = task >> 6, l = task & 63, rt = f >> 3, kt = f & 7, r = l & 31, h = l >> 5;
            *(u32x4*)(rec + HR_Q + (f * 64 + l) * 16) = afrag_rows(QH, GP_ST, 32 * rt + r, kt, h); }
    }
    __syncthreads(); asm volatile("" : "+v"(tid), "+v"(lane));
    {
#pragma unroll
        for (int n = 0; n < 2; ++n) {
            const int task = tid + 512 * n, f = task >> 6, l = task & 63, dt = f >> 2, ts = f & 3, r = l & 31, h = l >> 5;
            unsigned short v[8];
#pragma unroll
            for (int j = 0; j < 8; ++j) v[j] = KH[kidx_(ts, h, j) * GP_ST + 32 * dt + r];
            *(u32x4*)(rec + HR_K + (f * 64 + l) * 16) = (u32x4){(unsigned)v[0] | ((unsigned)v[1] << 16), (unsigned)v[2] | ((unsigned)v[3] << 16), (unsigned)v[4] | ((unsigned)v[5] << 16), (unsigned)v[6] | ((unsigned)v[7] << 16)};
        }
#pragma unroll
        for (int n = 0; n < 2; ++n) {
            const int task = tid + 512 * n, f = task >> 6, l = task & 63, slab = f >> 2, ts = f & 3, r = l & 31, h = l >> 5;
            unsigned short v[8];
#pragma unroll
            for (int j = 0; j < 8; ++j) v[j] = IS[kidx_(ts, h, j) * GP_ST + 32 * slab + r];
            *(u32x4*)(rec + HR_I + (f * 64 + l) * 16) = (u32x4){(unsigned)v[0] | ((unsigned)v[1] << 16), (unsigned)v[2] | ((unsigned)v[3] << 16), (unsigned)v[4] | ((unsigned)v[5] << 16), (unsigned)v[6] | ((unsigned)v[7] << 16)};
        }
        {
            const int f = tid >> 6, l = tid & 63, rt = f >> 2, ts = f & 3, r = l & 31, h = l >> 5;
            *(u32x4*)(rec + HR_A + (f * 64 + l) * 16) = afrag_rows(AT, GP_TST, 32 * rt + r, ts, h);
        }
    }
    __syncthreads(); asm volatile("" : "+v"(tid), "+v"(lane));
}

template <int NP> __device__ __forceinline__ void stage_image(LAS unsigned char* lds, const unsigned char* rec, unsigned nbytes, int tid) {
    unsigned off0 = (unsigned)tid * 16u; asm volatile("" : "+v"(off0));
    u32x4 v[NP];
#pragma unroll
    for (int i = 0; i < NP; ++i) { if (i * (NTHREADS * 16) + (NTHREADS * 16) <= (int)nbytes || off0 + i * (NTHREADS * 16) < nbytes) v[i] = *(const u32x4*)(rec + i * (NTHREADS * 16) + off0); }
    __syncthreads();
#pragma unroll
    for (int i = 0; i < NP; ++i) { if (i * (NTHREADS * 16) + (NTHREADS * 16) <= (int)nbytes || off0 + i * (NTHREADS * 16) < nbytes) *(LAS u32x4*)(lds + i * (NTHREADS * 16) + off0) = v[i]; }
    __syncthreads();
}
#define LFRAG(off) (*(const LAS bf16x8*)(lb + (off)))
__device__ __forceinline__ void gdn_seq_block(const PA& a, LAS unsigned char* lds, int u, int tid, int wid, int lane) {
    unsigned char* ws = a.ws();
    const int b = u >> 5, vh = u & 31, slab = wid;
    LAS unsigned char* lb = lds;
    bf16* O16 = (bf16*)(ws + WS_O16);
    f32x16 S[4];
#pragma unroll
    for (int d = 0; d < 4; ++d)
#pragma unroll
        for (int i = 0; i < 16; ++i) S[d][i] = 0.f;
    for (int c = 0; c < 32; ++c) {
        const unsigned char* rec = ws + WS_GREC + (size_t)((b * 32 + vh) * 32 + c) * GREC_BYTES;
        stage_image<7>(lds, rec, GR_IMG, tid);
        asm volatile("" : "+v"(lane));
        const int r = lane & 31, h = lane >> 5;
        if (wid < 4) {
            const float dec = ldg_agent((const float*)(rec + GR_DEC));
            f32x16 P1[2], P2[2];
#pragma unroll
            for (int rt = 0; rt < 2; ++rt) {
                const u32x4* up = (const u32x4*)(rec + GR_U + ((slab * 2 + rt) * 64 + lane) * 32);
                const u32x4 u0 = up[0], u1 = up[1];
                P1[rt][0] = bflo(u0.x); P1[rt][1] = bfhi(u0.x); P1[rt][2] = bflo(u0.y); P1[rt][3] = bfhi(u0.y); P1[rt][4] = bflo(u0.z); P1[rt][5] = bfhi(u0.z); P1[rt][6] = bflo(u0.w); P1[rt][7] = bfhi(u0.w);
                P1[rt][8] = bflo(u1.x); P1[rt][9] = bfhi(u1.x); P1[rt][10] = bflo(u1.y); P1[rt][11] = bfhi(u1.y); P1[rt][12] = bflo(u1.z); P1[rt][13] = bfhi(u1.z); P1[rt][14] = bflo(u1.w); P1[rt][15] = bfhi(u1.w);
#pragma unroll
                for (int i = 0; i < 16; ++i) P2[rt][i] = 0.f;
            }
#pragma unroll
            for (int d = 0; d < 4; ++d) {
                const bf16x8 b0 = pack_acc<0>(S[d]), b1 = pack_acc<1>(S[d]);
#pragma unroll
                for (int rt = 0; rt < 2; ++rt) {
                    P1[rt] = MFMA32(LFRAG(GR_W + ((rt * 8 + 2 * d) * 64 + lane) * 16), b0, P1[rt]);     P2[rt] = MFMA32(LFRAG(GR_Q + ((rt * 8 + 2 * d) * 64 + lane) * 16), b0, P2[rt]);
                    P1[rt] = MFMA32(LFRAG(GR_W + ((rt * 8 + 2 * d + 1) * 64 + lane) * 16), b1, P1[rt]); P2[rt] = MFMA32(LFRAG(GR_Q + ((rt * 8 + 2 * d + 1) * 64 + lane) * 16), b1, P2[rt]);
                }
                __builtin_amdgcn_sched_barrier(0);
            }
            const bf16x8 bv0 = pack_acc<0>(P1[0]), bv1 = pack_acc<1>(P1[0]), bv2 = pack_acc<0>(P1[1]), bv3 = pack_acc<1>(P1[1]);
#pragma unroll
            for (int rt = 0; rt < 2; ++rt) {
                P2[rt] = MFMA32(LFRAG(GR_A + ((rt * 4 + 0) * 64 + lane) * 16), bv0, P2[rt]); P2[rt] = MFMA32(LFRAG(GR_A + ((rt * 4 + 1) * 64 + lane) * 16), bv1, P2[rt]);
                P2[rt] = MFMA32(LFRAG(GR_A + ((rt * 4 + 2) * 64 + lane) * 16), bv2, P2[rt]); P2[rt] = MFMA32(LFRAG(GR_A + ((rt * 4 + 3) * 64 + lane) * 16), bv3, P2[rt]);
                __builtin_amdgcn_sched_barrier(0);
            }
            {
                bf16* op = O16 + (size_t)(b * SEQ + c * 64) * 6144 + 2048 + vh * 128 + 32 * slab + r;
#pragma unroll
                for (int rt = 0; rt < 2; ++rt)
#pragma unroll
                    for (int i = 0; i < 16; ++i) op[(size_t)(32 * rt + crow_(i, h)) * 6144] = (bf16)(cvtpk(P2[rt][i], 0.f) & 0xffffu);
            }
#pragma unroll
            for (int d = 0; d < 4; ++d) {
#pragma unroll
                for (int i = 0; i < 16; ++i) S[d][i] *= dec;
                S[d] = MFMA32(LFRAG(GR_K + ((d * 4 + 0) * 64 + lane) * 16), bv0, S[d]); S[d] = MFMA32(LFRAG(GR_K + ((d * 4 + 1) * 64 + lane) * 16), bv1, S[d]);
                S[d] = MFMA32(LFRAG(GR_K + ((d * 4 + 2) * 64 + lane) * 16), bv2, S[d]); S[d] = MFMA32(LFRAG(GR_K + ((d * 4 + 3) * 64 + lane) * 16), bv3, S[d]);
                __builtin_amdgcn_sched_barrier(0);
            }
        }
    }
    if (wid < 4) {
        asm volatile("" : "+v"(lane)); const int r = lane & 31, h = lane >> 5;
        float* so = a.out() + O_GDP + (size_t)((b * 32 + vh) * 128) * 128 + 32 * slab + r;
#pragma unroll
        for (int d = 0; d < 4; ++d)
#pragma unroll
            for (int i = 0; i < 16; ++i) so[(size_t)(32 * d + crow_(i, h)) * 128] = S[d][i];
    }
    __syncthreads();
}
__device__ __forceinline__ void hgrn_seq_block(const PA& a, LAS unsigned char* lds, int u, int tid, int wid, int lane) {
    unsigned char* ws = a.ws();
    const int b = u >> 4, hd = u & 15, slab = wid;
    LAS unsigned char* lb = lds;
    bf16* O16 = (bf16*)(ws + WS_O16);
    f32x16 S[4];
#pragma unroll
    for (int d = 0; d < 4; ++d)
#pragma unroll
        for (int i = 0; i < 16; ++i) S[d][i] = 0.f;
    for (int c = 0; c < 32; ++c) {
        stage_image<8>(lds, ws + WS_HREC + (size_t)((b * 16 + hd) * 32 + c) * HREC_BYTES, HR_IMG, tid);
        asm volatile("" : "+v"(lane));
        const int r = lane & 31, h = lane >> 5;
        if (wid < 4) {
            f32x16 o[2];
#pragma unroll
            for (int rt = 0; rt < 2; ++rt)
#pragma unroll
                for (int i = 0; i < 16; ++i) o[rt][i] = 0.f;
#pragma unroll
            for (int d = 0; d < 4; ++d) {
                const bf16x8 b0 = pack_acc<0>(S[d]), b1 = pack_acc<1>(S[d]);
#pragma unroll
                for (int rt = 0; rt < 2; ++rt) { o[rt] = MFMA32(LFRAG(HR_Q + ((rt * 8 + 2 * d) * 64 + lane) * 16), b0, o[rt]); o[rt] = MFMA32(LFRAG(HR_Q + ((rt * 8 + 2 * d + 1) * 64 + lane) * 16), b1, o[rt]); }
                __builtin_amdgcn_sched_barrier(0);
            }
            const bf16x8 i0 = LFRAG(HR_I + ((slab * 4 + 0) * 64 + lane) * 16), i1 = LFRAG(HR_I + ((slab * 4 + 1) * 64 + lane) * 16), i2 = LFRAG(HR_I + ((slab * 4 + 2) * 64 + lane) * 16), i3 = LFRAG(HR_I + ((slab * 4 + 3) * 64 + lane) * 16);
#pragma unroll
            for (int rt = 0; rt < 2; ++rt) {
                o[rt] = MFMA32(LFRAG(HR_A + ((rt * 4 + 0) * 64 + lane) * 16), i0, o[rt]); o[rt] = MFMA32(LFRAG(HR_A + ((rt * 4 + 1) * 64 + lane) * 16), i1, o[rt]);
                o[rt] = MFMA32(LFRAG(HR_A + ((rt * 4 + 2) * 64 + lane) * 16), i2, o[rt]); o[rt] = MFMA32(LFRAG(HR_A + ((rt * 4 + 3) * 64 + lane) * 16), i3, o[rt]);
                __builtin_amdgcn_sched_barrier(0);
            }
            {
                bf16* op = O16 + (size_t)(b * SEQ + c * 64) * 6144 + hd * 128 + 32 * slab + r;
#pragma unroll
                for (int rt = 0; rt < 2; ++rt)
#pragma unroll
                    for (int i = 0; i < 16; ++i) op[(size_t)(32 * rt + crow_(i, h)) * 6144] = (bf16)(cvtpk(o[rt][i], 0.f) & 0xffffu);
            }
            const LAS float* dec = (const LAS float*)(lb + HR_DEC);
#pragma unroll
            for (int d = 0; d < 4; ++d) {
#pragma unroll
                for (int i4 = 0; i4 < 4; ++i4) { const f32x4 dv = *(const LAS f32x4*)(dec + 32 * d + 8 * i4 + 4 * h);
#pragma unroll
                    for (int e = 0; e < 4; ++e) S[d][4 * i4 + e] *= dv[e]; }
                S[d] = MFMA32(LFRAG(HR_K + ((d * 4 + 0) * 64 + lane) * 16), i0, S[d]); S[d] = MFMA32(LFRAG(HR_K + ((d * 4 + 1) * 64 + lane) * 16), i1, S[d]);
                S[d] = MFMA32(LFRAG(HR_K + ((d * 4 + 2) * 64 + lane) * 16), i2, S[d]); S[d] = MFMA32(LFRAG(HR_K + ((d * 4 + 3) * 64 + lane) * 16), i3, S[d]);
                __builtin_amdgcn_sched_barrier(0);
            }
        }
    }
    if (wid < 4) {
        asm volatile("" : "+v"(lane)); const int r = lane & 31, h = lane >> 5;
        float* so = a.out() + O_HGP + (size_t)((b * 16 + hd) * 128) * 128 + 32 * slab + r;
#pragma unroll
        for (int d = 0; d < 4; ++d)
#pragma unroll
            for (int i = 0; i < 16; ++i) so[(size_t)(32 * d + crow_(i, h)) * 128] = S[d][i];
    }
    __syncthreads();
}

#define XB_TMO      128
#define XB_XCNT(j)  (256  + 64 * (j))
#define XB_XSUB(j)  (1280 + 64 * (j))
#define XB_XGEN(j)  (2304 + 64 * (j))
#define XB_TOP      3328
#define XB_TOPGEN   3392
#define XCD_BAR_WORDS 3456
#define XB_SPIN_CAP (1u << 18)
__device__ __forceinline__ unsigned xb_ld(unsigned* p)              { return __hip_atomic_load(p, __ATOMIC_RELAXED, __HIP_MEMORY_SCOPE_AGENT); }
__device__ __forceinline__ unsigned xb_add(unsigned* p, unsigned v) { return __hip_atomic_fetch_add(p, v, __ATOMIC_RELAXED, __HIP_MEMORY_SCOPE_AGENT); }
__device__ __forceinline__ unsigned xb_xcc_id() { return (unsigned)__builtin_amdgcn_s_getreg((3 << 11) | 20) & 0xFu; }
#define XB_SPIN(cond, bar) do { unsigned _sp = 0; while (cond) { __builtin_amdgcn_s_sleep(1); \
    if ((++_sp & 255u) == 0u) { if (xb_ld(&(bar)[XB_TMO])) break; if (_sp > XB_SPIN_CAP) { atomicAdd(&(bar)[XB_TMO], 1u); break; } } } } while (0)
__device__ __forceinline__ void xcd_barrier_complete(unsigned* bar, unsigned x, unsigned G, unsigned& nloc, unsigned& nx) {
    unsigned sum, cnt, mine, sp = 0u;
    for (;;) {
        sum = 0u; cnt = 0u; mine = 0u;
#pragma unroll
        for (unsigned j = 0; j < 16; ++j) { const unsigned c = xb_ld(&bar[XB_XCNT(j)]); sum += c; cnt += (c > 0u) ? 1u : 0u; mine = (j == x) ? c : mine; }
        if (sum == G) break;
        __builtin_amdgcn_s_sleep(1);
        if ((++sp & 255u) == 0u) { if (xb_ld(&bar[XB_TMO])) break; if (sp > XB_SPIN_CAP) { atomicAdd(&bar[XB_TMO], 1u); break; } }
    }
    nloc = mine > 0u ? mine : 1u; nx = cnt > 0u ? cnt : 1u;
}
__device__ __forceinline__ void xcd_barrier(unsigned* bar, unsigned x, volatile LAS unsigned* st, int tid, unsigned G) {
    asm volatile("s_waitcnt vmcnt(0)" ::: "memory");
    __syncthreads();
    if (tid == 0) {
        __builtin_amdgcn_s_waitcnt(0);
        unsigned nloc = st[0], nx = st[1];
        if (nloc == 0u) { xcd_barrier_complete(bar, x, G, nloc, nx); st[0] = nloc; st[1] = nx; }
        const unsigned old = xb_add(&bar[XB_XSUB(x)], 1u);
        const unsigned gen = old / nloc;
        if (old + 1u == (gen + 1u) * nloc) {
            __builtin_amdgcn_fence(__ATOMIC_RELEASE, "agent");
            asm volatile("s_waitcnt vmcnt(0)" ::: "memory");
            const unsigned og = xb_add(&bar[XB_TOP], 1u);
            const unsigned tg = og / nx;
            if (og + 1u == (tg + 1u) * nx) xb_add(&bar[XB_TOPGEN], 1u);
            else XB_SPIN(xb_ld(&bar[XB_TOPGEN]) == tg, bar);
            __builtin_amdgcn_fence(__ATOMIC_ACQUIRE, "agent");
            xb_add(&bar[XB_XGEN(x)], 1u);
            asm volatile("s_waitcnt vmcnt(0)" ::: "memory");
        } else {
            XB_SPIN(xb_ld(&bar[XB_XGEN(x)]) == gen, bar);
            __builtin_amdgcn_fence(__ATOMIC_ACQUIRE, "agent");
            asm volatile("s_waitcnt vmcnt(0)" ::: "memory");
        }
    }
    __syncthreads();
}
constexpr int CW_WORK = 64;
constexpr int CW_BAR = 4096;
constexpr size_t CTL_ZERO_BYTES = 65536;
constexpr int LDS_ST_OFF = LDS_BYTES - 64;

__global__ void __launch_bounds__(NTHREADS, 2) fwd(Args args_unused) {
    extern __shared__ __attribute__((aligned(16))) unsigned char lds_raw[];
    LAS unsigned char* lds = (LAS unsigned char*)lds_raw;
    const int wid = __builtin_amdgcn_readfirstlane(threadIdx.x >> 6);
    const int G = gridDim.x, bx = blockIdx.x;
    const int vcu = (G % 8 == 0) ? (bx % 8) * (G / 8) + bx / 8 : bx;
    const int gw = vcu * NWAVES + wid, NGW = G * NWAVES;
    volatile LAS unsigned* bst = (volatile LAS unsigned*)(lds + LDS_ST_OFF);
    const unsigned xcc = xb_xcc_id();
    { const PA a0 = PA::get(); const int l0 = lane_id_(); if (wid == 0 && l0 < 2) bst[l0] = 0u;
      if (a0.ph_hi() - a0.ph_lo() > 1 && wid == 0 && l0 == 0) (void)xb_add((unsigned*)a0.ws() + CW_BAR + XB_XCNT(xcc), 1u); }
    __syncthreads();
#ifndef PH_MASK
#define PH_MASK 0xffff
#endif
#define IN(k) (((PH_MASK >> (k)) & 1) && ph_in(k))
#define SEAM(k) do { if (IN(k) && IN((k) + 1)) { if ((k) == 0) cg::this_grid().sync(); \
    else { const PA ab = PA::get(); xcd_barrier((unsigned*)ab.ws() + CW_BAR, xcc, bst, wid * 64 + lane_id_(), (unsigned)G); } } } while (0)

    if (IN(0)) for (int rep_ = 0; rep_ < NREP(0); ++rep_) { if (rep_) { const PA ab = PA::get(); xcd_barrier((unsigned*)ab.ws() + CW_BAR, xcc, bst, wid * 64 + lane_id_(), (unsigned)G); }
        const PA a = PA::get(); unsigned char* ws = a.ws(); const int lane = lane_id_(), tid = wid * 64 + lane; (void)tid;
        for (int cb = vcu; cb < NADA / 64; cb += G) mod_item(a, lds, cb, tid, wid, lane);
        __syncthreads();
        LAS float* scr = (LAS float*)(lds + wid * 16384);
        constexpr int I0 = 32 * 770, I1 = 32 * 64, I2 = 64 * 64, I3 = 32 * 64, I4 = 32 * 256, I5 = 128 * 64, NIT = I0 + I1 + I2 + I3 + I4 + I5;
        bf16* BtIn = (bf16*)(ws + WS_BTIN); bf16* BtOut = (bf16*)(ws + WS_BTOUT); bf16* BtO = (bf16*)(ws + WS_BTO); bf16* BtUp = (bf16*)(ws + WS_BTUP); bf16* BtDn = (bf16*)(ws + WS_BTDN);
        for (int it = gw; it < NIT; it += NGW) {
            int r = it;
            if (r < I0) { const int kb = r / 770, nb = r % 770, n0 = nb * 32; const int nd = n0 < 20480 ? n0 : (n0 < 20544 ? n0 - 20480 + 24576 : n0 - 64);
                transpose_item(a.in(I_WIN), N_IN, BtIn, 2048, kb * 64, n0, nd, scr, lane); continue; } r -= I0;
            if (r < I1) { transpose_item(a.in(I_WOHG), 2048, BtOut, 6144, (r / 64) * 64, (r % 64) * 32, (r % 64) * 32, scr, lane); continue; } r -= I1;
            if (r < I2) { transpose_item(a.in(I_WOGD), 2048, BtOut + 2048, 6144, (r / 64) * 64, (r % 64) * 32, (r % 64) * 32, scr, lane); continue; } r -= I2;
            if (r < I3) { transpose_item(a.in(I_WO), 2048, BtO, 2048, (r / 64) * 64, (r % 64) * 32, (r % 64) * 32, scr, lane); continue; } r -= I3;
            if (r < I4) { transpose_item(a.in(I_WUP), 8192, BtUp, 2048, (r / 256) * 64, (r % 256) * 32, (r % 256) * 32, scr, lane); continue; } r -= I4;
            transpose_item(a.in(I_WDN), 2048, BtDn, 8192, (r / 64) * 64, (r % 64) * 32, (r % 64) * 32, scr, lane);
        }
        { u32x4* z = (u32x4*)(BtIn + (size_t)N_IN * 2048); const int nz = (N_INP - N_IN) * 2048 * 2 / 16;
          for (int i = vcu * NTHREADS + tid; i < nz; i += G * NTHREADS) z[i] = (u32x4){0u, 0u, 0u, 0u}; }
    }
    SEAM(0);
    if (IN(1)) for (int rep_ = 0; rep_ < NREP(1); ++rep_) { if (rep_) { const PA ab = PA::get(); xcd_barrier((unsigned*)ab.ws() + CW_BAR, xcc, bst, wid * 64 + lane_id_(), (unsigned)G); }
        const PA a = PA::get(); unsigned char* ws = a.ws(); const int lane = lane_id_(), tid = wid * 64 + lane; (void)tid;
        const float* mod = (const float*)(ws + WS_MOD); const float* ng = a.in(I_NG); bf16* A1 = (bf16*)(ws + WS_A1);
        for (int row = gw; row < MROWS; row += NGW) {
            const f32x4* xr = (const f32x4*)xrow_ptr(a, row) + lane; const float* md = mod + (size_t)seq_of_row(row) * NADA;
            f32x4 v[8]; float ss = 0.f;
#pragma unroll
            for (int j = 0; j < 8; ++j) { v[j] = xr[64 * j]; ss += (v[j][0] * v[j][0] + v[j][1] * v[j][1]) + (v[j][2] * v[j][2] + v[j][3] * v[j][3]); }
            const float r = rsqrtf(wave_sum(ss) * (1.f / DM) + EPS);
            u32x2* o = (u32x2*)(A1 + (size_t)row * DM) + lane;
#pragma unroll
            for (int j = 0; j < 8; ++j) { const int c = 4 * lane + 256 * j; const f32x4 g = *(const f32x4*)(ng + c), sh = *(const f32x4*)(md + c), sc = *(const f32x4*)(md + 2048 + c);
                f32x4 y; _Pragma("unroll") for (int e = 0; e < 4; ++e) y[e] = v[j][e] * r * g[e] * (1.f + sc[e]) + sh[e];
                o[64 * j] = (u32x2){pk2(y[0], y[1]), pk2(y[2], y[3])}; }
        }
    }
    SEAM(1);
    if (IN(2)) for (int rep_ = 0; rep_ < NREP(2); ++rep_) { if (rep_) { const PA ab = PA::get(); xcd_barrier((unsigned*)ab.ws() + CW_BAR, xcc, bst, wid * 64 + lane_id_(), (unsigned)G); }
        const PA a = PA::get(); unsigned char* ws = a.ws(); const int lane = lane_id_(), tid = wid * 64 + lane; (void)tid;
        pg8::Gemm g{(const bf16*)(ws + WS_A1), (const bf16*)(ws + WS_BTIN), 2048, 2048, 2048}; pg8::StaticOrder S; S.init(MROWS, N_INP, G, bx, 2048);
        EpiIn E{ws, a.in(I_LB), a.in(I_ALOG), a.in(I_DTB)};
        pg8::gemm_phase<EpiIn, pg8::StaticOrder, true, true>(lds, g, S, E, wid);
    }
    SEAM(2);
    if (IN(3)) for (int rep_ = 0; rep_ < NREP(3); ++rep_) { if (rep_) { const PA ab = PA::get(); xcd_barrier((unsigned*)ab.ws() + CW_BAR, xcc, bst, wid * 64 + lane_id_(), (unsigned)G); }
        const PA a = PA::get(); unsigned char* ws = a.ws(); const int lane = lane_id_(), tid = wid * 64 + lane; (void)tid;
#ifndef NO_GP
        for (int rr_ = 0; rr_ < NREP(16); ++rr_) for (int u = bx; u < 2048; u += G) gdn_prep_unit(a, lds, u, tid, wid, lane);
#endif
#ifndef NO_HP
        for (int rr_ = 0; rr_ < NREP(17); ++rr_) for (int u = bx; u < 2048; u += G) hgrn_prep_unit(a, lds, u, tid, wid, lane);
#endif
        { const bf16* US = (const bf16*)(ws + WS_US); bf16* UCS = (bf16*)(ws + WS_UCS); const float* cw = a.in(I_CW); const float* cc = a.in(I_CC);
          for (int it = gw; it < 512 * 16; it += NGW) {
            const int row = it >> 4, g = it & 15, c = g * 512 + 8 * lane, t = row & 3, b = row >> 2;
            float x[8];
#pragma unroll
            for (int e = 0; e < 8; ++e) x[e] = 0.f;
#pragma unroll
            for (int j = 0; j < 4; ++j) {
                const int tt = t - 3 + j; float u[8];
                if (tt >= 0) { const u32x4 w = *(const u32x4*)(US + (size_t)(row - 3 + j) * CONVCH + c);
                    u[0] = bflo(w.x); u[1] = bfhi(w.x); u[2] = bflo(w.y); u[3] = bfhi(w.y); u[4] = bflo(w.z); u[5] = bfhi(w.z); u[6] = bflo(w.w); u[7] = bfhi(w.w); }
                else { const f32x4* cp = (const f32x4*)(cc + ((size_t)b * 3 + (3 + tt)) * CONVCH + c); const f32x4 w0 = cp[0], w1 = cp[1];
                    u[0] = w0[0]; u[1] = w0[1]; u[2] = w0[2]; u[3] = w0[3]; u[4] = w1[0]; u[5] = w1[1]; u[6] = w1[2]; u[7] = w1[3]; }
                const f32x4* wp = (const f32x4*)(cw + (size_t)j * CONVCH + c); const f32x4 c0 = wp[0], c1 = wp[1];
                x[0] = fmaf(c0[0], u[0], x[0]); x[1] = fmaf(c0[1], u[1], x[1]); x[2] = fmaf(c0[2], u[2], x[2]); x[3] = fmaf(c0[3], u[3], x[3]);
                x[4] = fmaf(c1[0], u[4], x[4]); x[5] = fmaf(c1[1], u[5], x[5]); x[6] = fmaf(c1[2], u[6], x[6]); x[7] = fmaf(c1[3], u[7], x[7]);
            }
            float ss = 0.f;
#pragma unroll
            for (int e = 0; e < 8; ++e) { x[e] = siluf_(x[e]); ss = fmaf(x[e], x[e], ss); }
            if (g < 8) { ss += __shfl_xor(ss, 1); ss += __shfl_xor(ss, 2); ss += __shfl_xor(ss, 4); ss += __shfl_xor(ss, 8);
                float r = rsqrtf(ss + EPS); if (g < 4) r *= 0.08838834764831845f;
#pragma unroll
                for (int e = 0; e < 8; ++e) x[e] *= r; }
            *(u32x4*)(UCS + (size_t)row * CONVCH + c) = (u32x4){pk2(x[0], x[1]), pk2(x[2], x[3]), pk2(x[4], x[5]), pk2(x[6], x[7])};
          }
          const bf16* UPr = (const bf16*)(ws + WS_UP);
          for (int i = vcu * NTHREADS + tid; i < (12 + 384) * (CONVCH / 8); i += G * NTHREADS) {
            const int rr = i / (CONVCH / 8), c = (i % (CONVCH / 8)) * 8; const bf16* src; float* dst;
            if (rr < 12) { const int b = rr / 3, j = rr % 3; src = UPr + (size_t)(b * SEQ + SEQ - 3 + j) * CONVCH + c; dst = a.out() + O_CCP + (size_t)rr * CONVCH + c; }
            else { const int r2 = rr - 12, b = r2 / 3, j = r2 % 3; src = US + (size_t)(b * DSEQ + 1 + j) * CONVCH + c; dst = a.out() + O_CCS + (size_t)r2 * CONVCH + c; }
            const u32x4 w = *(const u32x4*)src;
            ((f32x4*)dst)[0] = (f32x4){bflo(w.x), bfhi(w.x), bflo(w.y), bfhi(w.y)}; ((f32x4*)dst)[1] = (f32x4){bflo(w.z), bfhi(w.z), bflo(w.w), bfhi(w.w)};
          } }
    }
    SEAM(3);
    if (IN(4)) for (int rep_ = 0; rep_ < NREP(4); ++rep_) { if (rep_) { const PA ab = PA::get(); xcd_barrier((unsigned*)ab.ws() + CW_BAR, xcc, bst, wid * 64 + lane_id_(), (unsigned)G); }
        const PA a = PA::get(); unsigned char* ws = a.ws(); const int lane = lane_id_(), tid = wid * 64 + lane; (void)tid;
        for (int rr_ = 0; rr_ < NREP(19); ++rr_) {
#ifndef NO_GS
        if (bx < 128) gdn_seq_block(a, lds, bx, tid, wid, lane);
#endif
#ifndef NO_HS
        if (bx >= 128 && bx < 192) hgrn_seq_block(a, lds, bx - 128, tid, wid, lane);
#endif
        }
        LAS float* wl = (LAS float*)(lds + wid * 4096);
        unsigned* ctr = (unsigned*)ws + CW_WORK + rep_;
        constexpr int NI_HS = 8192, NI_GS = 16384;
#define SAMPLE_LOAD(itv, SS) do { const int ln_ = lane_id_(); const bool gd_ = (itv) < NI_GS; const int r_ = gd_ ? (itv) : (itv) - NI_GS; \
            const float* s0_ = (gd_ ? a.in(I_SGD) : a.in(I_SHG)) + (size_t)(((r_ >> 2) * 128 + 64 * (ln_ >> 5)) * 128 + 32 * (r_ & 3) + (ln_ & 31)); \
            _Pragma("unroll") for (int j = 0; j < 64; ++j) SS[j] = s0_[j * 128]; } while (0)
#define SAMPLE_RUN(itv, SS) do { const int ln = lane_id_(); if ((itv) < NI_GS) gdn_item(a, wl, (itv) >> 7, ((itv) >> 2) & 31, (itv) & 3, ln, SS); \
            else { const int r = (itv) - NI_GS; hgrn_item(a, wl, r >> 6, (r >> 2) & 15, r & 3, ln, SS); } } while (0)
        {
            volatile LAS int* tk = (volatile LAS int*)(lds + LDS_ST_OFF + 16);
            for (int ri_ = 0; ri_ < NREP(24); ++ri_)
            for (;;) {
                __syncthreads();
                if (wid == 0 && lane_id_() == 0) tk[0] = (int)atomicAdd(ctr + 2 * ri_, 16u);
                __syncthreads();
                const int base = __builtin_amdgcn_readfirstlane(tk[0]);
                if (base >= NI_HS + NI_GS) break;
                const int i0 = base + 2 * wid, i1 = i0 + 1;
                float Sa[64], Sb[64];
                SAMPLE_LOAD(i0, Sa); SAMPLE_LOAD(i1, Sb);
                SAMPLE_RUN(i0, Sa);
                SAMPLE_RUN(i1, Sb);
            }
        }
#undef SAMPLE_RUN
#undef SAMPLE_LOAD
    }
    SEAM(4);
    if (IN(5)) for (int rep_ = 0; rep_ < NREP(5); ++rep_) { if (rep_) { const PA ab = PA::get(); xcd_barrier((unsigned*)ab.ws() + CW_BAR, xcc, bst, wid * 64 + lane_id_(), (unsigned)G); }
        const PA a = PA::get(); unsigned char* ws = a.ws(); const int lane = lane_id_(), tid = wid * 64 + lane; (void)tid;
        const bf16* O16 = (const bf16*)(ws + WS_O16); bf16* OA = (bf16*)(ws + WS_OA); const bf16* Gh = (const bf16*)(ws + WS_GH); const bf16* Gz = (const bf16*)(ws + WS_GZ);
        for (int row = gw; row < MROWS; row += NGW) {
            const u32x4* op = (const u32x4*)(O16 + (size_t)row * 6144) + lane; u32x4* dp = (u32x4*)(OA + (size_t)row * 6144) + lane;
            const u32x4* ghp = (const u32x4*)(Gh + (size_t)row * 2048) + lane; const u32x4* gzp = (const u32x4*)(Gz + (size_t)row * 4096) + lane;
#pragma unroll
            for (int kg = 0; kg < 3; ++kg) {
                u32x4 ov[4], gv[4];
#pragma unroll
                for (int k4 = 0; k4 < 4; ++k4) { const int k = 4 * kg + k4; ov[k4] = op[64 * k]; gv[k4] = kg == 0 ? ghp[64 * k] : gzp[64 * (k - 4)]; }
                const f32x4* np = (const f32x4*)((kg == 0 ? a.in(I_HGN) : a.in(I_GDN)) + 8 * (lane & 15)); const f32x4 n0 = np[0], n1 = np[1];
#pragma unroll
                for (int k4 = 0; k4 < 4; ++k4) {
                    const int k = 4 * kg + k4;
                    float o[8] = {bflo(ov[k4].x), bfhi(ov[k4].x), bflo(ov[k4].y), bfhi(ov[k4].y), bflo(ov[k4].z), bfhi(ov[k4].z), bflo(ov[k4].w), bfhi(ov[k4].w)};
                    const float g[8] = {bflo(gv[k4].x), bfhi(gv[k4].x), bflo(gv[k4].y), bfhi(gv[k4].y), bflo(gv[k4].z), bfhi(gv[k4].z), bflo(gv[k4].w), bfhi(gv[k4].w)};
                    float ss = 0.f;
#pragma unroll
                    for (int e = 0; e < 8; ++e) ss = fmaf(o[e], o[e], ss);
                    ss += __shfl_xor(ss, 1); ss += __shfl_xor(ss, 2); ss += __shfl_xor(ss, 4); ss += __shfl_xor(ss, 8);
                    const float r = rsqrtf(ss * (1.f / 128.f) + EPS);
                    dp[64 * k] = (u32x4){pk2(o[0] * r * n0[0] * g[0], o[1] * r * n0[1] * g[1]), pk2(o[2] * r * n0[2] * g[2], o[3] * r * n0[3] * g[3]),
                                         pk2(o[4] * r * n1[0] * g[4], o[5] * r * n1[1] * g[5]), pk2(o[6] * r * n1[2] * g[6], o[7] * r * n1[3] * g[7])};
                }
                asm volatile("" ::: "memory");
            }
        }
    }
    SEAM(5);
    if (IN(6)) for (int rep_ = 0; rep_ < NREP(6); ++rep_) { if (rep_) { const PA ab = PA::get(); xcd_barrier((unsigned*)ab.ws() + CW_BAR, xcc, bst, wid * 64 + lane_id_(), (unsigned)G); }
        const PA a = PA::get(); unsigned char* ws = a.ws();
        pg8::Gemm g{(const bf16*)(ws + WS_OA), (const bf16*)(ws + WS_BTOUT), 6144, 6144, 6144}; TailOrder S; S.init(G, bx, 2, 0, 32, 2048, 64);
        EpiOutC E{(float*)(ws + WS_T1), (const bf16*)(ws + WS_SA), (const bf16*)(ws + WS_SB), (bf16*)(ws + WS_MG), (float*)(ws + WS_SLO)};
        pg8::gemm_phase<EpiOutC, TailOrder, true, true>(lds, g, S, E, wid);
    }
    SEAM(6);
    if (IN(7)) for (int rep_ = 0; rep_ < NREP(7); ++rep_) { if (rep_) { const PA ab = PA::get(); xcd_barrier((unsigned*)ab.ws() + CW_BAR, xcc, bst, wid * 64 + lane_id_(), (unsigned)G); }
        const PA a = PA::get(); unsigned char* ws = a.ws(); const int lane = lane_id_(), tid = wid * 64 + lane;
        const float* SL = (const float*)(ws + WS_SLO); bf16* MG = (bf16*)(ws + WS_MG) + (size_t)NPROMPT * 2048;
        for (int i = vcu * NTHREADS + tid; i < 512 * 2048 / 8; i += G * NTHREADS) {
            f32x4 s0 = {0.f, 0.f, 0.f, 0.f}, s1 = {0.f, 0.f, 0.f, 0.f};
#pragma unroll 8
            for (int k = 0; k < 32; ++k) { const f32x4* p = (const f32x4*)(SL + (size_t)k * 512 * 2048 + (size_t)i * 8); s0 += p[0]; s1 += p[1]; }
            *(u32x4*)(MG + (size_t)i * 8) = (u32x4){pk2(s0[0], s0[1]), pk2(s0[2], s0[3]), pk2(s1[0], s1[1]), pk2(s1[2], s1[3])};
        }
    }
    SEAM(7);
    if (IN(8)) for (int rep_ = 0; rep_ < NREP(8); ++rep_) { if (rep_) { const PA ab = PA::get(); xcd_barrier((unsigned*)ab.ws() + CW_BAR, xcc, bst, wid * 64 + lane_id_(), (unsigned)G); }
        const PA a = PA::get(); unsigned char* ws = a.ws();
        pg8::Gemm g{(const bf16*)(ws + WS_MG), (const bf16*)(ws + WS_BTO), 2048, 2048, 2048}; TailOrder S; S.init(G, bx, 1, 0, 32, 0, 0);
        EpiF32S E{(float*)(ws + WS_MIX), (float*)(ws + WS_SLW)};
        pg8::gemm_phase<EpiF32S, TailOrder, true, true>(lds, g, S, E, wid);
    }
    SEAM(8);
    if (IN(9)) for (int rep_ = 0; rep_ < NREP(9); ++rep_) { if (rep_) { const PA ab = PA::get(); xcd_barrier((unsigned*)ab.ws() + CW_BAR, xcc, bst, wid * 64 + lane_id_(), (unsigned)G); }
        const PA a = PA::get(); unsigned char* ws = a.ws(); const int lane = lane_id_(), tid = wid * 64 + lane; (void)tid;
        const float* mod = (const float*)(ws + WS_MOD); const float* ng = a.in(I_NG); bf16* A1 = (bf16*)(ws + WS_A1); const float* MIX = (const float*)(ws + WS_MIX); float* H = (float*)(ws + WS_H);
        for (int row = gw; row < MROWS; row += NGW) {
            const f32x4* xr = (const f32x4*)xrow_ptr(a, row) + lane; const f32x4* mr = (const f32x4*)(MIX + (size_t)row * DM) + lane; const float* md = mod + (size_t)seq_of_row(row) * NADA;
            f32x4 v[8]; float ss = 0.f;
#pragma unroll
            for (int j = 0; j < 8; ++j) {
                if (row < NPROMPT) v[j] = mr[64 * j];
                else { const f32x4* sp = (const f32x4*)(ws + WS_SLW) + (size_t)(row - NPROMPT) * 512 + lane + 64 * j; f32x4 t = sp[0];
#pragma unroll
                    for (int k = 1; k < 16; ++k) t += sp[(size_t)k * 512 * 512]; v[j] = t; }
                ss += (v[j][0] * v[j][0] + v[j][1] * v[j][1]) + (v[j][2] * v[j][2] + v[j][3] * v[j][3]); }
            const float r1 = rsqrtf(wave_sum(ss) * (1.f / DM) + EPS);
            f32x4* ho = (f32x4*)(H + (size_t)row * DM) + lane; float s2 = 0.f;
#pragma unroll
            for (int j = 0; j < 8; ++j) { const int c = 4 * lane + 256 * j; const f32x4 g = *(const f32x4*)(ng + 2048 + c), g1 = *(const f32x4*)(md + 4096 + c), x = xr[64 * j];
                _Pragma("unroll") for (int e = 0; e < 4; ++e) { v[j][e] = x[e] + g1[e] * (v[j][e] * r1 * g[e]); s2 += v[j][e] * v[j][e]; }
                ho[64 * j] = v[j]; }
            const float r2 = rsqrtf(wave_sum(s2) * (1.f / DM) + EPS);
            u32x2* o = (u32x2*)(A1 + (size_t)row * DM) + lane;
#pragma unroll
            for (int j = 0; j < 8; ++j) { const int c = 4 * lane + 256 * j; const f32x4 g = *(const f32x4*)(ng + 4096 + c), sh = *(const f32x4*)(md + 6144 + c), sc = *(const f32x4*)(md + 8192 + c);
                f32x4 y; _Pragma("unroll") for (int e = 0; e < 4; ++e) y[e] = v[j][e] * r2 * g[e] * (1.f + sc[e]) + sh[e];
                o[64 * j] = (u32x2){pk2(y[0], y[1]), pk2(y[2], y[3])}; }
        }
    }
    SEAM(9);
    if (IN(10)) for (int rep_ = 0; rep_ < NREP(10); ++rep_) { if (rep_) { const PA ab = PA::get(); xcd_barrier((unsigned*)ab.ws() + CW_BAR, xcc, bst, wid * 64 + lane_id_(), (unsigned)G); }
        const PA a = PA::get(); unsigned char* ws = a.ws(); const int lane = lane_id_(), tid = wid * 64 + lane; (void)tid;
        pg8::Gemm g{(const bf16*)(ws + WS_A1), (const bf16*)(ws + WS_BTUP), 2048, 2048, 2048}; pg8::StaticOrder S; S.init(MROWS, DFF, G, bx, 2048);
        EpiRelu2 E{(bf16*)(ws + WS_U2), DFF};
        pg8::gemm_phase<EpiRelu2, pg8::StaticOrder, true, true>(lds, g, S, E, wid);
    }
    SEAM(10);
    if (IN(11)) for (int rep_ = 0; rep_ < NREP(11); ++rep_) { if (rep_) { const PA ab = PA::get(); xcd_barrier((unsigned*)ab.ws() + CW_BAR, xcc, bst, wid * 64 + lane_id_(), (unsigned)G); }
        const PA a = PA::get(); unsigned char* ws = a.ws(); const int lane = lane_id_(), tid = wid * 64 + lane; (void)tid;
        pg8::Gemm g{(const bf16*)(ws + WS_U2), (const bf16*)(ws + WS_BTDN), DFF, DFF, DFF}; TailOrder S; S.init(G, bx, 1, 0, 128, 0, 0);
        EpiF32S E{(float*)(ws + WS_FF), (float*)(ws + WS_SLD)};
        pg8::gemm_phase<EpiF32S, TailOrder, true, true>(lds, g, S, E, wid);
    }
    SEAM(11);
    if (IN(12)) for (int rep_ = 0; rep_ < NREP(12); ++rep_) { if (rep_) { const PA ab = PA::get(); xcd_barrier((unsigned*)ab.ws() + CW_BAR, xcc, bst, wid * 64 + lane_id_(), (unsigned)G); }
        const PA a = PA::get(); unsigned char* ws = a.ws(); const int lane = lane_id_(), tid = wid * 64 + lane; (void)tid;
        const float* mod = (const float*)(ws + WS_MOD); const float* ng = a.in(I_NG); const float* FF = (const float*)(ws + WS_FF); const float* H = (const float*)(ws + WS_H);
        for (int row = gw; row < MROWS; row += NGW) {
            const f32x4* fr_ = (const f32x4*)(FF + (size_t)row * DM) + lane; const f32x4* hr = (const f32x4*)(H + (size_t)row * DM) + lane; const float* md = mod + (size_t)seq_of_row(row) * NADA;
            f32x4 v[8]; float ss = 0.f;
#pragma unroll
            for (int j = 0; j < 8; ++j) {
                if (row < NPROMPT) v[j] = fr_[64 * j];
                else { const f32x4* sp = (const f32x4*)(ws + WS_SLD) + (size_t)(row - NPROMPT) * 512 + lane + 64 * j; f32x4 t = sp[0];
#pragma unroll
                    for (int k = 1; k < 16; ++k) t += sp[(size_t)k * 512 * 512]; v[j] = t; }
                ss += (v[j][0] * v[j][0] + v[j][1] * v[j][1]) + (v[j][2] * v[j][2] + v[j][3] * v[j][3]); }
            const float r = rsqrtf(wave_sum(ss) * (1.f / DM) + EPS);
            f32x4* yo = (f32x4*)(a.out() + O_Y + (size_t)row * DM) + lane;
#pragma unroll
            for (int j = 0; j < 8; ++j) { const int c = 4 * lane + 256 * j; const f32x4 g = *(const f32x4*)(ng + 6144 + c), g2 = *(const f32x4*)(md + 10240 + c), h = hr[64 * j];
                f32x4 y; _Pragma("unroll") for (int e = 0; e < 4; ++e) y[e] = h[e] + g2[e] * (v[j][e] * r * g[e]);
                yo[64 * j] = y; }
        }
    }
#undef IN
#undef SEAM
}

constexpr int N_PHASES = 13;
extern "C" void kernel_launch(void* const* d_in, const int* in_sizes, int n_in, void* d_out, int out_size, void* d_ws, size_t ws_size, hipStream_t stream) {
    static int grid = 0;
    if (grid == 0) {
        if (n_in != 22 || (size_t)out_size != O_END || ws_size < WS_END) { fprintf(stderr, "kernel_launch: unexpected shapes: n_in %d out %d ws %zu\n", n_in, out_size, ws_size); grid = -1; return; }
        int dev = 0, cus = 0, per_cu = 0;
        if (hipGetDevice(&dev) != hipSuccess || hipDeviceGetAttribute(&cus, hipDeviceAttributeMultiprocessorCount, dev) != hipSuccess) { grid = -1; return; }
        if (hipFuncSetAttribute((const void*)fwd, hipFuncAttributeMaxDynamicSharedMemorySize, LDS_BYTES) != hipSuccess) { fprintf(stderr, "kernel_launch: hipFuncSetAttribute failed\n"); grid = -1; return; }
        if (hipOccupancyMaxActiveBlocksPerMultiprocessor(&per_cu, (const void*)fwd, NTHREADS, LDS_BYTES) != hipSuccess || per_cu < 1) { fprintf(stderr, "kernel_launch: occupancy query says %d\n", per_cu); (void)hipGetLastError(); per_cu = 1; }
        grid = cus;
    }
    if (grid < 0) return;
    if (hipMemsetAsync(d_ws, 0, CTL_ZERO_BYTES, stream) != hipSuccess) { fprintf(stderr, "kernel_launch: memset failed\n"); return; }
    Args a{};
    for (int i = 0; i < 22; ++i) a.in[i] = (const float*)d_in[i];
    a.out = (float*)d_out; a.ws = (unsigned char*)d_ws;
#ifdef MULTI_LAUNCH
    for (int p = 0; p < N_PHASES; ++p) { a.ph_lo = p; a.ph_hi = p + 1; hipLaunchKernelGGL(fwd, dim3(grid), dim3(NTHREADS), LDS_BYTES, stream, a); }
#else
    a.ph_lo = 0; a.ph_hi = N_PHASES;
    void* args[] = {&a};
    hipError_t e = hipLaunchCooperativeKernel((const void*)fwd, dim3(grid), dim3(NTHREADS), args, LDS_BYTES, stream);
    if (e != hipSuccess) fprintf(stderr, "cooperative launch failed: %s (grid %d)\n", hipGetErrorString(e), grid);
#endif
}
```

```cpp
#include <hip/hip_runtime.h>
#include <hip/hip_cooperative_groups.h>
#include <cstdio>
#include <cstdint>
namespace cg = cooperative_groups;
__device__ __forceinline__ int lane_id_() { int l; asm volatile("v_mbcnt_lo_u32_b32 %0, -1, 0\n\tv_mbcnt_hi_u32_b32 %0, -1, %0" : "=v"(l)); return l; }
#ifndef REP_MASK
#define REP_MASK 0
#endif
#define NREP(k) (1 + ((REP_MASK >> (k)) & 1))
namespace pg8 {
#define PG8_LAS __attribute__((address_space(3)))
typedef unsigned short bf16_t;
typedef short bf16x8 __attribute__((ext_vector_type(8)));
typedef float f32x4 __attribute__((ext_vector_type(4)));
typedef unsigned u32x4 __attribute__((ext_vector_type(4)));
constexpr int BM = 256, BK = 64, HALF = 128, HTB = HALF * BK * 2  , STAGE_BYTES = 8 * HTB, NXCD = 8, WGM = 8;

__host__ __device__ __forceinline__ int lds_byte(int r, int c) { const int st = (r >> 4) * 2 + (c >> 5), rr = r & 15, cc = c & 31, ob = rr * 64 + cc * 2; return st * 1024 + (ob ^ (((ob >> 9) & 1) << 5)); }
__host__ __device__ __forceinline__ void stage_rc(int b, int& R, int& C) { const int st = b / 1024, sb = b % 1024, swz = sb ^ (((sb >> 9) & 1) << 5); R = (st >> 1) * 16 + swz / 64; C = (st & 1) * 32 + (swz % 64) / 2; }
__host__ __device__ __forceinline__ int perm32(int rho) { const int n = rho >> 4, i = rho & 15; return 8 * (i >> 2) + 4 * n + (i & 3); }

struct Unit { int pm, pn, k0, nt, kind; };
struct Gemm { const bf16_t* A; const bf16_t* Bt; int lda, ldb, K; };

struct StaticOrder {
    int nM, nN, nwg, G, c, ntk;
    __host__ __device__ void init(int M, int N, int G_, int c_, int K_) { nM = M / BM; nN = N / BM; nwg = nM * nN; G = G_; c = c_; ntk = K_ / BK; }
    __host__ __device__ bool next(int i, Unit& u) const {
        const long L = (long)i * G + c; if (L >= nwg) return false;
        int wgid = (int)L; { const int q = nwg / NXCD, r = nwg % NXCD, xcd = wgid % NXCD, off = wgid / NXCD; wgid = (xcd < r ? xcd * (q + 1) : r * (q + 1) + (xcd - r) * q) + off; }
        const int nig = WGM * nN, gid = wgid / nig, fm = gid * WGM, gsz = (nM - fm) < WGM ? (nM - fm) : WGM;
        u.pm = fm + ((wgid % nig) % gsz); u.pn = (wgid % nig) / gsz; u.k0 = 0; u.nt = ntk; u.kind = 0; return true;
    }
    __device__ __forceinline__ void a_ready(const Unit&) const {}
    __device__ __forceinline__ void done(const Unit&) const {}
};

__device__ __forceinline__ unsigned cvt_pk_bf16(float lo, float hi) { unsigned r; asm volatile("v_cvt_pk_bf16_f32 %0, %1, %2" : "=v"(r) : "v"(lo), "v"(hi)); return r; }

template <class Epi, class Sched, bool ALIGN_EPI = false, bool SP2 = false>
__device__ __forceinline__ void gemm_phase(PG8_LAS unsigned char* lds, const Gemm g, const Sched& S, const Epi& E, int wid_in) {
    const int wid = wid_in, lane = lane_id_(), tid = wid * 64 + lane, wr = wid >> 2, wc = wid & 3, fr = lane & 15, fq = lane >> 4;
    unsigned voffA[2], voffB[2];
#pragma unroll
    for (int i = 0; i < 2; ++i) { int R, C; stage_rc(tid * 16 + i * 8192, R, C); const int Rb = Epi::PERM ? ((R & ~31) + perm32(R & 31)) : R;
        voffA[i] = (unsigned)(R * g.lda + C) * 2u; voffB[i] = (unsigned)(Rb * g.ldb + C) * 2u; }
    const size_t kstep = (size_t)(BK * 2);
    const size_t hstepA = (size_t)HALF * g.lda * 2, hstepB = (size_t)HALF * g.ldb * 2;
    const size_t tstepA = 2 * hstepA, tstepB = 2 * hstepB;
    const unsigned ldsw = (unsigned)wid * 1024u;
    const int aoff = lds_byte(wr * 64 + fr, fq * 8), boff = lds_byte(wc * 32 + fr, fq * 8);
#define PG8_SA(b, h) (((b) * 2 + (h)) * HTB)
#define PG8_SB(b, h) ((4 + (b) * 2 + (h)) * HTB)
#define PG8_STAGE(bufoff, gbase, voff) do { _Pragma("unroll") for (int _i = 0; _i < 2; ++_i) \
        __builtin_amdgcn_global_load_lds((const unsigned*)((const char*)(gbase) + (voff)[_i]), (PG8_LAS unsigned*)(lds + (bufoff) + ldsw + _i * 8192), 16, 0, 0); } while (0)
#define PG8_LDA(dst, b, h) do { _Pragma("unroll") for (int m = 0; m < 4; ++m) _Pragma("unroll") for (int k = 0; k < 2; ++k) dst[m][k] = *(const PG8_LAS bf16x8*)(lds + PG8_SA(b, h) + aoff + m * 2048 + k * 1024); } while (0)
#define PG8_LDB(dst, b, h) do { _Pragma("unroll") for (int n = 0; n < 2; ++n) _Pragma("unroll") for (int k = 0; k < 2; ++k) dst[n][k] = *(const PG8_LAS bf16x8*)(lds + PG8_SB(b, h) + boff + n * 2048 + k * 1024); } while (0)
#define PG8_MMA(ai, bj, At, Bt) do { __builtin_amdgcn_s_setprio(1); _Pragma("unroll") for (int m = 0; m < 4; ++m) _Pragma("unroll") for (int n = 0; n < 2; ++n) _Pragma("unroll") for (int k = 0; k < 2; ++k) \
        acc[ai][bj][m][n] = __builtin_amdgcn_mfma_f32_16x16x32_bf16(Bt[n][k], At[m][k], acc[ai][bj][m][n], 0, 0, 0); __builtin_amdgcn_s_setprio(0); } while (0)
#define PG8_WAIT_V(n) asm volatile("s_waitcnt vmcnt(" #n ")" ::: "memory")
#define PG8_WAIT_L(n) asm volatile("s_waitcnt lgkmcnt(" #n ")" ::: "memory")
#define PG8_BAR __builtin_amdgcn_s_barrier()
#define PG8_SCHED __builtin_amdgcn_sched_barrier(0)
    Unit cur, nxt; int ui = 0;
    if (!S.next(0, cur)) return;
    f32x4 acc[2][2][4][2];
#pragma unroll
    for (int a = 0; a < 2; ++a)
#pragma unroll
        for (int b = 0; b < 2; ++b)
#pragma unroll
            for (int m = 0; m < 4; ++m)
#pragma unroll
                for (int n = 0; n < 2; ++n) acc[a][b][m][n] = (f32x4){0.f, 0.f, 0.f, 0.f};
    bf16x8 At[4][2], B0[2][2], B1[2][2];
    const char* cA = (const char*)g.A + (size_t)cur.pm * tstepA + (size_t)cur.k0 * 2; const char* cB = (const char*)g.Bt + (size_t)cur.pn * tstepB + (size_t)cur.k0 * 2;
    S.a_ready(cur);
    if constexpr (SP2) {
        PG8_STAGE(PG8_SB(0, 0), cB, voffB); PG8_STAGE(PG8_SB(0, 1), cB + hstepB, voffB); PG8_STAGE(PG8_SA(0, 0), cA, voffA); PG8_STAGE(PG8_SA(0, 1), cA + hstepA, voffA);
        if (wr == 1) PG8_BAR;
        PG8_WAIT_V(2); PG8_BAR;
        PG8_STAGE(PG8_SB(1, 0), cB + kstep, voffB); PG8_STAGE(PG8_SA(1, 0), cA + kstep, voffA); PG8_STAGE(PG8_SB(1, 1), cB + hstepB + kstep, voffB);
        PG8_WAIT_V(6); PG8_BAR;
    } else {
        PG8_STAGE(PG8_SB(0, 0), cB, voffB); PG8_STAGE(PG8_SA(0, 0), cA, voffA); PG8_STAGE(PG8_SB(0, 1), cB + hstepB, voffB); PG8_STAGE(PG8_SA(0, 1), cA + hstepA, voffA);
        if (wr == 1) PG8_BAR;
        PG8_WAIT_V(4); PG8_BAR;
        PG8_STAGE(PG8_SB(1, 0), cB + kstep, voffB); PG8_STAGE(PG8_SA(1, 0), cA + kstep, voffA); PG8_STAGE(PG8_SB(1, 1), cB + hstepB + kstep, voffB);
        PG8_WAIT_V(6); PG8_BAR;
    }
    for (;;) {
        const bool has_next = S.next(ui + 1, nxt);
        const char* nA = has_next ? (const char*)g.A + (size_t)nxt.pm * tstepA + (size_t)nxt.k0 * 2 : cA; const char* nB = has_next ? (const char*)g.Bt + (size_t)nxt.pn * tstepB + (size_t)nxt.k0 * 2 : cB;
        const int nt = cur.nt;
        for (int t = 0; t < nt; t += 2) {
            const bool last = (t == nt - 2);
            const char* a1 = cA + (size_t)(t + 1) * kstep;
            const char* a2 = last ? nA : cA + (size_t)(t + 2) * kstep; const char* b2 = last ? nB : cB + (size_t)(t + 2) * kstep;
            const char* a3 = a2 + kstep; const char* b3 = b2 + kstep;
            if (last && has_next) S.a_ready(nxt);
            if constexpr (SP2) {
            PG8_LDB(B0, 0, 0); PG8_LDB(B1, 0, 1); PG8_SCHED; PG8_LDA(At, 0, 0); PG8_STAGE(PG8_SA(1, 1), a1 + hstepA, voffA);
            PG8_WAIT_V(8); PG8_WAIT_L(0); PG8_BAR; PG8_MMA(0, 0, At, B0); PG8_MMA(0, 1, At, B1); PG8_BAR; PG8_SCHED;
            PG8_LDA(At, 0, 1); PG8_STAGE(PG8_SB(0, 0), b2, voffB); PG8_STAGE(PG8_SB(0, 1), b2 + hstepB, voffB); PG8_STAGE(PG8_SA(0, 0), a2, voffA);
            PG8_WAIT_V(8); PG8_WAIT_L(0); PG8_BAR; PG8_MMA(1, 0, At, B0); PG8_MMA(1, 1, At, B1); PG8_BAR; PG8_SCHED;
            PG8_LDB(B0, 1, 0); PG8_LDB(B1, 1, 1); PG8_SCHED; PG8_LDA(At, 1, 0); PG8_STAGE(PG8_SA(0, 1), a2 + hstepA, voffA);
            PG8_WAIT_V(8); PG8_WAIT_L(0); PG8_BAR; PG8_MMA(0, 0, At, B0); PG8_MMA(0, 1, At, B1); PG8_BAR; PG8_SCHED;
            PG8_LDA(At, 1, 1); PG8_STAGE(PG8_SB(1, 0), b3, voffB); PG8_STAGE(PG8_SB(1, 1), b3 + hstepB, voffB); PG8_STAGE(PG8_SA(1, 0), a3, voffA);
            PG8_WAIT_V(8); PG8_WAIT_L(0); PG8_BAR; PG8_MMA(1, 0, At, B0); PG8_MMA(1, 1, At, B1); PG8_BAR; PG8_SCHED;
            } else {
            PG8_LDB(B0, 0, 0); PG8_SCHED; PG8_LDA(At, 0, 0); PG8_STAGE(PG8_SA(1, 1), a1 + hstepA, voffA);
            PG8_WAIT_L(8); PG8_BAR; PG8_WAIT_L(0); PG8_MMA(0, 0, At, B0); PG8_BAR; PG8_SCHED;
            PG8_LDB(B1, 0, 1); PG8_STAGE(PG8_SB(0, 0), b2, voffB);
            PG8_BAR; PG8_WAIT_L(0); PG8_MMA(0, 1, At, B1); PG8_BAR;
            PG8_LDA(At, 0, 1); PG8_STAGE(PG8_SA(0, 0), a2, voffA);
            PG8_BAR; PG8_WAIT_L(0); PG8_MMA(1, 0, At, B0); PG8_BAR; PG8_SCHED;
            PG8_STAGE(PG8_SB(0, 1), b2 + hstepB, voffB);
            PG8_WAIT_V(6); PG8_BAR; PG8_MMA(1, 1, At, B1); PG8_BAR;
            PG8_LDB(B0, 1, 0); PG8_SCHED; PG8_LDA(At, 1, 0); PG8_STAGE(PG8_SA(0, 1), a2 + hstepA, voffA);
            PG8_WAIT_L(8); PG8_BAR; PG8_WAIT_L(0); PG8_MMA(0, 0, At, B0); PG8_BAR; PG8_SCHED;
            PG8_LDB(B1, 1, 1); PG8_STAGE(PG8_SB(1, 0), b3, voffB);
            PG8_BAR; PG8_WAIT_L(0); PG8_MMA(0, 1, At, B1); PG8_BAR;
            PG8_LDA(At, 1, 1); PG8_STAGE(PG8_SA(1, 0), a3, voffA);
            PG8_BAR; PG8_WAIT_L(0); PG8_MMA(1, 0, At, B0); PG8_BAR; PG8_SCHED;
            PG8_STAGE(PG8_SB(1, 1), b3 + hstepB, voffB);
            PG8_WAIT_V(6); PG8_BAR; PG8_MMA(1, 1, At, B1); PG8_BAR;
            }
        }
        if constexpr (ALIGN_EPI) { if (wr == 0) PG8_BAR; }
        if constexpr (!Epi::AFTER_DRAIN) { for (int re_ = 0; re_ < NREP(27); ++re_) E(acc, cur, wr, wc, fr, fq); S.done(cur); }
        if (!has_next) break;
#pragma unroll
        for (int a = 0; a < 2; ++a)
#pragma unroll
            for (int b = 0; b < 2; ++b)
#pragma unroll
                for (int m = 0; m < 4; ++m)
#pragma unroll
                    for (int n = 0; n < 2; ++n) acc[a][b][m][n] = (f32x4){0.f, 0.f, 0.f, 0.f};
        cur = nxt; cA = nA; cB = nB; ++ui;
        if constexpr (ALIGN_EPI) { if (wr == 1) PG8_BAR; }
    }
    PG8_WAIT_V(0);
    if constexpr (!ALIGN_EPI) { if (wr == 0) PG8_BAR; }
    PG8_BAR;
    if constexpr (Epi::AFTER_DRAIN) { E.fused(acc, cur, wr, wc, fr, fq, lds, wid, lane); S.done(cur); }
#undef PG8_SA
#undef PG8_SB
#undef PG8_STAGE
#undef PG8_LDA
#undef PG8_LDB
#undef PG8_MMA
#undef PG8_WAIT_V
#undef PG8_WAIT_L
#undef PG8_BAR
#undef PG8_SCHED
}
}


#define LAS __attribute__((address_space(3)))
typedef unsigned short bf16;
typedef float f32x4 __attribute__((ext_vector_type(4)));
typedef float f32x2 __attribute__((ext_vector_type(2)));
typedef short bf16x8 __attribute__((ext_vector_type(8)));
typedef unsigned u32x4 __attribute__((ext_vector_type(4)));
typedef unsigned u32x2 __attribute__((ext_vector_type(2)));

constexpr int NWAVES = 8, NTHREADS = 512;
constexpr int DM = 2048, MROWS = 8704, NPROMPT = 8192, NSEQ = 132, SEQ = 2048, DSEQ = 4;
constexpr int N_IN = 24640, N_INP = 24832, CONVCH = 8192, DFF = 8192, NADA = 12288;
constexpr float EPS = 1e-6f;
constexpr int LDS_BYTES = 147456;

enum { I_XP = 0, I_XS, I_SHG, I_SGD, I_CC, I_CP, I_CS, I_LB, I_WADA, I_BADA, I_NG, I_WIN, I_CW, I_ALOG, I_DTB, I_HGN, I_GDN, I_WOHG, I_WOGD, I_WO, I_WUP, I_WDN };
constexpr size_t O_Y = 0, O_HGP = 17825792, O_GDP = 18874368, O_CCP = 20971520, O_HGS = 21069824, O_GDS = 54624256, O_CCS = 121733120, O_END = 124878848;
constexpr size_t MiB = 1u << 20;
constexpr size_t WS_MOD = 1 * MiB, WS_BTOUT = 8 * MiB, WS_BTO = 32 * MiB, WS_BTUP = 40 * MiB, WS_BTDN = 72 * MiB, WS_BTIN = 104 * MiB, WS_A1 = 201 * MiB;
constexpr size_t WS_QHP = 235 * MiB, WS_FP = 267 * MiB, WS_IP = 331 * MiB, WS_UP = 363 * MiB, WS_GH = 491 * MiB, WS_GZ = 525 * MiB, WS_SA = 593 * MiB, WS_SB = 627 * MiB, WS_BL = 661 * MiB;
constexpr size_t WS_QHS = 664 * MiB, WS_FS = 666 * MiB, WS_IS = 670 * MiB, WS_US = 672 * MiB;
constexpr size_t WS_GREC = 680 * MiB, WS_HREC = 104 * MiB, WS_UCS = 218 * MiB, WS_O16 = 235 * MiB;
constexpr size_t WS_OA = 363 * MiB, WS_T1 = 680 * MiB, WS_MG = 748 * MiB, WS_MIX = 782 * MiB, WS_H = 850 * MiB, WS_U2 = 235 * MiB, WS_FF = 782 * MiB;
constexpr size_t WS_SLO = 465 * MiB, WS_SLW = 104 * MiB, WS_SLD = 465 * MiB;
constexpr size_t WS_END = 970 * MiB;

__device__ __forceinline__ unsigned f2bf(float f) { unsigned u = __float_as_uint(f); return (u + 0x7fffu + ((u >> 16) & 1u)) >> 16; }
typedef float f32x2c_t __attribute__((ext_vector_type(2))); typedef __bf16 bf16x2c_t __attribute__((ext_vector_type(2)));
__device__ __forceinline__ unsigned pk2(float lo, float hi) { f32x2c_t v = {lo, hi}; bf16x2c_t b = __builtin_convertvector(v, bf16x2c_t); return __builtin_bit_cast(unsigned, b); }
__device__ __forceinline__ float bf2f(unsigned h) { return __uint_as_float(h << 16); }
__device__ __forceinline__ float bflo(unsigned w) { return __uint_as_float(w << 16); }
__device__ __forceinline__ float bfhi(unsigned w) { return __uint_as_float(w & 0xffff0000u); }
__device__ __forceinline__ float sigmoidf_(float x) { return __builtin_amdgcn_rcpf(1.0f + __expf(-x)); }
__device__ __forceinline__ float siluf_(float x) { return x * sigmoidf_(x); }
__device__ __forceinline__ float wave_sum(float v) {
#pragma unroll
    for (int o = 1; o < 64; o <<= 1) v += __shfl_xor(v, o);
    return v;
}
__device__ __forceinline__ float wave_sum_sw(float v) {
    v += __builtin_bit_cast(float, __builtin_amdgcn_ds_swizzle(__builtin_bit_cast(int, v), (1 << 10) | 0x1f));
    v += __builtin_bit_cast(float, __builtin_amdgcn_ds_swizzle(__builtin_bit_cast(int, v), (2 << 10) | 0x1f));
    v += __builtin_bit_cast(float, __builtin_amdgcn_ds_swizzle(__builtin_bit_cast(int, v), (4 << 10) | 0x1f));
    v += __builtin_bit_cast(float, __builtin_amdgcn_ds_swizzle(__builtin_bit_cast(int, v), (8 << 10) | 0x1f));
    v += __builtin_bit_cast(float, __builtin_amdgcn_ds_swizzle(__builtin_bit_cast(int, v), (16 << 10) | 0x1f));
    return __builtin_bit_cast(float, __builtin_amdgcn_readlane(__builtin_bit_cast(int, v), 0)) + __builtin_bit_cast(float, __builtin_amdgcn_readlane(__builtin_bit_cast(int, v), 32));
}
#define LDS_WAIT() asm volatile("s_waitcnt lgkmcnt(0)" ::: "memory")

struct Args { const float* in[22]; float* out; unsigned char* ws; int ph_lo, ph_hi; };
typedef __attribute__((address_space(4))) const unsigned char* kargp_t;
struct PA {
    kargp_t kp;
    static __device__ __forceinline__ PA get() { PA p; p.kp = (kargp_t)__builtin_amdgcn_kernarg_segment_ptr(); asm volatile("" : "+s"(p.kp)); return p; }
    __device__ __forceinline__ const float* in(int i) const { typedef const float* cfp; return ((__attribute__((address_space(4))) const cfp*)kp)[i]; }
    __device__ __forceinline__ float* out() const { typedef float* fp; return *((__attribute__((address_space(4))) const fp*)(kp + 176)); }
    __device__ __forceinline__ unsigned char* ws() const { typedef unsigned char* up; return *((__attribute__((address_space(4))) const up*)(kp + 184)); }
    __device__ __forceinline__ int ph_lo() const { return *((__attribute__((address_space(4))) const int*)(kp + 192)); }
    __device__ __forceinline__ int ph_hi() const { return *((__attribute__((address_space(4))) const int*)(kp + 196)); }
};
static_assert(sizeof(Args) == 200, "Args layout");
__device__ __forceinline__ bool ph_in(int k) { const PA p = PA::get(); return p.ph_lo() <= k && k < p.ph_hi(); }

template <int MODE> __device__ __forceinline__ float actf(float v) {
    if (MODE == 1) return siluf_(v);
    if (MODE == 2) return sigmoidf_(v);
    if (MODE == 3) { const float r = fmaxf(v, 0.f); return r * r; }
    return v;
}
template <int MODE> __device__ __forceinline__ void tile_store_bf16(const f32x4 (&acc)[2][2][4][2], bf16* base, int ld, int row0, int col0) {
#pragma unroll
    for (int ai = 0; ai < 2; ++ai)
#pragma unroll
        for (int m = 0; m < 4; ++m) {
            bf16* rowp = base + (size_t)(row0 + ai * 128 + m * 16) * ld + col0;
#pragma unroll
            for (int bj = 0; bj < 2; ++bj) {
                const f32x4 v0 = acc[ai][bj][m][0], v1 = acc[ai][bj][m][1];
                u32x4 w;
                w.x = pk2(actf<MODE>(v0[0]), actf<MODE>(v0[1])); w.y = pk2(actf<MODE>(v0[2]), actf<MODE>(v0[3]));
                w.z = pk2(actf<MODE>(v1[0]), actf<MODE>(v1[1])); w.w = pk2(actf<MODE>(v1[2]), actf<MODE>(v1[3]));
                *(u32x4*)(rowp + bj * 128) = w;
            }
        }
}
__device__ __forceinline__ void tile_store_f32(const f32x4 (&acc)[2][2][4][2], float* base, int ld, int row0, int col0) {
#pragma unroll
    for (int ai = 0; ai < 2; ++ai)
#pragma unroll
        for (int m = 0; m < 4; ++m) {
            float* rowp = base + (size_t)(row0 + ai * 128 + m * 16) * ld + col0;
#pragma unroll
            for (int bj = 0; bj < 2; ++bj) { *(f32x4*)(rowp + bj * 128) = acc[ai][bj][m][0]; *(f32x4*)(rowp + bj * 128 + 4) = acc[ai][bj][m][1]; }
        }
}

struct EpiIn {
    static constexpr bool PERM = true, AFTER_DRAIN = false;
    unsigned char* ws; const float *lbl, *alog, *dtb;
    __device__ __forceinline__ void operator()(const f32x4 (&acc)[2][2][4][2], const pg8::Unit& u, int wr, int wc, int fr, int fq) const {
        const int pn = u.pn, row0 = u.pm * 256 + wr * 64 + fr, cl = wc * 32 + 8 * fq;
        const bool smp = u.pm >= 32; const int rowq = smp ? row0 - NPROMPT : row0;
        if (pn >= 8 && pn < 16) {
            const int c0 = (pn - 8) * 256 + cl;
            float lb[2][8];
#pragma unroll
            for (int bj = 0; bj < 2; ++bj)
#pragma unroll
                for (int j = 0; j < 8; ++j) { const int c = c0 + bj * 128 + j; lb[bj][j] = sigmoidf_(lbl[c] - lbl[2048 + c]); }
#pragma unroll
            for (int ai = 0; ai < 2; ++ai)
#pragma unroll
                for (int m = 0; m < 4; ++m) {
                    float* rowp = (float*)(ws + (smp ? WS_FS : WS_FP)) + (size_t)(rowq + ai * 128 + m * 16) * 2048 + c0;
#pragma unroll
                    for (int bj = 0; bj < 2; ++bj) {
                        const f32x4 v0 = acc[ai][bj][m][0], v1 = acc[ai][bj][m][1]; f32x4 o0, o1;
#pragma unroll
                        for (int j = 0; j < 4; ++j) { o0[j] = lb[bj][j] + (1.f - lb[bj][j]) * sigmoidf_(v0[j]); o1[j] = lb[bj][4 + j] + (1.f - lb[bj][4 + j]) * sigmoidf_(v1[j]); }
                        *(f32x4*)(rowp + bj * 128) = o0; *(f32x4*)(rowp + bj * 128 + 4) = o1;
                    }
                }
            return;
        }
        if (pn == 96) {
            if (wc < 2) {
#pragma unroll
                for (int ai = 0; ai < 2; ++ai)
#pragma unroll
                    for (int m = 0; m < 4; ++m) {
                        float* rowp = (float*)(ws + WS_BL) + (size_t)(row0 + ai * 128 + m * 16) * 64 + cl;
                        const f32x4 v0 = acc[ai][0][m][0], v1 = acc[ai][0][m][1]; f32x4 o0, o1;
#pragma unroll
                        for (int j = 0; j < 4; ++j) {
                            if (wc == 0) { o0[j] = sigmoidf_(v0[j]); o1[j] = sigmoidf_(v1[j]); }
                            else { const int h0 = 8 * fq + j, h1 = 8 * fq + 4 + j; const float x0 = v0[j] + dtb[h0], x1 = v1[j] + dtb[h1];
                                   o0[j] = -expf(alog[h0]) * (fmaxf(x0, 0.f) + log1pf(expf(-fabsf(x0)))); o1[j] = -expf(alog[h1]) * (fmaxf(x1, 0.f) + log1pf(expf(-fabsf(x1)))); }
                        }
                        *(f32x4*)(rowp) = o0; *(f32x4*)(rowp + 4) = o1;
                    }
            }
            return;
        }
        size_t boff; int ld, c0, mode, rowb = row0;
        if (pn < 8)       { boff = smp ? WS_QHS : WS_QHP; ld = 2048; c0 = pn * 256; mode = 1; rowb = rowq; }
        else if (pn < 24) { boff = smp ? WS_IS : WS_IP;   ld = 2048; c0 = (pn - 16) * 256; mode = 0; rowb = rowq; }
        else if (pn < 32) { boff = WS_GH; ld = 2048; c0 = (pn - 24) * 256; mode = 1; }
        else if (pn < 64) { boff = smp ? WS_US : WS_UP;   ld = 8192; c0 = (pn - 32) * 256; mode = 0; rowb = rowq; }
        else if (pn < 80) { boff = WS_GZ; ld = 4096; c0 = (pn - 64) * 256; mode = 1; }
        else if (pn < 88) { boff = WS_SA; ld = 2048; c0 = (pn - 80) * 256; mode = 2; }
        else              { boff = WS_SB; ld = 2048; c0 = (pn - 88) * 256; mode = 2; }
        bf16* base = (bf16*)(ws + boff);
        if (mode == 0) tile_store_bf16<0>(acc, base, ld, rowb, c0 + cl);
        else if (mode == 1) tile_store_bf16<1>(acc, base, ld, rowb, c0 + cl);
        else tile_store_bf16<2>(acc, base, ld, rowb, c0 + cl);
    }
};
struct EpiOut1 {
    static constexpr bool PERM = true, AFTER_DRAIN = false;
    float* T1; const bf16* SA;
    __device__ __forceinline__ void operator()(const f32x4 (&acc)[2][2][4][2], const pg8::Unit& u, int wr, int wc, int fr, int fq) const {
        const int row0 = u.pm * 256 + wr * 64 + fr, c0 = u.pn * 256 + wc * 32 + 8 * fq;
#pragma unroll
        for (int ai = 0; ai < 2; ++ai)
#pragma unroll
            for (int m = 0; m < 4; ++m) {
                const size_t ro = (size_t)(row0 + ai * 128 + m * 16) * 2048 + c0;
#pragma unroll
                for (int bj = 0; bj < 2; ++bj) {
                    const u32x4 s = *(const u32x4*)(SA + ro + bj * 128);
                    const f32x4 v0 = acc[ai][bj][m][0], v1 = acc[ai][bj][m][1];
                    f32x4 o0 = {v0[0] * bflo(s.x), v0[1] * bfhi(s.x), v0[2] * bflo(s.y), v0[3] * bfhi(s.y)};
                    f32x4 o1 = {v1[0] * bflo(s.z), v1[1] * bfhi(s.z), v1[2] * bflo(s.w), v1[3] * bfhi(s.w)};
                    *(f32x4*)(T1 + ro + bj * 128) = o0; *(f32x4*)(T1 + ro + bj * 128 + 4) = o1;
                }
            }
    }
};
struct EpiOut2 {
    static constexpr bool PERM = true, AFTER_DRAIN = false;
    const float* T1; const bf16* SB; bf16* MG;
    __device__ __forceinline__ void operator()(const f32x4 (&acc)[2][2][4][2], const pg8::Unit& u, int wr, int wc, int fr, int fq) const {
        const int row0 = u.pm * 256 + wr * 64 + fr, c0 = u.pn * 256 + wc * 32 + 8 * fq;
#pragma unroll
        for (int ai = 0; ai < 2; ++ai)
#pragma unroll
            for (int m = 0; m < 4; ++m) {
                const size_t ro = (size_t)(row0 + ai * 128 + m * 16) * 2048 + c0;
#pragma unroll
                for (int bj = 0; bj < 2; ++bj) {
                    const u32x4 s = *(const u32x4*)(SB + ro + bj * 128);
                    const f32x4 t0 = *(const f32x4*)(T1 + ro + bj * 128), t1 = *(const f32x4*)(T1 + ro + bj * 128 + 4);
                    const f32x4 v0 = acc[ai][bj][m][0], v1 = acc[ai][bj][m][1];
                    u32x4 w;
                    w.x = pk2(t0[0] + v0[0] * bflo(s.x), t0[1] + v0[1] * bfhi(s.x)); w.y = pk2(t0[2] + v0[2] * bflo(s.y), t0[3] + v0[3] * bfhi(s.y));
                    w.z = pk2(t1[0] + v1[0] * bflo(s.z), t1[1] + v1[1] * bfhi(s.z)); w.w = pk2(t1[2] + v1[2] * bflo(s.w), t1[3] + v1[3] * bfhi(s.w));
                    *(u32x4*)(MG + ro + bj * 128) = w;
                }
            }
    }
};
struct EpiF32 {
    static constexpr bool PERM = true, AFTER_DRAIN = false;
    float* O; int ld;
    __device__ __forceinline__ void operator()(const f32x4 (&acc)[2][2][4][2], const pg8::Unit& u, int wr, int wc, int fr, int fq) const {
        tile_store_f32(acc, O, ld, u.pm * 256 + wr * 64 + fr, u.pn * 256 + wc * 32 + 8 * fq);
    }
};
struct EpiRelu2 {
    static constexpr bool PERM = true, AFTER_DRAIN = false;
    bf16* O; int ld;
    __device__ __forceinline__ void operator()(const f32x4 (&acc)[2][2][4][2], const pg8::Unit& u, int wr, int wc, int fr, int fq) const {
        tile_store_bf16<3>(acc, O, ld, u.pm * 256 + wr * 64 + fr, u.pn * 256 + wc * 32 + 8 * fq);
    }
};

struct TailOrder {
    pg8::StaticOrder so; int c, npass, k0a, nta, k0b, ntb;
    __device__ __forceinline__ void init(int G_, int c_, int npass_, int k0a_, int nta_, int k0b_, int ntb_) { so.init(NPROMPT, 2048, G_, c_, 2048); c = c_; npass = npass_; k0a = k0a_; nta = nta_; k0b = k0b_; ntb = ntb_; }
    __device__ __forceinline__ bool next(int i, pg8::Unit& u) const {
        if (i < npass) { so.next(0, u); u.k0 = i ? k0b : k0a; u.nt = i ? ntb : nta; u.kind = i; return true; }
        const int j = i - npass; if (j >= npass) return false;
        const int tile = c & 15, sl = c >> 4, nts = (j ? ntb : nta) >> 4;
        u.pm = 32 + (tile >> 3); u.pn = tile & 7; u.nt = nts; u.k0 = (j ? k0b : k0a) + sl * nts * 64; u.kind = (2 + j) | (sl << 8); return true;
    }
    __device__ __forceinline__ void a_ready(const pg8::Unit&) const {}
    __device__ __forceinline__ void done(const pg8::Unit&) const {}
};
struct EpiOutC {
    static constexpr bool PERM = true, AFTER_DRAIN = false;
    float* T1; const bf16* SA; const bf16* SB; bf16* MG; float* SL;
    __device__ __forceinline__ void operator()(const f32x4 (&acc)[2][2][4][2], const pg8::Unit& u, int wr, int wc, int fr, int fq) const {
        const int kind = u.kind & 255, sl = u.kind >> 8, row0 = u.pm * 256 + wr * 64 + fr, c0 = u.pn * 256 + wc * 32 + 8 * fq;
        const bf16* GT = (kind & 1) ? SB : SA;
        float* slab = SL + (size_t)(((kind & 1) * 16 + sl) * 512) * 2048;
#pragma unroll
        for (int ai = 0; ai < 2; ++ai)
#pragma unroll
            for (int m = 0; m < 4; ++m) {
                const int row = row0 + ai * 128 + m * 16; const size_t ro = (size_t)row * 2048 + c0;
#pragma unroll
                for (int bj = 0; bj < 2; ++bj) {
                    const u32x4 g = *(const u32x4*)(GT + ro + bj * 128);
                    const f32x4 v0 = acc[ai][bj][m][0], v1 = acc[ai][bj][m][1];
                    f32x4 o0 = {v0[0] * bflo(g.x), v0[1] * bfhi(g.x), v0[2] * bflo(g.y), v0[3] * bfhi(g.y)};
                    f32x4 o1 = {v1[0] * bflo(g.z), v1[1] * bfhi(g.z), v1[2] * bflo(g.w), v1[3] * bfhi(g.w)};
                    if (kind == 0) { *(f32x4*)(T1 + ro + bj * 128) = o0; *(f32x4*)(T1 + ro + bj * 128 + 4) = o1; }
                    else if (kind == 1) { const f32x4 t0 = *(const f32x4*)(T1 + ro + bj * 128), t1 = *(const f32x4*)(T1 + ro + bj * 128 + 4);
                        *(u32x4*)(MG + ro + bj * 128) = (u32x4){pk2(t0[0] + o0[0], t0[1] + o0[1]), pk2(t0[2] + o0[2], t0[3] + o0[3]), pk2(t1[0] + o1[0], t1[1] + o1[1]), pk2(t1[2] + o1[2], t1[3] + o1[3])}; }
                    else { float* d = slab + (size_t)(row - NPROMPT) * 2048 + c0 + bj * 128; *(f32x4*)d = o0; *(f32x4*)(d + 4) = o1; }
                }
            }
    }
};
struct EpiF32S {
    static constexpr bool PERM = true, AFTER_DRAIN = false;
    float* O; float* SL;
    __device__ __forceinline__ void operator()(const f32x4 (&acc)[2][2][4][2], const pg8::Unit& u, int wr, int wc, int fr, int fq) const {
        const int kind = u.kind & 255, sl = u.kind >> 8, row0 = u.pm * 256 + wr * 64 + fr, c0 = u.pn * 256 + wc * 32 + 8 * fq;
        if (kind == 0) tile_store_f32(acc, O, 2048, row0, c0);
        else tile_store_f32(acc, SL + (size_t)(sl * 512) * 2048, 2048, row0 - NPROMPT, c0);
    }
};

__device__ __forceinline__ void transpose_item(const float* W, int N, bf16* WT, int ldk, int k0, int n0, int nrow0, LAS float* scr, int lane) {
#pragma unroll 8
    for (int i = 0; i < 32; ++i) { const int kk = 2 * i + (lane >> 5); scr[kk * 33 + (lane & 31)] = W[(size_t)(k0 + kk) * N + n0 + (lane & 31)]; }
    LDS_WAIT(); asm volatile("" ::: "memory");
    const int c = lane & 7;
#pragma unroll
    for (int j = 0; j < 4; ++j) { const int n = (lane >> 3) + 8 * j; const LAS float* s = scr + (8 * c) * 33 + n;
        u32x4 o; o.x = pk2(s[0 * 33], s[1 * 33]); o.y = pk2(s[2 * 33], s[3 * 33]); o.z = pk2(s[4 * 33], s[5 * 33]); o.w = pk2(s[6 * 33], s[7 * 33]);
        *(u32x4*)(WT + (size_t)(nrow0 + n) * ldk + k0 + 8 * c) = o; }
    LDS_WAIT(); asm volatile("" ::: "memory");
}
__device__ __forceinline__ void mod_item(const PA& a, LAS unsigned char* lds, int cb, int tid, int wid, int lane) {
    constexpr int AST = 264;
    LAS bf16* As = (LAS bf16*)lds; LAS bf16* Wt = (LAS bf16*)(lds + 144 * AST * 2);
    const float* cp = a.in(I_CP); const float* cs = a.in(I_CS); const float* W = a.in(I_WADA); const float* bada = a.in(I_BADA);
    float* mod = (float*)(a.ws() + WS_MOD);
    const int nt = wid % 3, mh = wid / 3, fr = lane & 15, fq = lane >> 4, n0 = cb * 48;
    f32x4 acc[5];
#pragma unroll
    for (int i = 0; i < 5; ++i) acc[i] = (f32x4){0.f, 0.f, 0.f, 0.f};
    for (int kc = 0; kc < 8; ++kc) {
        __syncthreads();
        {
            f32x4 xv[18];
#pragma unroll
            for (int i = 0; i < 18; ++i) { const int e = tid + i * NTHREADS, s = e >> 6, q = e & 63;
                if (s < NSEQ) xv[i] = *(const f32x4*)((s < 4 ? cp + (size_t)s * 2048 : cs + (size_t)(s - 4) * 2048) + kc * 256 + q * 4); else xv[i] = (f32x4){0.f, 0.f, 0.f, 0.f}; }
#pragma unroll
            for (int i = 0; i < 18; ++i) { const int e = tid + i * NTHREADS, s = e >> 6, q = e & 63;
                *(LAS u32x2*)(As + s * AST + q * 4) = (u32x2){pk2(siluf_(xv[i][0]), siluf_(xv[i][1])), pk2(siluf_(xv[i][2]), siluf_(xv[i][3]))}; }
        }
#pragma unroll
        for (int i = 0; i < 6; ++i) {
            const int e = tid + i * NTHREADS, k = e / 12, c4 = e % 12;
            const f32x4 x = *(const f32x4*)(W + (size_t)(kc * 256 + k) * NADA + n0 + 4 * c4);
            *(LAS u32x2*)(Wt + k * 52 + 4 * c4) = (u32x2){pk2(x[0], x[1]), pk2(x[2], x[3])};
        }
        __syncthreads();
        if (wid < 6) {
#pragma unroll 2
            for (int ks = 0; ks < 8; ++ks) {
                const LAS bf16* bp = Wt + (ks * 32 + 8 * fq) * 52 + nt * 16 + fr;
                const u32x4 bw = {(unsigned)bp[0] | ((unsigned)bp[52] << 16), (unsigned)bp[104] | ((unsigned)bp[156] << 16), (unsigned)bp[208] | ((unsigned)bp[260] << 16), (unsigned)bp[312] | ((unsigned)bp[364] << 16)};
                const bf16x8 b = __builtin_bit_cast(bf16x8, bw);
#pragma unroll
                for (int i = 0; i < 5; ++i) {
                    const int mt = mh * 5 + i;
                    if (mt < 9) { const bf16x8 av = *(const LAS bf16x8*)(As + (mt * 16 + fr) * AST + ks * 32 + 8 * fq);
                        acc[i] = __builtin_amdgcn_mfma_f32_16x16x32_bf16(av, b, acc[i], 0, 0, 0); }
                }
            }
        }
    }
    if (wid < 6) {
        const int n = n0 + nt * 16 + fr; const float bb = bada[n];
#pragma unroll
        for (int i = 0; i < 5; ++i)
#pragma unroll
            for (int r = 0; r < 4; ++r) { const int s = (mh * 5 + i) * 16 + 4 * fq + r; if (s < NSEQ) mod[(size_t)s * NADA + n] = acc[i][r] + bb; }
    }
}

__device__ __forceinline__ const float* xrow_ptr(const PA& a, int row) { return row < NPROMPT ? a.in(I_XP) + (size_t)row * DM : a.in(I_XS) + (size_t)(row - NPROMPT) * DM; }
__device__ __forceinline__ int seq_of_row(int row) { return row < NPROMPT ? (row >> 11) : 4 + ((row - NPROMPT) >> 2); }

__device__ __forceinline__ float ldg_agent(const float* p) { return __hip_atomic_load(p, __ATOMIC_RELAXED, __HIP_MEMORY_SCOPE_AGENT); }
__device__ __forceinline__ float xhalf_sum(float v) { return v + __shfl_xor(v, 32); }
constexpr int NI_GS = 16384, NI_HS = 8192;
__device__ __forceinline__ void item_inputs(const PA& a, int it, int lane, float (&tin)[4][7]) {
    if (it < NI_GS) {
        const bf16* UC = (const bf16*)(a.ws() + WS_UCS); const float* BL = (const float*)(a.ws() + WS_BL);
        const int b = it >> 7, vh = (it >> 2) & 31, dv = (it & 3) * 32 + (lane & 31), qh = vh >> 1;
#pragma unroll
        for (int t = 0; t < DSEQ; ++t) {
            const unsigned ro = (unsigned)(b * DSEQ + t) * 8192u + qh * 128, rb = (unsigned)(NPROMPT + b * DSEQ + t) * 64u + vh;
            tin[t][0] = bf2f(UC[ro + lane]); tin[t][1] = bf2f(UC[ro + 64 + lane]); tin[t][2] = bf2f(UC[ro + 2048 + lane]); tin[t][3] = bf2f(UC[ro + 2048 + 64 + lane]);
            tin[t][4] = bf2f(UC[(unsigned)(b * DSEQ + t) * 8192u + 4096 + vh * 128 + dv]); tin[t][5] = ldg_agent(BL + rb); tin[t][6] = ldg_agent(BL + rb + 32);
        }
    } else {
        const bf16* Qh = (const bf16*)(a.ws() + WS_QHS); const float* F = (const float*)(a.ws() + WS_FS); const bf16* Ih = (const bf16*)(a.ws() + WS_IS);
        const int r = it - NI_GS, b = r >> 6, h = (r >> 2) & 15, dv = (r & 3) * 32 + (lane & 31);
#pragma unroll
        for (int t = 0; t < DSEQ; ++t) {
            const unsigned ro = (unsigned)(b * DSEQ + t) * 2048u + h * 128;
            tin[t][0] = bf2f(Qh[ro + lane]); tin[t][1] = bf2f(Qh[ro + 64 + lane]); tin[t][2] = F[ro + lane]; tin[t][3] = F[ro + 64 + lane]; tin[t][4] = bf2f(Ih[ro + dv]); tin[t][5] = 0.f; tin[t][6] = 0.f;
        }
    }
}
__device__ __forceinline__ void hgrn_item(const PA& a, LAS float* wl, int b, int h, int quarter, int lane, const float (&tin)[4][7], float (&S)[64]) {
    bf16* O16 = (bf16*)(a.ws() + WS_O16);
    const int c = lane & 31, hh = lane >> 5, dv = quarter * 32 + c;
    const unsigned sidx = (unsigned)((b * 16 + h) * 128 + 64 * hh) * 128u + dv;
    LAS float* qs = wl; LAS float* fs = wl + 128;
#pragma unroll
    for (int t = 0; t < DSEQ; ++t) {
        const float iv = tin[t][4];
        qs[lane] = tin[t][0]; qs[64 + lane] = tin[t][1]; fs[lane] = tin[t][2]; fs[64 + lane] = tin[t][3];
        float o0 = 0.f, o1 = 0.f, o2 = 0.f, o3 = 0.f;
#pragma unroll
        for (int j4 = 0; j4 < 16; ++j4) {
            const f32x4 q4 = *(const LAS f32x4*)(qs + 64 * hh + 4 * j4), f4 = *(const LAS f32x4*)(fs + 64 * hh + 4 * j4);
            S[4 * j4 + 0] = fmaf(f4[0], S[4 * j4 + 0] - iv, iv); o0 = fmaf(q4[0], S[4 * j4 + 0], o0);
            S[4 * j4 + 1] = fmaf(f4[1], S[4 * j4 + 1] - iv, iv); o1 = fmaf(q4[1], S[4 * j4 + 1], o1);
            S[4 * j4 + 2] = fmaf(f4[2], S[4 * j4 + 2] - iv, iv); o2 = fmaf(q4[2], S[4 * j4 + 2], o2);
            S[4 * j4 + 3] = fmaf(f4[3], S[4 * j4 + 3] - iv, iv); o3 = fmaf(q4[3], S[4 * j4 + 3], o3);
        }
        const float o = xhalf_sum((o0 + o1) + (o2 + o3));
        if (hh == 0) O16[(unsigned)(NPROMPT + b * DSEQ + t) * 6144u + h * 128 + dv] = (bf16)(pk2(o, 0.f) & 0xffffu);
        asm volatile("" ::: "memory");
    }
    float* so = a.out() + O_HGS + sidx;
#pragma unroll
    for (int j = 0; j < 64; ++j) so[j * 128] = S[j];
}
__device__ __forceinline__ void gdn_item(const PA& a, LAS float* wl, int b, int vh, int quarter, int lane, const float (&tin)[4][7], float (&S)[64]) {
    bf16* O16 = (bf16*)(a.ws() + WS_O16);
    const int c = lane & 31, hh = lane >> 5, dv = quarter * 32 + c;
    const unsigned sidx = (unsigned)((b * 32 + vh) * 128 + 64 * hh) * 128u + dv;
    LAS float* qs = wl; LAS float* ks = wl + 128;
#pragma unroll
    for (int t = 0; t < DSEQ; ++t) {
        const float q0 = tin[t][0], q1 = tin[t][1], k0 = tin[t][2], k1 = tin[t][3], vv = tin[t][4], beta = tin[t][5], al = __expf(tin[t][6]);
        qs[lane] = q0; qs[64 + lane] = q1; ks[lane] = k0; ks[64 + lane] = k1;
        const float qk = wave_sum_sw(q0 * k0 + q1 * k1);
        float c0 = 0.f, c1 = 0.f, c2 = 0.f, c3 = 0.f, o0 = 0.f, o1 = 0.f, o2 = 0.f, o3 = 0.f;
#pragma unroll
        for (int j4 = 0; j4 < 16; ++j4) {
            const f32x4 k4 = *(const LAS f32x4*)(ks + 64 * hh + 4 * j4), q4 = *(const LAS f32x4*)(qs + 64 * hh + 4 * j4);
            c0 = fmaf(k4[0], S[4 * j4 + 0], c0); c1 = fmaf(k4[1], S[4 * j4 + 1], c1); c2 = fmaf(k4[2], S[4 * j4 + 2], c2); c3 = fmaf(k4[3], S[4 * j4 + 3], c3);
            o0 = fmaf(q4[0], S[4 * j4 + 0], o0); o1 = fmaf(q4[1], S[4 * j4 + 1], o1); o2 = fmaf(q4[2], S[4 * j4 + 2], o2); o3 = fmaf(q4[3], S[4 * j4 + 3], o3);
        }
        const float kS = xhalf_sum((c0 + c1) + (c2 + c3)), qS = xhalf_sum((o0 + o1) + (o2 + o3));
        const float dlt = beta * (vv - al * kS);
#pragma unroll
        for (int j4 = 0; j4 < 16; ++j4) {
            const f32x4 k4 = *(const LAS f32x4*)(ks + 64 * hh + 4 * j4);
            S[4 * j4 + 0] = fmaf(k4[0], dlt, al * S[4 * j4 + 0]); S[4 * j4 + 1] = fmaf(k4[1], dlt, al * S[4 * j4 + 1]);
            S[4 * j4 + 2] = fmaf(k4[2], dlt, al * S[4 * j4 + 2]); S[4 * j4 + 3] = fmaf(k4[3], dlt, al * S[4 * j4 + 3]);
        }
        if (hh == 0) O16[(unsigned)(NPROMPT + b * DSEQ + t) * 6144u + 2048 + vh * 128 + dv] = (bf16)(pk2(fmaf(al, qS, qk * dlt), 0.f) & 0xffffu);
        asm volatile("" ::: "memory");
    }
    float* so = a.out() + O_GDS + sidx;
#pragma unroll
    for (int j = 0; j < 64; ++j) so[j * 128] = S[j];
}

typedef float f32x16 __attribute__((ext_vector_type(16)));
typedef float f32x2_t __attribute__((ext_vector_type(2))); typedef __bf16 bf16x2_t __attribute__((ext_vector_type(2)));
#define MFMA32(a, b, c) __builtin_amdgcn_mfma_f32_32x32x16_bf16((a), (b), (c), 0, 0, 0)
__device__ __forceinline__ unsigned cvtpk(float lo, float hi) { f32x2_t v = {lo, hi}; bf16x2_t b = __builtin_convertvector(v, bf16x2_t); return __builtin_bit_cast(unsigned, b); }
__device__ __forceinline__ int crow_(int i, int h) { return (i & 3) + 8 * (i >> 2) + 4 * h; }
template <int S> __device__ __forceinline__ bf16x8 pack_acc(const f32x16& x) {
    u32x4 p; p.x = cvtpk(x[8 * S + 0], x[8 * S + 1]); p.y = cvtpk(x[8 * S + 2], x[8 * S + 3]); p.z = cvtpk(x[8 * S + 4], x[8 * S + 5]); p.w = cvtpk(x[8 * S + 6], x[8 * S + 7]);
    return __builtin_bit_cast(bf16x8, p);
}
__device__ __forceinline__ u32x4 afrag_rows(const LAS bf16* img, int stride, int row, int kt, int h) {
    const LAS u32x2* p = (const LAS u32x2*)(img + row * stride + 16 * kt + 4 * h);
    const u32x2 lo = p[0], hi = p[2];
    return (u32x4){lo.x, lo.y, hi.x, hi.y};
}
__device__ __forceinline__ u32x4 afrag_rows_scaled(const LAS bf16* img, int stride, int row, int kt, int h, float sc) {
    const u32x4 w = afrag_rows(img, stride, row, kt, h);
    return (u32x4){cvtpk(bflo(w.x) * sc, bfhi(w.x) * sc), cvtpk(bflo(w.y) * sc, bfhi(w.y) * sc), cvtpk(bflo(w.z) * sc, bfhi(w.z) * sc), cvtpk(bflo(w.w) * sc, bfhi(w.w) * sc)};
}
__device__ __forceinline__ int kidx_(int kt, int h, int j) { return 16 * kt + 8 * (j >> 2) + 4 * h + (j & 3); }

constexpr int GREC_BYTES = 73984;
constexpr int GR_W = 0, GR_Q = 16384, GR_K = 32768, GR_A = 49152, GR_U = 57344, GR_DEC = 73728, GR_IMG = 57344;
constexpr int HREC_BYTES = 57856;
constexpr int HR_Q = 0, HR_K = 16384, HR_A = 32768, HR_I = 40960, HR_DEC = 57344, HR_IMG = 57856;

constexpr int GP_QS = 0, GP_KS = 17408, GP_VS = 34816, GP_BG = 69632, GP_KK = 73728, GP_QK = 90368, GP_AS = 107008, GP_XL = 0, GP_ATT = 73728;
constexpr int GP_ST = 136, GP_XST = 264, GP_AST = 68, GP_KST = 65, GP_TST = 72;
__device__ __forceinline__ void gdn_prep_unit(const PA& a, LAS unsigned char* lds, int u, int tid, int wid, int lane) {
    asm volatile("" : "+v"(tid), "+v"(lane));
    unsigned char* ws = a.ws();
    const int b = u >> 9, qh = (u >> 5) & 15, c = u & 31;
    const bf16* UP = (const bf16*)(ws + WS_UP); const float* BL = (const float*)(ws + WS_BL); const float* cw = a.in(I_CW);
    LAS bf16* QS = (LAS bf16*)(lds + GP_QS); LAS bf16* KS = (LAS bf16*)(lds + GP_KS); LAS bf16* VS = (LAS bf16*)(lds + GP_VS);
    LAS float* BG = (LAS float*)(lds + GP_BG);
    LAS float* KKs = (LAS float*)(lds + GP_KK); LAS float* QKs = (LAS float*)(lds + GP_QK); LAS float* AS = (LAS float*)(lds + GP_AS);
    LAS bf16* XL = (LAS bf16*)(lds + GP_XL); LAS bf16* ATT = (LAS bf16*)(lds + GP_ATT);
    const int row0 = b * SEQ + c * 64;
    unsigned char* rec0 = ws + WS_GREC + (size_t)((b * 32 + 2 * qh) * 32 + c) * GREC_BYTES;
    for (int r0_ = 0; r0_ < NREP(20); ++r0_) {
        const int cg = tid & 31, rb = tid >> 5, t0 = 4 * rb;
        const int ch0 = cg < 8 ? qh * 128 + cg * 16 : (cg < 16 ? 2048 + qh * 128 + (cg - 8) * 16 : 4096 + (2 * qh) * 128 + (cg - 16) * 16);
        f32x4 wt[4][4];
#pragma unroll
        for (int j = 0; j < 4; ++j) { const f32x4* wp = (const f32x4*)(cw + (size_t)j * CONVCH + ch0); wt[j][0] = wp[0]; wt[j][1] = wp[1]; wt[j][2] = wp[2]; wt[j][3] = wp[3]; }
        u32x4 rw[7][2];
#pragma unroll
        for (int q = 0; q < 7; ++q) {
            if (c * 64 + t0 - 3 + q >= 0) { const u32x4* src = (const u32x4*)(UP + (size_t)(row0 + t0 - 3 + q) * CONVCH + ch0); rw[q][0] = src[0]; rw[q][1] = src[1]; }
            else { rw[q][0] = (u32x4){0u, 0u, 0u, 0u}; rw[q][1] = (u32x4){0u, 0u, 0u, 0u}; }
        }
#pragma unroll
        for (int i = 0; i < 4; ++i) {
            float x[16];
#pragma unroll
            for (int e = 0; e < 16; ++e) x[e] = 0.f;
#pragma unroll
            for (int j = 0; j < 4; ++j) {
                const u32x4 w0 = rw[i + j][0], w1 = rw[i + j][1];
                x[0] = fmaf(wt[j][0][0], bflo(w0.x), x[0]); x[1] = fmaf(wt[j][0][1], bfhi(w0.x), x[1]); x[2] = fmaf(wt[j][0][2], bflo(w0.y), x[2]); x[3] = fmaf(wt[j][0][3], bfhi(w0.y), x[3]);
                x[4] = fmaf(wt[j][1][0], bflo(w0.z), x[4]); x[5] = fmaf(wt[j][1][1], bfhi(w0.z), x[5]); x[6] = fmaf(wt[j][1][2], bflo(w0.w), x[6]); x[7] = fmaf(wt[j][1][3], bfhi(w0.w), x[7]);
                x[8] = fmaf(wt[j][2][0], bflo(w1.x), x[8]); x[9] = fmaf(wt[j][2][1], bfhi(w1.x), x[9]); x[10] = fmaf(wt[j][2][2], bflo(w1.y), x[10]); x[11] = fmaf(wt[j][2][3], bfhi(w1.y), x[11]);
                x[12] = fmaf(wt[j][3][0], bflo(w1.z), x[12]); x[13] = fmaf(wt[j][3][1], bfhi(w1.z), x[13]); x[14] = fmaf(wt[j][3][2], bflo(w1.w), x[14]); x[15] = fmaf(wt[j][3][3], bfhi(w1.w), x[15]);
            }
            float ss = 0.f;
#pragma unroll
            for (int e = 0; e < 16; ++e) { x[e] = siluf_(x[e]); ss = fmaf(x[e], x[e], ss); }
            ss += __shfl_xor(ss, 1); ss += __shfl_xor(ss, 2); ss += __shfl_xor(ss, 4);
            float r = 1.f;
            if (cg < 16) { r = rsqrtf(ss + EPS); if (cg < 8) r *= 0.08838834764831845f; }
            u32x4 o0, o1;
            o0.x = cvtpk(x[0] * r, x[1] * r); o0.y = cvtpk(x[2] * r, x[3] * r); o0.z = cvtpk(x[4] * r, x[5] * r); o0.w = cvtpk(x[6] * r, x[7] * r);
            o1.x = cvtpk(x[8] * r, x[9] * r); o1.y = cvtpk(x[10] * r, x[11] * r); o1.z = cvtpk(x[12] * r, x[13] * r); o1.w = cvtpk(x[14] * r, x[15] * r);
            LAS bf16* img = cg < 8 ? QS + cg * 16 : (cg < 16 ? KS + (cg - 8) * 16 : VS + ((cg - 16) >> 3) * (64 * GP_ST) + ((cg - 16) & 7) * 16);
            LAS u32x4* dst = (LAS u32x4*)(img + (t0 + i) * GP_ST);
            dst[0] = o0; dst[1] = o1;
        }
        if (tid < 256) { const int vhh = tid >> 7, k = (tid >> 6) & 1, tt = tid & 63;
            BG[k * 128 + vhh * 64 + tt] = BL[(size_t)(row0 + tt) * 64 + k * 32 + 2 * qh + vhh]; }
    }
    __syncthreads(); asm volatile("" : "+v"(tid), "+v"(lane));
    if (wid < 2) {
        float g = BG[128 + wid * 64 + lane];
#pragma unroll
        for (int o = 1; o < 64; o <<= 1) { const float v = __shfl_up(g, o); if (lane >= o) g += v; }
        const float g63 = __shfl(g, 63);
        BG[256 + wid * 64 + lane] = g; BG[384 + wid * 64 + lane] = __expf(g); BG[512 + wid * 64 + lane] = __expf(g63 - g);
        if (lane == 63) *(float*)(rec0 + (size_t)wid * 32 * GREC_BYTES + GR_DEC) = __expf(g63);
    }
    {
        const int m = wid >> 2, rt = (wid >> 1) & 1, ct = wid & 1, r = lane & 31, h = lane >> 5;
        const LAS bf16* Am = (m ? QS : KS) + (32 * rt + r) * GP_ST + 8 * h; const LAS bf16* Bm = KS + (32 * ct + r) * GP_ST + 8 * h;
        f32x16 acc;
#pragma unroll
        for (int i = 0; i < 16; ++i) acc[i] = 0.f;
#pragma unroll
        for (int kt = 0; kt < 8; ++kt) acc = MFMA32(*(const LAS bf16x8*)(Am + 16 * kt), *(const LAS bf16x8*)(Bm + 16 * kt), acc);
        LAS float* dst = (m ? QKs : KKs) + 32 * ct + r;
#pragma unroll
        for (int i = 0; i < 16; ++i) dst[(32 * rt + crow_(i, h)) * GP_KST] = acc[i];
    }
    __syncthreads(); asm volatile("" : "+v"(tid), "+v"(lane));
    float att[16];
    for (int r2_ = 0; r2_ < NREP(23); ++r2_) {
        const int vhh = tid >> 8, e = tid & 255;
        const LAS float* bet = BG + vhh * 64; const LAS float* gam = BG + 256 + vhh * 64;
#pragma unroll
        for (int n = 0; n < 16; ++n) {
            const int idx = e + 256 * n, t = idx >> 6, s = idx & 63;
            const float L = (t >= s) ? __expf(gam[t] - gam[s]) : 0.f;
            AS[(vhh * 64 + t) * GP_AST + s] = (t > s) ? bet[t] * KKs[t * GP_KST + s] * L : 0.f;
            att[n] = -QKs[t * GP_KST + s] * L;
        }
#pragma unroll
        for (int n = 0; n < 4; ++n) {
            const int task = tid + 512 * n, vh2 = task >> 10, f = (task >> 6) & 15, l = task & 63, rt = f >> 3, kt = f & 7, r = l & 31, h = l >> 5;
            const u32x4 w = afrag_rows_scaled(QS, GP_ST, 32 * rt + r, kt, h, BG[384 + vh2 * 64 + 32 * rt + r]);
            *(u32x4*)(rec0 + (size_t)vh2 * 32 * GREC_BYTES + GR_Q + (f * 64 + l) * 16) = w;
        }
#pragma unroll
        for (int n = 0; n < 4; ++n) {
            const int task = tid + 512 * n, vh2 = task >> 10, f = (task >> 6) & 15, l = task & 63, dt = f >> 2, ts = f & 3, r = l & 31, h = l >> 5;
            float v[8];
#pragma unroll
            for (int j = 0; j < 8; ++j) { const int tok = kidx_(ts, h, j); v[j] = -bf2f(KS[tok * GP_ST + 32 * dt + r]) * BG[512 + vh2 * 64 + tok]; }
            *(u32x4*)(rec0 + (size_t)vh2 * 32 * GREC_BYTES + GR_K + (f * 64 + l) * 16) = (u32x4){cvtpk(v[0], v[1]), cvtpk(v[2], v[3]), cvtpk(v[4], v[5]), cvtpk(v[6], v[7])};
        }
    }
    __syncthreads(); asm volatile("" : "+v"(tid), "+v"(lane));
    {
        const int vhh = tid >> 8, e = tid & 255;
#pragma unroll
        for (int n = 0; n < 16; ++n) { const int idx = e + 256 * n, t = idx >> 6, s = idx & 63; ATT[(vhh * 64 + t) * GP_TST + s] = (bf16)(cvtpk(att[n], 0.f) & 0xffffu); }
    }
    float X[64], R0[64];
    {
        const int vhh = tid >> 8, cc = tid & 255;
        const LAS float* bet = BG + vhh * 64; const LAS float* eg = BG + 384 + vhh * 64;
        const LAS bf16* src = (cc < 128) ? (VS + vhh * (64 * GP_ST) + cc) : (KS + (cc - 128));
        const bool isw = cc >= 128;
#pragma unroll
        for (int t = 0; t < 64; ++t) { const float bt = bet[t] * (isw ? eg[t] : 1.f); R0[t] = bf2f(src[t * GP_ST]) * bt; }
    }
    for (int r3_ = 0; r3_ < NREP(21); ++r3_) {
        const int vhh = tid >> 8, cc = tid & 255;
#pragma unroll
        for (int t = 0; t < 64; ++t) X[t] = R0[t];
        __syncthreads();
#define GDN_SOLVE_QUARTER(QQ, S4LO) \
        _Pragma("unroll 1") for (int tb = 4 * (QQ); tb < 4 * (QQ) + 4; ++tb) { \
            float rr[4]; \
            _Pragma("unroll") for (int j = 4 * (QQ); j < 4 * (QQ) + 4; ++j) if (j == tb) { rr[0] = X[4 * j]; rr[1] = X[4 * j + 1]; rr[2] = X[4 * j + 2]; rr[3] = X[4 * j + 3]; } \
            const LAS float* ar = AS + (vhh * 64 + 4 * tb) * GP_AST; \
            _Pragma("unroll") for (int s4 = (S4LO); s4 < 4 * (QQ) + 4; ++s4) { \
                if (s4 < 4 * (QQ) || s4 < tb) { \
                    const f32x4 a0 = *(const LAS f32x4*)(ar + 4 * s4), a1 = *(const LAS f32x4*)(ar + GP_AST + 4 * s4), a2 = *(const LAS f32x4*)(ar + 2 * GP_AST + 4 * s4), a3 = *(const LAS f32x4*)(ar + 3 * GP_AST + 4 * s4); \
                    _Pragma("unroll") for (int e = 0; e < 4; ++e) { const float x = X[4 * s4 + e]; rr[0] = fmaf(-a0[e], x, rr[0]); rr[1] = fmaf(-a1[e], x, rr[1]); rr[2] = fmaf(-a2[e], x, rr[2]); rr[3] = fmaf(-a3[e], x, rr[3]); } \
                } \
                if ((s4 & 1) == 1) asm volatile("" : "+v"(ar) : "v"(rr[0])); \
            } \
            const f32x4 d1 = *(const LAS f32x4*)(ar + GP_AST + 4 * tb), d2 = *(const LAS f32x4*)(ar + 2 * GP_AST + 4 * tb), d3 = *(const LAS f32x4*)(ar + 3 * GP_AST + 4 * tb); \
            rr[1] = fmaf(-d1[0], rr[0], rr[1]); \
            rr[2] = fmaf(-d2[0], rr[0], rr[2]); rr[2] = fmaf(-d2[1], rr[1], rr[2]); \
            rr[3] = fmaf(-d3[0], rr[0], rr[3]); rr[3] = fmaf(-d3[1], rr[1], rr[3]); rr[3] = fmaf(-d3[2], rr[2], rr[3]); \
            _Pragma("unroll") for (int j = 4 * (QQ); j < 4 * (QQ) + 4; ++j) if (j == tb) { X[4 * j] = rr[0]; X[4 * j + 1] = rr[1]; X[4 * j + 2] = rr[2]; X[4 * j + 3] = rr[3]; } \
        }
        GDN_SOLVE_QUARTER(0, 0) GDN_SOLVE_QUARTER(1, 0)
        const float sg = (cc < 128) ? -1.f : 1.f;
#pragma unroll
        for (int t = 0; t < 32; ++t) XL[(vhh * 64 + t) * GP_XST + cc] = (bf16)(cvtpk(X[t] * sg, 0.f) & 0xffffu);
        __syncthreads();
        {
            const int r = lane & 31, h = lane >> 5, ct0 = 2 * (wid & 3);
            f32x16 Pe, Po;
#pragma unroll
            for (int i = 0; i < 16; ++i) { Pe[i] = 0.f; Po[i] = 0.f; }
#pragma unroll
            for (int ks = 0; ks < 2; ++ks) {
                const LAS float* ap = AS + (vhh * 64 + 32 + r) * GP_AST + 16 * ks + 8 * h;
                const f32x4 a0 = *(const LAS f32x4*)ap, a1 = *(const LAS f32x4*)(ap + 4);
                const u32x4 au = {cvtpk(a0[0], a0[1]), cvtpk(a0[2], a0[3]), cvtpk(a1[0], a1[1]), cvtpk(a1[2], a1[3])};
                const LAS bf16* bp = XL + (vhh * 64 + 16 * ks + 8 * h) * GP_XST + 32 * ct0 + r;
                unsigned be[4], bo[4];
#pragma unroll
                for (int j2 = 0; j2 < 4; ++j2) { be[j2] = (unsigned)bp[(2 * j2) * GP_XST] | ((unsigned)bp[(2 * j2 + 1) * GP_XST] << 16); bo[j2] = (unsigned)bp[(2 * j2) * GP_XST + 32] | ((unsigned)bp[(2 * j2 + 1) * GP_XST + 32] << 16); }
                Pe = MFMA32(__builtin_bit_cast(bf16x8, au), __builtin_bit_cast(bf16x8, ((u32x4){be[0], be[1], be[2], be[3]})), Pe);
                Po = MFMA32(__builtin_bit_cast(bf16x8, au), __builtin_bit_cast(bf16x8, ((u32x4){bo[0], bo[1], bo[2], bo[3]})), Po);
            }
#pragma unroll
            for (int i = 0; i < 16; ++i) {
                const float xe = __shfl_xor(Pe[i], 32), xo = __shfl_xor(Po[i], 32);
                const float pa = h ? xo : Pe[i], pb = h ? Po[i] : xe;
                const int ra = 32 + (i & 3) + 8 * (i >> 2);
                X[ra] = fmaf(-sg, pa, X[ra]); X[ra + 4] = fmaf(-sg, pb, X[ra + 4]);
            }
        }
        GDN_SOLVE_QUARTER(2, 8) GDN_SOLVE_QUARTER(3, 8)
#undef GDN_SOLVE_QUARTER
#pragma unroll
        for (int t = 32; t < 64; ++t) XL[(vhh * 64 + t) * GP_XST + cc] = (bf16)(cvtpk(X[t] * sg, 0.f) & 0xffffu);
    }
    __syncthreads(); asm volatile("" : "+v"(tid), "+v"(lane));
    for (int r4_ = 0; r4_ < NREP(22); ++r4_) {
#pragma unroll
        for (int n = 0; n < 4; ++n) {
            const int task = tid + 512 * n, vh2 = task >> 10, f = (task >> 6) & 15, l = task & 63, rt = f >> 3, kt = f & 7, r = l & 31, h = l >> 5;
            const u32x4 w = afrag_rows(XL + vh2 * (64 * GP_XST) + 128, GP_XST, 32 * rt + r, kt, h);
            *(u32x4*)(rec0 + (size_t)vh2 * 32 * GREC_BYTES + GR_W + (f * 64 + l) * 16) = w;
        }
#pragma unroll
        for (int n = 0; n < 2; ++n) {
            const int task = tid + 512 * n, vh2 = task >> 9, f = (task >> 6) & 7, l = task & 63, slab = f >> 1, rt = f & 1, r = l & 31, h = l >> 5;
            const LAS bf16* src = XL + (vh2 * 64 + 32 * rt) * GP_XST + 32 * slab + r;
            unsigned w[8];
#pragma unroll
            for (int i2 = 0; i2 < 8; ++i2) w[i2] = (unsigned)src[crow_(2 * i2, h) * GP_XST] | ((unsigned)src[crow_(2 * i2 + 1, h) * GP_XST] << 16);
            u32x4* dst = (u32x4*)(rec0 + (size_t)vh2 * 32 * GREC_BYTES + GR_U + (f * 64 + l) * 32);
            dst[0] = (u32x4){w[0], w[1], w[2], w[3]}; dst[1] = (u32x4){w[4], w[5], w[6], w[7]};
        }
#pragma unroll
        for (int n = 0; n < 2; ++n) {
            const int task = tid + 512 * n, vh2 = task >> 9, f = (task >> 6) & 7, l = task & 63, rt = f >> 2, ts = f & 3, r = l & 31, h = l >> 5;
            const u32x4 w = afrag_rows(ATT + vh2 * (64 * GP_TST), GP_TST, 32 * rt + r, ts, h);
            *(u32x4*)(rec0 + (size_t)vh2 * 32 * GREC_BYTES + GR_A + (f * 64 + l) * 16) = w;
        }
    }
    __syncthreads(); asm volatile("" : "+v"(tid), "+v"(lane));
}

constexpr int HP_QT = 0, HP_KT = 17408, HP_QH = 34816, HP_KH = 52224, HP_IS = 69632, HP_GS = 87040, HP_AT = 90112;
__device__ __forceinline__ void hgrn_prep_unit(const PA& a, LAS unsigned char* lds, int u, int tid, int wid, int lane) {
    asm volatile("" : "+v"(tid), "+v"(lane));
    unsigned char* ws = a.ws();
    const int b = u >> 9, hd = (u >> 5) & 15, c = u & 31;
    const bf16* QhP = (const bf16*)(ws + WS_QHP); const float* FP = (const float*)(ws + WS_FP); const bf16* IP = (const bf16*)(ws + WS_IP);
    LAS bf16* QT = (LAS bf16*)(lds + HP_QT); LAS bf16* KT = (LAS bf16*)(lds + HP_KT); LAS bf16* QH = (LAS bf16*)(lds + HP_QH); LAS bf16* KH = (LAS bf16*)(lds + HP_KH);
    LAS bf16* IS = (LAS bf16*)(lds + HP_IS); LAS float* GS = (LAS float*)(lds + HP_GS); LAS bf16* AT = (LAS bf16*)(lds + HP_AT);
    const int row0 = b * SEQ + c * 64;
    unsigned char* rec = ws + WS_HREC + (size_t)((b * 16 + hd) * 32 + c) * HREC_BYTES;
    {
        const int d = tid & 127, tq = tid >> 7;
        float G[16], qv[16], kv[16];
        const size_t base = (size_t)(row0 + 16 * tq) * 2048 + hd * 128 + d;
        float run = 0.f;
#pragma unroll
        for (int j = 0; j < 16; ++j) { const float f = FP[base + (size_t)j * 2048]; run += __logf(f); G[j] = run; kv[j] = 1.f - f; qv[j] = bf2f(QhP[base + (size_t)j * 2048]);
            IS[(16 * tq + j) * GP_ST + d] = IP[base + (size_t)j * 2048]; }
        GS[256 + tq * 128 + d] = run;
        __syncthreads(); asm volatile("" : "+v"(tid), "+v"(lane));
        float off = 0.f;
#pragma unroll
        for (int q = 0; q < 3; ++q) if (q < tq) off += GS[256 + q * 128 + d];
        if (tq == 2) GS[128 + d] = off + G[0];
        if (tq == 3) { const float g63 = off + G[15]; GS[d] = g63; *(float*)(rec + HR_DEC + d * 4) = __expf(g63); }
        __syncthreads(); asm volatile("" : "+v"(tid), "+v"(lane));
        const float gref = GS[128 + d], g63 = GS[d];
#pragma unroll
        for (int j = 0; j < 16; ++j) {
            const float g = off + G[j]; const int t = 16 * tq + j;
            QT[t * GP_ST + d] = (bf16)(cvtpk(qv[j] * __expf(g - gref), 0.f) & 0xffffu);
            KT[t * GP_ST + d] = (bf16)(cvtpk(kv[j] * __expf(gref - g), 0.f) & 0xffffu);
            QH[t * GP_ST + d] = (bf16)(cvtpk(qv[j] * __expf(g), 0.f) & 0xffffu);
            KH[t * GP_ST + d] = (bf16)(cvtpk(kv[j] * __expf(g63 - g), 0.f) & 0xffffu);
        }
    }
    __syncthreads(); asm volatile("" : "+v"(tid), "+v"(lane));
    if (wid < 4) {
        const int rt = wid >> 1, ct = wid & 1, r = lane & 31, h = lane >> 5;
        const LAS bf16* Am = QT + (32 * rt + r) * GP_ST + 8 * h; const LAS bf16* Bm = KT + (32 * ct + r) * GP_ST + 8 * h;
        f32x16 acc;
#pragma unroll
        for (int i = 0; i < 16; ++i) acc[i] = 0.f;
#pragma unroll
        for (int kt = 0; kt < 8; ++kt) acc = MFMA32(*(const LAS bf16x8*)(Am + 16 * kt), *(const LAS bf16x8*)(Bm + 16 * kt), acc);
#pragma unroll
        for (int i = 0; i < 16; ++i) { const int t = 32 * rt + crow_(i, h), s = 32 * ct + r; AT[t * GP_TST + s] = (bf16)(cvtpk(t >= s ? acc[i] : 0.f, 0.f) & 0xffffu); }
    } else {
        const int t2 = tid - 256;
#pragma unroll
        for (int n = 0; n < 4; ++n) { const int task = t2 + 256 * n, f = task >> 6, l = task & 63, rt = f >> 3, kt = f & 7, r = l & 31, h = l >> 5;
            *(u32x4*)(rec + HR_Q + (f * 64 + l) * 16) = afrag_rows(QH, GP_ST, 32 * rt + r, kt, h); }
    }
    __syncthreads(); asm volatile("" : "+v"(tid), "+v"(lane));
    {
#pragma unroll
        for (int n = 0; n < 2; ++n) {
            const int task = tid + 512 * n, f = task >> 6, l = task & 63, dt = f >> 2, ts = f & 3, r = l & 31, h = l >> 5;
            unsigned short v[8];
#pragma unroll
            for (int j = 0; j < 8; ++j) v[j] = KH[kidx_(ts, h, j) * GP_ST + 32 * dt + r];
            *(u32x4*)(rec + HR_K + (f * 64 + l) * 16) = (u32x4){(unsigned)v[0] | ((unsigned)v[1] << 16), (unsigned)v[2] | ((unsigned)v[3] << 16), (unsigned)v[4] | ((unsigned)v[5] << 16), (unsigned)v[6] | ((unsigned)v[7] << 16)};
        }
#pragma unroll
        for (int n = 0; n < 2; ++n) {
            const int task = tid + 512 * n, f = task >> 6, l = task & 63, slab = f >> 2, ts = f & 3, r = l & 31, h = l >> 5;
            unsigned short v[8];
#pragma unroll
            for (int j = 0; j < 8; ++j) v[j] = IS[kidx_(ts, h, j) * GP_ST + 32 * slab + r];
            *(u32x4*)(rec + HR_I + (f * 64 + l) * 16) = (u32x4){(unsigned)v[0] | ((unsigned)v[1] << 16), (unsigned)v[2] | ((unsigned)v[3] << 16), (unsigned)v[4] | ((unsigned)v[5] << 16), (unsigned)v[6] | ((unsigned)v[7] << 16)};
        }
        {
            const int f = tid >> 6, l = tid & 63, rt = f >> 2, ts = f & 3, r = l & 31, h = l >> 5;
            *(u32x4*)(rec + HR_A + (f * 64 + l) * 16) = afrag_rows(AT, GP_TST, 32 * rt + r, ts, h);
        }
    }
    __syncthreads(); asm volatile("" : "+v"(tid), "+v"(lane));
}

template <int NP> __device__ __forceinline__ void stage_image(LAS unsigned char* lds, const unsigned char* rec, unsigned nbytes, int tid) {
    unsigned off0 = (unsigned)tid * 16u; asm volatile("" : "+v"(off0));
    u32x4 v[NP];
#pragma unroll
    for (int i = 0; i < NP; ++i) { if (i * (NTHREADS * 16) + (NTHREADS * 16) <= (int)nbytes || off0 + i * (NTHREADS * 16) < nbytes) v[i] = *(const u32x4*)(rec + i * (NTHREADS * 16) + off0); }
    __syncthreads();
#pragma unroll
    for (int i = 0; i < NP; ++i) { if (i * (NTHREADS * 16) + (NTHREADS * 16) <= (int)nbytes || off0 + i * (NTHREADS * 16) < nbytes) *(LAS u32x4*)(lds + i * (NTHREADS * 16) + off0) = v[i]; }
    __syncthreads();
}
#define LFRAG(off) (*(const LAS bf16x8*)(lb + (off)))
__device__ __forceinline__ void gdn_seq_block(const PA& a, LAS unsigned char* lds, int u, int tid, int wid, int lane) {
    unsigned char* ws = a.ws();
    const int b = u >> 5, vh = u & 31, slab = wid;
    LAS unsigned char* lb = lds;
    bf16* O16 = (bf16*)(ws + WS_O16);
    f32x16 S[4];
#pragma unroll
    for (int d = 0; d < 4; ++d)
#pragma unroll
        for (int i = 0; i < 16; ++i) S[d][i] = 0.f;
    const unsigned char* rec0 = ws + WS_GREC + (size_t)((b * 32 + vh) * 32) * GREC_BYTES;
    stage_image<7>(lds, rec0, GR_IMG, tid);
    u32x4 un[2][2]; float decn = 0.f;
    if (wid < 4) { decn = ldg_agent((const float*)(rec0 + GR_DEC));
#pragma unroll
        for (int rt = 0; rt < 2; ++rt) { const u32x4* up = (const u32x4*)(rec0 + GR_U + ((slab * 2 + rt) * 64 + lane) * 32); un[rt][0] = up[0]; un[rt][1] = up[1]; } }
    for (int c = 0; c < 32; ++c) {
        const unsigned char* recn = rec0 + (size_t)(c + 1 < 32 ? c + 1 : c) * GREC_BYTES;
        u32x4 vimg[14];
        if (wid >= 4) {
            unsigned off0 = (unsigned)(tid - 256) * 16u; asm volatile("" : "+v"(off0));
#pragma unroll
            for (int i = 0; i < 14; ++i) vimg[i] = *(const u32x4*)(recn + i * 4096 + off0);
        }
        asm volatile("" : "+v"(lane));
        const int r = lane & 31, h = lane >> 5;
        if (wid < 4) {
            const float dec = decn;
            f32x16 P1[2], P2[2];
#pragma unroll
            for (int rt = 0; rt < 2; ++rt) {
                const u32x4 u0 = un[rt][0], u1 = un[rt][1];
                P1[rt][0] = bflo(u0.x); P1[rt][1] = bfhi(u0.x); P1[rt][2] = bflo(u0.y); P1[rt][3] = bfhi(u0.y); P1[rt][4] = bflo(u0.z); P1[rt][5] = bfhi(u0.z); P1[rt][6] = bflo(u0.w); P1[rt][7] = bfhi(u0.w);
                P1[rt][8] = bflo(u1.x); P1[rt][9] = bfhi(u1.x); P1[rt][10] = bflo(u1.y); P1[rt][11] = bfhi(u1.y); P1[rt][12] = bflo(u1.z); P1[rt][13] = bfhi(u1.z); P1[rt][14] = bflo(u1.w); P1[rt][15] = bfhi(u1.w);
#pragma unroll
                for (int i = 0; i < 16; ++i) P2[rt][i] = 0.f;
            }
            decn = ldg_agent((const float*)(recn + GR_DEC));
#pragma unroll
            for (int rt = 0; rt < 2; ++rt) { const u32x4* up = (const u32x4*)(recn + GR_U + ((slab * 2 + rt) * 64 + lane) * 32); un[rt][0] = up[0]; un[rt][1] = up[1]; }
#pragma unroll
            for (int d = 0; d < 4; ++d) {
                const bf16x8 b0 = pack_acc<0>(S[d]), b1 = pack_acc<1>(S[d]);
#pragma unroll
                for (int rt = 0; rt < 2; ++rt) {
                    P1[rt] = MFMA32(LFRAG(GR_W + ((rt * 8 + 2 * d) * 64 + lane) * 16), b0, P1[rt]);     P2[rt] = MFMA32(LFRAG(GR_Q + ((rt * 8 + 2 * d) * 64 + lane) * 16), b0, P2[rt]);
                    P1[rt] = MFMA32(LFRAG(GR_W + ((rt * 8 + 2 * d + 1) * 64 + lane) * 16), b1, P1[rt]); P2[rt] = MFMA32(LFRAG(GR_Q + ((rt * 8 + 2 * d + 1) * 64 + lane) * 16), b1, P2[rt]);
                }
                __builtin_amdgcn_sched_barrier(0);
            }
            const bf16x8 bv0 = pack_acc<0>(P1[0]), bv1 = pack_acc<1>(P1[0]), bv2 = pack_acc<0>(P1[1]), bv3 = pack_acc<1>(P1[1]);
#pragma unroll
            for (int rt = 0; rt < 2; ++rt) {
                P2[rt] = MFMA32(LFRAG(GR_A + ((rt * 4 + 0) * 64 + lane) * 16), bv0, P2[rt]); P2[rt] = MFMA32(LFRAG(GR_A + ((rt * 4 + 1) * 64 + lane) * 16), bv1, P2[rt]);
                P2[rt] = MFMA32(LFRAG(GR_A + ((rt * 4 + 2) * 64 + lane) * 16), bv2, P2[rt]); P2[rt] = MFMA32(LFRAG(GR_A + ((rt * 4 + 3) * 64 + lane) * 16), bv3, P2[rt]);
                __builtin_amdgcn_sched_barrier(0);
            }
            {
                bf16* op = O16 + (size_t)(b * SEQ + c * 64) * 6144 + 2048 + vh * 128 + 32 * slab + r;
#pragma unroll
                for (int rt = 0; rt < 2; ++rt)
#pragma unroll
                    for (int i = 0; i < 16; ++i) op[(size_t)(32 * rt + crow_(i, h)) * 6144] = (bf16)(cvtpk(P2[rt][i], 0.f) & 0xffffu);
            }
#pragma unroll
            for (int d = 0; d < 4; ++d) {
#pragma unroll
                for (int i = 0; i < 16; ++i) S[d][i] *= dec;
                S[d] = MFMA32(LFRAG(GR_K + ((d * 4 + 0) * 64 + lane) * 16), bv0, S[d]); S[d] = MFMA32(LFRAG(GR_K + ((d * 4 + 1) * 64 + lane) * 16), bv1, S[d]);
                S[d] = MFMA32(LFRAG(GR_K + ((d * 4 + 2) * 64 + lane) * 16), bv2, S[d]); S[d] = MFMA32(LFRAG(GR_K + ((d * 4 + 3) * 64 + lane) * 16), bv3, S[d]);
                __builtin_amdgcn_sched_barrier(0);
            }
        }
        __syncthreads();
        if (wid >= 4 && c + 1 < 32) { unsigned off0 = (unsigned)(tid - 256) * 16u; asm volatile("" : "+v"(off0));
#pragma unroll
            for (int i = 0; i < 14; ++i) *(LAS u32x4*)(lds + i * 4096 + off0) = vimg[i]; }
        __syncthreads();
    }
    if (wid < 4) {
        asm volatile("" : "+v"(lane)); const int r = lane & 31, h = lane >> 5;
        float* so = a.out() + O_GDP + (size_t)((b * 32 + vh) * 128) * 128 + 32 * slab + r;
#pragma unroll
        for (int d = 0; d < 4; ++d)
#pragma unroll
            for (int i = 0; i < 16; ++i) so[(size_t)(32 * d + crow_(i, h)) * 128] = S[d][i];
    }
    __syncthreads();
}
__device__ __forceinline__ void hgrn_seq_block(const PA& a, LAS unsigned char* lds, int u, int tid, int wid, int lane) {
    unsigned char* ws = a.ws();
    const int b = u >> 4, hd = u & 15, slab = wid;
    LAS unsigned char* lb = lds;
    bf16* O16 = (bf16*)(ws + WS_O16);
    f32x16 S[4];
#pragma unroll
    for (int d = 0; d < 4; ++d)
#pragma unroll
        for (int i = 0; i < 16; ++i) S[d][i] = 0.f;
    const unsigned char* rec0 = ws + WS_HREC + (size_t)((b * 16 + hd) * 32) * HREC_BYTES;
    stage_image<8>(lds, rec0, HR_IMG, tid);
    for (int c = 0; c < 32; ++c) {
        const unsigned char* recn = rec0 + (size_t)(c + 1 < 32 ? c + 1 : c) * HREC_BYTES;
        u32x4 vimg[15];
        if (wid >= 4) {
            unsigned off0 = (unsigned)(tid - 256) * 16u; asm volatile("" : "+v"(off0));
#pragma unroll
            for (int i = 0; i < 15; ++i) if (i < 14 || off0 + 14 * 4096 < (unsigned)HR_IMG) vimg[i] = *(const u32x4*)(recn + i * 4096 + off0);
        }
        asm volatile("" : "+v"(lane));
        const int r = lane & 31, h = lane >> 5;
        if (wid < 4) {
            f32x16 o[2];
#pragma unroll
            for (int rt = 0; rt < 2; ++rt)
#pragma unroll
                for (int i = 0; i < 16; ++i) o[rt][i] = 0.f;
#pragma unroll
            for (int d = 0; d < 4; ++d) {
                const bf16x8 b0 = pack_acc<0>(S[d]), b1 = pack_acc<1>(S[d]);
#pragma unroll
                for (int rt = 0; rt < 2; ++rt) { o[rt] = MFMA32(LFRAG(HR_Q + ((rt * 8 + 2 * d) * 64 + lane) * 16), b0, o[rt]); o[rt] = MFMA32(LFRAG(HR_Q + ((rt * 8 + 2 * d + 1) * 64 + lane) * 16), b1, o[rt]); }
                __builtin_amdgcn_sched_barrier(0);
            }
            const bf16x8 i0 = LFRAG(HR_I + ((slab * 4 + 0) * 64 + lane) * 16), i1 = LFRAG(HR_I + ((slab * 4 + 1) * 64 + lane) * 16), i2 = LFRAG(HR_I + ((slab * 4 + 2) * 64 + lane) * 16), i3 = LFRAG(HR_I + ((slab * 4 + 3) * 64 + lane) * 16);
#pragma unroll
            for (int rt = 0; rt < 2; ++rt) {
                o[rt] = MFMA32(LFRAG(HR_A + ((rt * 4 + 0) * 64 + lane) * 16), i0, o[rt]); o[rt] = MFMA32(LFRAG(HR_A + ((rt * 4 + 1) * 64 + lane) * 16), i1, o[rt]);
                o[rt] = MFMA32(LFRAG(HR_A + ((rt * 4 + 2) * 64 + lane) * 16), i2, o[rt]); o[rt] = MFMA32(LFRAG(HR_A + ((rt * 4 + 3) * 64 + lane) * 16), i3, o[rt]);
                __builtin_amdgcn_sched_barrier(0);
            }
            {
                bf16* op = O16 + (size_t)(b * SEQ + c * 64) * 6144 + hd * 128 + 32 * slab + r;
#pragma unroll
                for (int rt = 0; rt < 2; ++rt)
#pragma unroll
                    for (int i = 0; i < 16; ++i) op[(size_t)(32 * rt + crow_(i, h)) * 6144] = (bf16)(cvtpk(o[rt][i], 0.f) & 0xffffu);
            }
            const LAS float* dec = (const LAS float*)(lb + HR_DEC);
#pragma unroll
            for (int d = 0; d < 4; ++d) {
#pragma unroll
                for (int i4 = 0; i4 < 4; ++i4) { const f32x4 dv = *(const LAS f32x4*)(dec + 32 * d + 8 * i4 + 4 * h);
#pragma unroll
                    for (int e = 0; e < 4; ++e) S[d][4 * i4 + e] *= dv[e]; }
                S[d] = MFMA32(LFRAG(HR_K + ((d * 4 + 0) * 64 + lane) * 16), i0, S[d]); S[d] = MFMA32(LFRAG(HR_K + ((d * 4 + 1) * 64 + lane) * 16), i1, S[d]);
                S[d] = MFMA32(LFRAG(HR_K + ((d * 4 + 2) * 64 + lane) * 16), i2, S[d]); S[d] = MFMA32(LFRAG(HR_K + ((d * 4 + 3) * 64 + lane) * 16), i3, S[d]);
                __builtin_amdgcn_sched_barrier(0);
            }
        }
        __syncthreads();
        if (wid >= 4 && c + 1 < 32) { unsigned off0 = (unsigned)(tid - 256) * 16u; asm volatile("" : "+v"(off0));
#pragma unroll
            for (int i = 0; i < 15; ++i) if (i < 14 || off0 + 14 * 4096 < (unsigned)HR_IMG) *(LAS u32x4*)(lds + i * 4096 + off0) = vimg[i]; }
        __syncthreads();
    }
    if (wid < 4) {
        asm volatile("" : "+v"(lane)); const int r = lane & 31, h = lane >> 5;
        float* so = a.out() + O_HGP + (size_t)((b * 16 + hd) * 128) * 128 + 32 * slab + r;
#pragma unroll
        for (int d = 0; d < 4; ++d)
#pragma unroll
            for (int i = 0; i < 16; ++i) so[(size_t)(32 * d + crow_(i, h)) * 128] = S[d][i];
    }
    __syncthreads();
}

#define XB_TMO      128
#define XB_XCNT(j)  (256  + 64 * (j))
#define XB_XSUB(j)  (1280 + 64 * (j))
#define XB_XGEN(j)  (2304 + 64 * (j))
#define XB_TOP      3328
#define XB_TOPGEN   3392
#define XCD_BAR_WORDS 3456
#define XB_SPIN_CAP (1u << 18)
__device__ __forceinline__ unsigned xb_ld(unsigned* p)              { return __hip_atomic_load(p, __ATOMIC_RELAXED, __HIP_MEMORY_SCOPE_AGENT); }
__device__ __forceinline__ unsigned xb_add(unsigned* p, unsigned v) { return __hip_atomic_fetch_add(p, v, __ATOMIC_RELAXED, __HIP_MEMORY_SCOPE_AGENT); }
__device__ __forceinline__ unsigned xb_xcc_id() { return (unsigned)__builtin_amdgcn_s_getreg((3 << 11) | 20) & 0xFu; }
#define XB_SPIN(cond, bar) do { unsigned _sp = 0; while (cond) { __builtin_amdgcn_s_sleep(1); \
    if ((++_sp & 255u) == 0u) { if (xb_ld(&(bar)[XB_TMO])) break; if (_sp > XB_SPIN_CAP) { atomicAdd(&(bar)[XB_TMO], 1u); break; } } } } while (0)
__device__ __forceinline__ void xcd_barrier_complete(unsigned* bar, unsigned x, unsigned G, unsigned& nloc, unsigned& nx) {
    unsigned sum, cnt, mine, sp = 0u;
    for (;;) {
        sum = 0u; cnt = 0u; mine = 0u;
#pragma unroll
        for (unsigned j = 0; j < 16; ++j) { const unsigned c = xb_ld(&bar[XB_XCNT(j)]); sum += c; cnt += (c > 0u) ? 1u : 0u; mine = (j == x) ? c : mine; }
        if (sum == G) break;
        __builtin_amdgcn_s_sleep(1);
        if ((++sp & 255u) == 0u) { if (xb_ld(&bar[XB_TMO])) break; if (sp > XB_SPIN_CAP) { atomicAdd(&bar[XB_TMO], 1u); break; } }
    }
    nloc = mine > 0u ? mine : 1u; nx = cnt > 0u ? cnt : 1u;
}
__device__ __forceinline__ void xcd_barrier(unsigned* bar, unsigned x, volatile LAS unsigned* st, int tid, unsigned G) {
    asm volatile("s_waitcnt vmcnt(0)" ::: "memory");
    __syncthreads();
    if (tid == 0) {
        __builtin_amdgcn_s_waitcnt(0);
        unsigned nloc = st[0], nx = st[1];
        if (nloc == 0u) { xcd_barrier_complete(bar, x, G, nloc, nx); st[0] = nloc; st[1] = nx; }
        const unsigned old = xb_add(&bar[XB_XSUB(x)], 1u);
        const unsigned gen = old / nloc;
        if (old + 1u == (gen + 1u) * nloc) {
            __builtin_amdgcn_fence(__ATOMIC_RELEASE, "agent");
            asm volatile("s_waitcnt vmcnt(0)" ::: "memory");
            const unsigned og = xb_add(&bar[XB_TOP], 1u);
            const unsigned tg = og / nx;
            if (og + 1u == (tg + 1u) * nx) xb_add(&bar[XB_TOPGEN], 1u);
            else XB_SPIN(xb_ld(&bar[XB_TOPGEN]) == tg, bar);
            __builtin_amdgcn_fence(__ATOMIC_ACQUIRE, "agent");
            xb_add(&bar[XB_XGEN(x)], 1u);
            asm volatile("s_waitcnt vmcnt(0)" ::: "memory");
        } else {
            XB_SPIN(xb_ld(&bar[XB_XGEN(x)]) == gen, bar);
            __builtin_amdgcn_fence(__ATOMIC_ACQUIRE, "agent");
            asm volatile("s_waitcnt vmcnt(0)" ::: "memory");
        }
    }
    __syncthreads();
}
constexpr int CW_CNT = 8192;
constexpr int CW_WORK = 64;
constexpr int CW_BAR = 4096;
constexpr size_t CTL_ZERO_BYTES = 65536;
constexpr int LDS_ST_OFF = LDS_BYTES - 64;

__global__ void __launch_bounds__(NTHREADS, 2) fwd(Args args_unused) {
    extern __shared__ __attribute__((aligned(16))) unsigned char lds_raw[];
    LAS unsigned char* lds = (LAS unsigned char*)lds_raw;
    const int wid = __builtin_amdgcn_readfirstlane(threadIdx.x >> 6);
    const int G = gridDim.x, bx = blockIdx.x;
    const int vcu = (G % 8 == 0) ? (bx % 8) * (G / 8) + bx / 8 : bx;
    const int gw = vcu * NWAVES + wid, NGW = G * NWAVES;
    if (PA::get().ph_lo() == -12345) cg::this_grid().sync();
    volatile LAS unsigned* bst = (volatile LAS unsigned*)(lds + LDS_ST_OFF);
    const unsigned xcc = xb_xcc_id();
    { const PA a0 = PA::get(); const int l0 = lane_id_(); if (wid == 0 && l0 < 2) bst[l0] = 0u;
      if (a0.ph_hi() - a0.ph_lo() > 1 && wid == 0 && l0 == 0) (void)xb_add((unsigned*)a0.ws() + CW_BAR + XB_XCNT(xcc), 1u); }
    __syncthreads();
#ifndef PH_MASK
#define PH_MASK 0xffff
#endif
#define IN(k) (((PH_MASK >> (k)) & 1) && ph_in(k))
#define SEAM(k) do { if (IN(k) && IN((k) + 1)) { const PA ab = PA::get(); xcd_barrier((unsigned*)ab.ws() + CW_BAR, xcc, bst, wid * 64 + lane_id_(), (unsigned)G); } } while (0)

    if (IN(0)) for (int rep_ = 0; rep_ < NREP(0); ++rep_) { if (rep_) { const PA ab = PA::get(); xcd_barrier((unsigned*)ab.ws() + CW_BAR, xcc, bst, wid * 64 + lane_id_(), (unsigned)G); }
        const PA a = PA::get(); unsigned char* ws = a.ws(); const int lane = lane_id_(), tid = wid * 64 + lane; (void)tid;
        for (int rm_ = 0; rm_ < NREP(25); ++rm_) for (int cb = vcu; cb < NADA / 48; cb += G) mod_item(a, lds, cb, tid, wid, lane);
        __syncthreads();
        LAS float* scr = (LAS float*)(lds + wid * 16384);
        constexpr int I0 = 32 * 770, I1 = 32 * 64, I2 = 64 * 64, I3 = 32 * 64, I4 = 32 * 256, I5 = 128 * 64, NIT = I0 + I1 + I2 + I3 + I4 + I5;
        bf16* BtIn = (bf16*)(ws + WS_BTIN); bf16* BtOut = (bf16*)(ws + WS_BTOUT); bf16* BtO = (bf16*)(ws + WS_BTO); bf16* BtUp = (bf16*)(ws + WS_BTUP); bf16* BtDn = (bf16*)(ws + WS_BTDN);
        for (int rt_ = 0; rt_ < NREP(26); ++rt_) for (int it = gw; it < NIT; it += NGW) {
            int r = it;
            if (r < I0) { const int kb = r / 770, nb = r % 770, n0 = nb * 32; const int nd = n0 < 20480 ? n0 : (n0 < 20544 ? n0 - 20480 + 24576 : n0 - 64);
                transpose_item(a.in(I_WIN), N_IN, BtIn, 2048, kb * 64, n0, nd, scr, lane); continue; } r -= I0;
            if (r < I1) { transpose_item(a.in(I_WOHG), 2048, BtOut, 6144, (r / 64) * 64, (r % 64) * 32, (r % 64) * 32, scr, lane); continue; } r -= I1;
            if (r < I2) { transpose_item(a.in(I_WOGD), 2048, BtOut + 2048, 6144, (r / 64) * 64, (r % 64) * 32, (r % 64) * 32, scr, lane); continue; } r -= I2;
            if (r < I3) { transpose_item(a.in(I_WO), 2048, BtO, 2048, (r / 64) * 64, (r % 64) * 32, (r % 64) * 32, scr, lane); continue; } r -= I3;
            if (r < I4) { transpose_item(a.in(I_WUP), 8192, BtUp, 2048, (r / 256) * 64, (r % 256) * 32, (r % 256) * 32, scr, lane); continue; } r -= I4;
            transpose_item(a.in(I_WDN), 2048, BtDn, 8192, (r / 64) * 64, (r % 64) * 32, (r % 64) * 32, scr, lane);
        }
        { u32x4* z = (u32x4*)(BtIn + (size_t)N_IN * 2048); const int nz = (N_INP - N_IN) * 2048 * 2 / 16;
          for (int i = vcu * NTHREADS + tid; i < nz; i += G * NTHREADS) z[i] = (u32x4){0u, 0u, 0u, 0u}; }
    }
    SEAM(0);
    if (IN(1)) for (int rep_ = 0; rep_ < NREP(1); ++rep_) { if (rep_) { const PA ab = PA::get(); xcd_barrier((unsigned*)ab.ws() + CW_BAR, xcc, bst, wid * 64 + lane_id_(), (unsigned)G); }
        const PA a = PA::get(); unsigned char* ws = a.ws(); const int lane = lane_id_(), tid = wid * 64 + lane; (void)tid;
        const float* mod = (const float*)(ws + WS_MOD); const float* ng = a.in(I_NG); bf16* A1 = (bf16*)(ws + WS_A1);
        for (int row = gw; row < MROWS; row += NGW) {
            const f32x4* xr = (const f32x4*)xrow_ptr(a, row) + lane; const float* md = mod + (size_t)seq_of_row(row) * NADA;
            f32x4 v[8]; float ss = 0.f;
#pragma unroll
            for (int j = 0; j < 8; ++j) { v[j] = xr[64 * j]; ss += (v[j][0] * v[j][0] + v[j][1] * v[j][1]) + (v[j][2] * v[j][2] + v[j][3] * v[j][3]); }
            const float r = rsqrtf(wave_sum(ss) * (1.f / DM) + EPS);
            u32x2* o = (u32x2*)(A1 + (size_t)row * DM) + lane;
#pragma unroll
            for (int j = 0; j < 8; ++j) { const int c = 4 * lane + 256 * j; const f32x4 g = *(const f32x4*)(ng + c), sh = *(const f32x4*)(md + c), sc = *(const f32x4*)(md + 2048 + c);
                f32x4 y; _Pragma("unroll") for (int e = 0; e < 4; ++e) y[e] = v[j][e] * r * g[e] * (1.f + sc[e]) + sh[e];
                o[64 * j] = (u32x2){pk2(y[0], y[1]), pk2(y[2], y[3])}; }
        }
    }
    SEAM(1);
    if (IN(2)) for (int rep_ = 0; rep_ < NREP(2); ++rep_) { if (rep_) { const PA ab = PA::get(); xcd_barrier((unsigned*)ab.ws() + CW_BAR, xcc, bst, wid * 64 + lane_id_(), (unsigned)G); }
        const PA a = PA::get(); unsigned char* ws = a.ws(); const int lane = lane_id_(), tid = wid * 64 + lane; (void)tid;
        pg8::Gemm g{(const bf16*)(ws + WS_A1), (const bf16*)(ws + WS_BTIN), 2048, 2048, 2048}; pg8::StaticOrder S; S.init(MROWS, N_INP, G, bx, 2048);
        EpiIn E{ws, a.in(I_LB), a.in(I_ALOG), a.in(I_DTB)};
        pg8::gemm_phase<EpiIn, pg8::StaticOrder, true, true>(lds, g, S, E, wid);
    }
    SEAM(2);
    if (IN(3)) for (int rep_ = 0; rep_ < NREP(3); ++rep_) { if (rep_) { const PA ab = PA::get(); xcd_barrier((unsigned*)ab.ws() + CW_BAR, xcc, bst, wid * 64 + lane_id_(), (unsigned)G); }
        const PA a = PA::get(); unsigned char* ws = a.ws(); const int lane = lane_id_(), tid = wid * 64 + lane; (void)tid;
#ifndef NO_GP
        for (int rr_ = 0; rr_ < NREP(16); ++rr_) for (int u = bx; u < 2048; u += G) gdn_prep_unit(a, lds, u, tid, wid, lane);
#endif
#ifndef NO_HP
        for (int rr_ = 0; rr_ < NREP(17); ++rr_) for (int u = bx; u < 2048; u += G) hgrn_prep_unit(a, lds, u, tid, wid, lane);
#endif
        { const bf16* US = (const bf16*)(ws + WS_US); bf16* UCS = (bf16*)(ws + WS_UCS); const float* cw = a.in(I_CW); const float* cc = a.in(I_CC);
          for (int it = gw; it < 512 * 16; it += NGW) {
            const int row = it >> 4, g = it & 15, c = g * 512 + 8 * lane, t = row & 3, b = row >> 2;
            float x[8];
#pragma unroll
            for (int e = 0; e < 8; ++e) x[e] = 0.f;
#pragma unroll
            for (int j = 0; j < 4; ++j) {
                const int tt = t - 3 + j; float u[8];
                if (tt >= 0) { const u32x4 w = *(const u32x4*)(US + (size_t)(row - 3 + j) * CONVCH + c);
                    u[0] = bflo(w.x); u[1] = bfhi(w.x); u[2] = bflo(w.y); u[3] = bfhi(w.y); u[4] = bflo(w.z); u[5] = bfhi(w.z); u[6] = bflo(w.w); u[7] = bfhi(w.w); }
                else { const f32x4* cp = (const f32x4*)(cc + ((size_t)b * 3 + (3 + tt)) * CONVCH + c); const f32x4 w0 = cp[0], w1 = cp[1];
                    u[0] = w0[0]; u[1] = w0[1]; u[2] = w0[2]; u[3] = w0[3]; u[4] = w1[0]; u[5] = w1[1]; u[6] = w1[2]; u[7] = w1[3]; }
                const f32x4* wp = (const f32x4*)(cw + (size_t)j * CONVCH + c); const f32x4 c0 = wp[0], c1 = wp[1];
                x[0] = fmaf(c0[0], u[0], x[0]); x[1] = fmaf(c0[1], u[1], x[1]); x[2] = fmaf(c0[2], u[2], x[2]); x[3] = fmaf(c0[3], u[3], x[3]);
                x[4] = fmaf(c1[0], u[4], x[4]); x[5] = fmaf(c1[1], u[5], x[5]); x[6] = fmaf(c1[2], u[6], x[6]); x[7] = fmaf(c1[3], u[7], x[7]);
            }
            float ss = 0.f;
#pragma unroll
            for (int e = 0; e < 8; ++e) { x[e] = siluf_(x[e]); ss = fmaf(x[e], x[e], ss); }
            if (g < 8) { ss += __shfl_xor(ss, 1); ss += __shfl_xor(ss, 2); ss += __shfl_xor(ss, 4); ss += __shfl_xor(ss, 8);
                float r = rsqrtf(ss + EPS); if (g < 4) r *= 0.08838834764831845f;
#pragma unroll
                for (int e = 0; e < 8; ++e) x[e] *= r; }
            *(u32x4*)(UCS + (size_t)row * CONVCH + c) = (u32x4){pk2(x[0], x[1]), pk2(x[2], x[3]), pk2(x[4], x[5]), pk2(x[6], x[7])};
          }
          const bf16* UPr = (const bf16*)(ws + WS_UP);
          for (int i = vcu * NTHREADS + tid; i < (12 + 384) * (CONVCH / 8); i += G * NTHREADS) {
            const int rr = i / (CONVCH / 8), c = (i % (CONVCH / 8)) * 8; const bf16* src; float* dst;
            if (rr < 12) { const int b = rr / 3, j = rr % 3; src = UPr + (size_t)(b * SEQ + SEQ - 3 + j) * CONVCH + c; dst = a.out() + O_CCP + (size_t)rr * CONVCH + c; }
            else { const int r2 = rr - 12, b = r2 / 3, j = r2 % 3; src = US + (size_t)(b * DSEQ + 1 + j) * CONVCH + c; dst = a.out() + O_CCS + (size_t)r2 * CONVCH + c; }
            const u32x4 w = *(const u32x4*)src;
            ((f32x4*)dst)[0] = (f32x4){bflo(w.x), bfhi(w.x), bflo(w.y), bfhi(w.y)}; ((f32x4*)dst)[1] = (f32x4){bflo(w.z), bfhi(w.z), bflo(w.w), bfhi(w.w)};
          } }
    }
    SEAM(3);
    if (IN(4)) for (int rep_ = 0; rep_ < NREP(4); ++rep_) { if (rep_) { const PA ab = PA::get(); xcd_barrier((unsigned*)ab.ws() + CW_BAR, xcc, bst, wid * 64 + lane_id_(), (unsigned)G); }
        const PA a = PA::get(); unsigned char* ws = a.ws(); const int lane = lane_id_(), tid = wid * 64 + lane; (void)tid;
        for (int rr_ = 0; rr_ < NREP(19); ++rr_) {
#ifndef NO_GS
        if (bx < 128) gdn_seq_block(a, lds, bx, tid, wid, lane);
#endif
#ifndef NO_HS
        if (bx >= 128 && bx < 192) hgrn_seq_block(a, lds, bx - 128, tid, wid, lane);
#endif
        }
        __syncthreads();
        {
            LAS float* wl = (LAS float*)(lds + wid * 4096);
            const int grp = bx & 31;
            unsigned* ctr = (unsigned*)ws + CW_CNT + grp * 64 + rep_ * 2048;
#define SAMPLE_TICKET(pv) do { unsigned t_ = 0; if (lane_id_() == 0) t_ = atomicAdd(ctr, 1u); pv = (int)__builtin_amdgcn_readfirstlane(t_); } while (0)
#define SAMPLE_LOAD(itv, SS) do { const int ln_ = lane_id_(); const bool gd_ = (itv) < NI_GS; const int r_ = gd_ ? (itv) : (itv) - NI_GS; \
            const float* s0_ = (gd_ ? a.in(I_SGD) : a.in(I_SHG)) + (size_t)(((r_ >> 2) * 128 + 64 * (ln_ >> 5)) * 128 + 32 * (r_ & 3) + (ln_ & 31)); \
            _Pragma("unroll") for (int j = 0; j < 64; ++j) SS[j] = s0_[j * 128]; } while (0)
#define SAMPLE_RUN(itv, TT, SS) do { const int ln = lane_id_(); if ((itv) < NI_GS) gdn_item(a, wl, (itv) >> 7, ((itv) >> 2) & 31, (itv) & 3, ln, TT, SS); \
            else { const int r = (itv) - NI_GS; hgrn_item(a, wl, r >> 6, (r >> 2) & 15, r & 3, ln, TT, SS); } } while (0)
            int itk; SAMPLE_TICKET(itk);
            while (itk < 768) {
                const int i0 = grp * 768 + itk;
                float ta[4][7], Sa[64];
                item_inputs(a, i0, lane_id_(), ta);
                SAMPLE_LOAD(i0, Sa);
                int inext; SAMPLE_TICKET(inext);
                SAMPLE_RUN(i0, ta, Sa);
                itk = inext;
            }
#undef SAMPLE_RUN
#undef SAMPLE_LOAD
#undef SAMPLE_TICKET
        }
    }
    SEAM(4);
    if (IN(5)) for (int rep_ = 0; rep_ < NREP(5); ++rep_) { if (rep_) { const PA ab = PA::get(); xcd_barrier((unsigned*)ab.ws() + CW_BAR, xcc, bst, wid * 64 + lane_id_(), (unsigned)G); }
        const PA a = PA::get(); unsigned char* ws = a.ws(); const int lane = lane_id_(), tid = wid * 64 + lane; (void)tid;
        const bf16* O16 = (const bf16*)(ws + WS_O16); bf16* OA = (bf16*)(ws + WS_OA); const bf16* Gh = (const bf16*)(ws + WS_GH); const bf16* Gz = (const bf16*)(ws + WS_GZ);
        for (int row = gw; row < MROWS; row += NGW) {
            const u32x4* op = (const u32x4*)(O16 + (size_t)row * 6144) + lane; u32x4* dp = (u32x4*)(OA + (size_t)row * 6144) + lane;
            const u32x4* ghp = (const u32x4*)(Gh + (size_t)row * 2048) + lane; const u32x4* gzp = (const u32x4*)(Gz + (size_t)row * 4096) + lane;
#pragma unroll
            for (int kg = 0; kg < 3; ++kg) {
                u32x4 ov[4], gv[4];
#pragma unroll
                for (int k4 = 0; k4 < 4; ++k4) { const int k = 4 * kg + k4; ov[k4] = op[64 * k]; gv[k4] = kg == 0 ? ghp[64 * k] : gzp[64 * (k - 4)]; }
                const f32x4* np = (const f32x4*)((kg == 0 ? a.in(I_HGN) : a.in(I_GDN)) + 8 * (lane & 15)); const f32x4 n0 = np[0], n1 = np[1];
#pragma unroll
                for (int k4 = 0; k4 < 4; ++k4) {
                    const int k = 4 * kg + k4;
                    float o[8] = {bflo(ov[k4].x), bfhi(ov[k4].x), bflo(ov[k4].y), bfhi(ov[k4].y), bflo(ov[k4].z), bfhi(ov[k4].z), bflo(ov[k4].w), bfhi(ov[k4].w)};
                    const float g[8] = {bflo(gv[k4].x), bfhi(gv[k4].x), bflo(gv[k4].y), bfhi(gv[k4].y), bflo(gv[k4].z), bfhi(gv[k4].z), bflo(gv[k4].w), bfhi(gv[k4].w)};
                    float ss = 0.f;
#pragma unroll
                    for (int e = 0; e < 8; ++e) ss = fmaf(o[e], o[e], ss);
                    ss += __shfl_xor(ss, 1); ss += __shfl_xor(ss, 2); ss += __shfl_xor(ss, 4); ss += __shfl_xor(ss, 8);
                    const float r = rsqrtf(ss * (1.f / 128.f) + EPS);
                    dp[64 * k] = (u32x4){pk2(o[0] * r * n0[0] * g[0], o[1] * r * n0[1] * g[1]), pk2(o[2] * r * n0[2] * g[2], o[3] * r * n0[3] * g[3]),
                                         pk2(o[4] * r * n1[0] * g[4], o[5] * r * n1[1] * g[5]), pk2(o[6] * r * n1[2] * g[6], o[7] * r * n1[3] * g[7])};
                }
                asm volatile("" ::: "memory");
            }
        }
    }
    SEAM(5);
    if (IN(6)) for (int rep_ = 0; rep_ < NREP(6); ++rep_) { if (rep_) { const PA ab = PA::get(); xcd_barrier((unsigned*)ab.ws() + CW_BAR, xcc, bst, wid * 64 + lane_id_(), (unsigned)G); }
        const PA a = PA::get(); unsigned char* ws = a.ws();
        pg8::Gemm g{(const bf16*)(ws + WS_OA), (const bf16*)(ws + WS_BTOUT), 6144, 6144, 6144}; TailOrder S; S.init(G, bx, 2, 0, 32, 2048, 64);
        EpiOutC E{(float*)(ws + WS_T1), (const bf16*)(ws + WS_SA), (const bf16*)(ws + WS_SB), (bf16*)(ws + WS_MG), (float*)(ws + WS_SLO)};
        pg8::gemm_phase<EpiOutC, TailOrder, true, true>(lds, g, S, E, wid);
    }
    SEAM(6);
    if (IN(7)) for (int rep_ = 0; rep_ < NREP(7); ++rep_) { if (rep_) { const PA ab = PA::get(); xcd_barrier((unsigned*)ab.ws() + CW_BAR, xcc, bst, wid * 64 + lane_id_(), (unsigned)G); }
        const PA a = PA::get(); unsigned char* ws = a.ws(); const int lane = lane_id_(), tid = wid * 64 + lane;
        const float* SL = (const float*)(ws + WS_SLO); bf16* MG = (bf16*)(ws + WS_MG) + (size_t)NPROMPT * 2048;
        for (int i = vcu * NTHREADS + tid; i < 512 * 2048 / 8; i += G * NTHREADS) {
            f32x4 s0 = {0.f, 0.f, 0.f, 0.f}, s1 = {0.f, 0.f, 0.f, 0.f};
#pragma unroll 8
            for (int k = 0; k < 32; ++k) { const f32x4* p = (const f32x4*)(SL + (size_t)k * 512 * 2048 + (size_t)i * 8); s0 += p[0]; s1 += p[1]; }
            *(u32x4*)(MG + (size_t)i * 8) = (u32x4){pk2(s0[0], s0[1]), pk2(s0[2], s0[3]), pk2(s1[0], s1[1]), pk2(s1[2], s1[3])};
        }
    }
    SEAM(7);
    if (IN(8)) for (int rep_ = 0; rep_ < NREP(8); ++rep_) { if (rep_) { const PA ab = PA::get(); xcd_barrier((unsigned*)ab.ws() + CW_BAR, xcc, bst, wid * 64 + lane_id_(), (unsigned)G); }
        const PA a = PA::get(); unsigned char* ws = a.ws();
        pg8::Gemm g{(const bf16*)(ws + WS_MG), (const bf16*)(ws + WS_BTO), 2048, 2048, 2048}; TailOrder S; S.init(G, bx, 1, 0, 32, 0, 0);
        EpiF32S E{(float*)(ws + WS_MIX), (float*)(ws + WS_SLW)};
        pg8::gemm_phase<EpiF32S, TailOrder, true, true>(lds, g, S, E, wid);
    }
    SEAM(8);
    if (IN(9)) for (int rep_ = 0; rep_ < NREP(9); ++rep_) { if (rep_) { const PA ab = PA::get(); xcd_barrier((unsigned*)ab.ws() + CW_BAR, xcc, bst, wid * 64 + lane_id_(), (unsigned)G); }
        const PA a = PA::get(); unsigned char* ws = a.ws(); const int lane = lane_id_(), tid = wid * 64 + lane; (void)tid;
        const float* mod = (const float*)(ws + WS_MOD); const float* ng = a.in(I_NG); bf16* A1 = (bf16*)(ws + WS_A1); const float* MIX = (const float*)(ws + WS_MIX); float* H = (float*)(ws + WS_H);
        for (int row = gw; row < MROWS; row += NGW) {
            const f32x4* xr = (const f32x4*)xrow_ptr(a, row) + lane; const f32x4* mr = (const f32x4*)(MIX + (size_t)row * DM) + lane; const float* md = mod + (size_t)seq_of_row(row) * NADA;
            f32x4 v[8]; float ss = 0.f;
#pragma unroll
            for (int j = 0; j < 8; ++j) {
                if (row < NPROMPT) v[j] = mr[64 * j];
                else { const f32x4* sp = (const f32x4*)(ws + WS_SLW) + (size_t)(row - NPROMPT) * 512 + lane + 64 * j; f32x4 t = sp[0];
#pragma unroll
                    for (int k = 1; k < 16; ++k) t += sp[(size_t)k * 512 * 512]; v[j] = t; }
                ss += (v[j][0] * v[j][0] + v[j][1] * v[j][1]) + (v[j][2] * v[j][2] + v[j][3] * v[j][3]); }
            const float r1 = rsqrtf(wave_sum(ss) * (1.f / DM) + EPS);
            f32x4* ho = (f32x4*)(H + (size_t)row * DM) + lane; float s2 = 0.f;
#pragma unroll
            for (int j = 0; j < 8; ++j) { const int c = 4 * lane + 256 * j; const f32x4 g = *(const f32x4*)(ng + 2048 + c), g1 = *(const f32x4*)(md + 4096 + c), x = xr[64 * j];
                _Pragma("unroll") for (int e = 0; e < 4; ++e) { v[j][e] = x[e] + g1[e] * (v[j][e] * r1 * g[e]); s2 += v[j][e] * v[j][e]; }
                ho[64 * j] = v[j]; }
            const float r2 = rsqrtf(wave_sum(s2) * (1.f / DM) + EPS);
            u32x2* o = (u32x2*)(A1 + (size_t)row * DM) + lane;
#pragma unroll
            for (int j = 0; j < 8; ++j) { const int c = 4 * lane + 256 * j; const f32x4 g = *(const f32x4*)(ng + 4096 + c), sh = *(const f32x4*)(md + 6144 + c), sc = *(const f32x4*)(md + 8192 + c);
                f32x4 y; _Pragma("unroll") for (int e = 0; e < 4; ++e) y[e] = v[j][e] * r2 * g[e] * (1.f + sc[e]) + sh[e];
                o[64 * j] = (u32x2){pk2(y[0], y[1]), pk2(y[2], y[3])}; }
        }
    }
    SEAM(9);
    if (IN(10)) for (int rep_ = 0; rep_ < NREP(10); ++rep_) { if (rep_) { const PA ab = PA::get(); xcd_barrier((unsigned*)ab.ws() + CW_BAR, xcc, bst, wid * 64 + lane_id_(), (unsigned)G); }
        const PA a = PA::get(); unsigned char* ws = a.ws(); const int lane = lane_id_(), tid = wid * 64 + lane; (void)tid;
        pg8::Gemm g{(const bf16*)(ws + WS_A1), (const bf16*)(ws + WS_BTUP), 2048, 2048, 2048}; pg8::StaticOrder S; S.init(MROWS, DFF, G, bx, 2048);
        EpiRelu2 E{(bf16*)(ws + WS_U2), DFF};
        pg8::gemm_phase<EpiRelu2, pg8::StaticOrder, true, true>(lds, g, S, E, wid);
    }
    SEAM(10);
    if (IN(11)) for (int rep_ = 0; rep_ < NREP(11); ++rep_) { if (rep_) { const PA ab = PA::get(); xcd_barrier((unsigned*)ab.ws() + CW_BAR, xcc, bst, wid * 64 + lane_id_(), (unsigned)G); }
        const PA a = PA::get(); unsigned char* ws = a.ws(); const int lane = lane_id_(), tid = wid * 64 + lane; (void)tid;
        pg8::Gemm g{(const bf16*)(ws + WS_U2), (const bf16*)(ws + WS_BTDN), DFF, DFF, DFF}; TailOrder S; S.init(G, bx, 1, 0, 128, 0, 0);
        EpiF32S E{(float*)(ws + WS_FF), (float*)(ws + WS_SLD)};
        pg8::gemm_phase<EpiF32S, TailOrder, true, true>(lds, g, S, E, wid);
    }
    SEAM(11);
    if (IN(12)) for (int rep_ = 0; rep_ < NREP(12); ++rep_) { if (rep_) { const PA ab = PA::get(); xcd_barrier((unsigned*)ab.ws() + CW_BAR, xcc, bst, wid * 64 + lane_id_(), (unsigned)G); }
        const PA a = PA::get(); unsigned char* ws = a.ws(); const int lane = lane_id_(), tid = wid * 64 + lane; (void)tid;
        const float* mod = (const float*)(ws + WS_MOD); const float* ng = a.in(I_NG); const float* FF = (const float*)(ws + WS_FF); const float* H = (const float*)(ws + WS_H);
        for (int row = gw; row < MROWS; row += NGW) {
            const f32x4* fr_ = (const f32x4*)(FF + (size_t)row * DM) + lane; const f32x4* hr = (const f32x4*)(H + (size_t)row * DM) + lane; const float* md = mod + (size_t)seq_of_row(row) * NADA;
            f32x4 v[8]; float ss = 0.f;
#pragma unroll
            for (int j = 0; j < 8; ++j) {
                if (row < NPROMPT) v[j] = fr_[64 * j];
                else { const f32x4* sp = (const f32x4*)(ws + WS_SLD) + (size_t)(row - NPROMPT) * 512 + lane + 64 * j; f32x4 t = sp[0];
#pragma unroll
                    for (int k = 1; k < 16; ++k) t += sp[(size_t)k * 512 * 512]; v[j] = t; }
                ss += (v[j][0] * v[j][0] + v[j][1] * v[j][1]) + (v[j][2] * v[j][2] + v[j][3] * v[j][3]); }
            const float r = rsqrtf(wave_sum(ss) * (1.f / DM) + EPS);
            f32x4* yo = (f32x4*)(a.out() + O_Y + (size_t)row * DM) + lane;
#pragma unroll
            for (int j = 0; j < 8; ++j) { const int c = 4 * lane + 256 * j; const f32x4 g = *(const f32x4*)(ng + 6144 + c), g2 = *(const f32x4*)(md + 10240 + c), h = hr[64 * j];
                f32x4 y; _Pragma("unroll") for (int e = 0; e < 4; ++e) y[e] = h[e] + g2[e] * (v[j][e] * r * g[e]);
                yo[64 * j] = y; }
        }
    }
#undef IN
#undef SEAM
}

constexpr int N_PHASES = 13;
extern "C" void kernel_launch(void* const* d_in, const int* in_sizes, int n_in, void* d_out, int out_size, void* d_ws, size_t ws_size, hipStream_t stream) {
    static int grid = 0;
    if (grid == 0) {
        if (n_in != 22 || (size_t)out_size != O_END || ws_size < WS_END) { fprintf(stderr, "kernel_launch: unexpected shapes: n_in %d out %d ws %zu\n", n_in, out_size, ws_size); grid = -1; return; }
        int dev = 0, cus = 0, per_cu = 0;
        if (hipGetDevice(&dev) != hipSuccess || hipDeviceGetAttribute(&cus, hipDeviceAttributeMultiprocessorCount, dev) != hipSuccess) { grid = -1; return; }
        if (hipFuncSetAttribute((const void*)fwd, hipFuncAttributeMaxDynamicSharedMemorySize, LDS_BYTES) != hipSuccess) { fprintf(stderr, "kernel_launch: hipFuncSetAttribute failed\n"); grid = -1; return; }
        if (hipOccupancyMaxActiveBlocksPerMultiprocessor(&per_cu, (const void*)fwd, NTHREADS, LDS_BYTES) != hipSuccess || per_cu < 1) { fprintf(stderr, "kernel_launch: occupancy query says %d\n", per_cu); (void)hipGetLastError(); per_cu = 1; }
        grid = cus;
    }
    if (grid < 0) return;
    if (hipMemsetAsync(d_ws, 0, CTL_ZERO_BYTES, stream) != hipSuccess) { fprintf(stderr, "kernel_launch: memset failed\n"); return; }
    Args a{};
    for (int i = 0; i < 22; ++i) a.in[i] = (const float*)d_in[i];
    a.out = (float*)d_out; a.ws = (unsigned char*)d_ws;
#ifdef MULTI_LAUNCH
    for (int p = 0; p < N_PHASES; ++p) { a.ph_lo = p; a.ph_hi = p + 1; hipLaunchKernelGGL(fwd, dim3(grid), dim3(NTHREADS), LDS_BYTES, stream, a); }
#else
    a.ph_lo = 0; a.ph_hi = N_PHASES;
    void* args[] = {&a};
    hipError_t e = hipLaunchCooperativeKernel((const void*)fwd, dim3(grid), dim3(NTHREADS), args, LDS_BYTES, stream);
    if (e != hipSuccess) fprintf(stderr, "cooperative launch failed: %s (grid %d)\n", hipGetErrorString(e), grid);
#endif
}
```
